# Optimizing an MI355X kernel written in HIP

```python
import math
import jax
import jax.numpy as jnp
from jax import lax
import numpy as np

D_MODEL = 1024
BATCH = 8
SEQ = 2048
DEPTH = 2
DEC_BATCH = 128
DEC_SEQ = 1
PAST_LEN = 16384
PAGE_SIZE = 128

N_META = 16
CHUNK = 64
A_HEADS = 4
A_DK = 128
A_DV = 128
A_QK = A_HEADS * A_DK
A_V = A_HEADS * A_DV
CONV_W = 4
CONV_CH = 2 * A_QK + A_V
B_HEADS = 4
B_DK = 64
B_DV = 128
B_QK = B_HEADS * B_DK
B_V = B_HEADS * B_DV
B_GATE_RANK = 16
B_GATE_TAU = 16.0
D_FF = ((8 * D_MODEL + 3 * 256 - 1) // (3 * 256)) * 256
IN_SIZES = (CONV_CH, A_V, A_HEADS, A_HEADS, B_QK, B_QK, B_V, B_V, B_GATE_RANK, D_MODEL, D_MODEL)
D_IN = sum(IN_SIZES)
DEEPNORM_ALPHA = (2.0 * DEPTH) ** 0.25
DEEPNORM_BETA = (8.0 * DEPTH) ** -0.25
F32 = jnp.float32

kernel_name = 'hybrid_gdn_gla_deepnorm_step'


def _layer_norm(x, g, b, eps=1e-5):
    xf = x.astype(F32)
    mu = jnp.mean(xf, axis=-1, keepdims=True)
    var = jnp.mean(jnp.square(xf - mu), axis=-1, keepdims=True)
    return ((xf - mu) * lax.rsqrt(var + eps) * g.astype(F32) + b.astype(F32)).astype(x.dtype)


def _rms_norm(x, w, eps=1e-6):
    xf = x.astype(F32)
    return xf * lax.rsqrt(jnp.mean(xf * xf, axis=-1, keepdims=True) + eps) * w.astype(F32)


def _l2norm(x, eps=1e-6):
    return x * lax.rsqrt(jnp.sum(x * x, axis=-1, keepdims=True) + eps)


def _heads(t, n):
    b, l = t.shape[:2]
    return t.reshape(b, l, n, -1).transpose(0, 2, 1, 3).astype(F32)


def _split_in(p):
    offsets = np.cumsum(IN_SIZES)[:-1].tolist()
    return jnp.split(p, offsets, axis=-1)


def _causal_conv(u, buf, w):
    l = u.shape[1]
    ext = jnp.concatenate([buf.astype(u.dtype), u], axis=1)
    out = sum(ext[:, i:i + l] * w[i] for i in range(CONV_W))
    return jax.nn.silu(out), ext[:, l:]


def _gdn_chunks(q, k, v, g, beta, s0, chunk):
    b, h, l, dk = q.shape
    dv = v.shape[-1]
    n = l // chunk
    r = lambda t: t.reshape(t.shape[:2] + (n, chunk) + t.shape[3:])
    q, k, v, g, beta = r(q), r(k), r(v), r(g), r(beta)
    gam = jnp.cumsum(g, axis=-1)
    incl = jnp.tril(jnp.ones((chunk, chunk), dtype=bool))
    strict = jnp.tril(jnp.ones((chunk, chunk), dtype=bool), k=-1)
    diff = gam[..., :, None] - gam[..., None, :]
    dec_incl = jnp.exp(jnp.where(incl, diff, -jnp.inf))
    dec_strict = jnp.where(strict, dec_incl, 0.0)
    a_mat = beta[..., None] * dec_strict * jnp.einsum('bhnck,bhnjk->bhncj', k, k)
    eye = jnp.eye(chunk, dtype=F32)
    rhs = jnp.concatenate([beta[..., None] * v, (beta * jnp.exp(gam))[..., None] * k], axis=-1)
    sol = lax.linalg.triangular_solve(eye + a_mat, rhs, left_side=True, lower=True, unit_diagonal=True)
    u0, w = sol[..., :dv], sol[..., dv:]
    qk = jnp.einsum('bhnck,bhnjk->bhncj', q, k) * dec_incl
    q_dec = q * jnp.exp(gam)[..., None]
    k_dec = k * jnp.exp(gam[..., -1:] - gam)[..., None]
    g_tot = jnp.exp(gam[..., -1])
    xs = tuple(jnp.moveaxis(t, 2, 0) for t in (u0, w, qk, q_dec, k_dec, g_tot))

    def step(s, inp):
        u0_c, w_c, qk_c, qd_c, kd_c, gt_c = inp
        u = u0_c - jnp.einsum('bhck,bhkv->bhcv', w_c, s)
        o = jnp.einsum('bhck,bhkv->bhcv', qd_c, s) + jnp.einsum('bhcj,bhjv->bhcv', qk_c, u)
        s = gt_c[..., None, None] * s + jnp.einsum('bhck,bhcv->bhkv', kd_c, u)
        return s, o

    s, o = lax.scan(step, s0.astype(F32), xs)
    return jnp.moveaxis(o, 0, 2).reshape(b, h, l, dv), s


def _gla_chunks(q, k, v, lg, s0, chunk):
    b, h, l, dk = q.shape
    dv = v.shape[-1]
    n = l // chunk
    r = lambda t: t.reshape(t.shape[:2] + (n, chunk) + t.shape[3:])
    q, k, v, lg = r(q), r(k), r(v), r(lg)
    cb = jnp.cumsum(lg, axis=-2)
    q_dec = q * jnp.exp(cb)
    k_dec = k * jnp.exp(cb[..., -1:, :] - cb)
    a_tot = jnp.exp(cb[..., -1, :])
    incl = jnp.tril(jnp.ones((chunk, chunk), dtype=bool))[:, :, None]
    xs = tuple(jnp.moveaxis(t, 2, 0) for t in (q, k, v, cb, q_dec, k_dec, a_tot))

    def step(s, inp):
        q_c, k_c, v_c, cb_c, qd_c, kd_c, at_c = inp
        diff = cb_c[:, :, :, None, :] - cb_c[:, :, None, :, :]
        dec = jnp.exp(jnp.where(incl, diff, -jnp.inf))
        attn = jnp.einsum('bhtk,bhjk,bhtjk->bhtj', q_c, k_c, dec)
        o = jnp.einsum('bhck,bhkv->bhcv', qd_c, s) + jnp.einsum('bhtj,bhjv->bhtv', attn, v_c)
        s = at_c[..., None] * s + jnp.einsum('bhck,bhcv->bhkv', kd_c, v_c)
        return s, o

    s, o = lax.scan(step, s0.astype(F32), xs)
    return jnp.moveaxis(o, 0, 2).reshape(b, h, l, dv), s


def _token_mix(h, conv_buf, s_gdn, s_gla, segments, w_in, conv_w, a_log, dt_bias, gdn_norm_w,
               gla_gate_w2, gla_gate_b, gla_norm_w, w_branch_a, w_branch_b, w_out):
    b, l, _ = h.shape
    qkv_a, z_a, beta_a, a_a, q_b, k_b, v_b, r_b, glr_b, gate_a, gate_b = _split_in(h @ w_in)
    qkv_a, conv_buf = _causal_conv(qkv_a, conv_buf, conv_w)
    q_a, k_a, v_a = jnp.split(qkv_a, [A_QK, 2 * A_QK], axis=-1)
    q_a = _l2norm(_heads(q_a, A_HEADS)) * (A_DK ** -0.5)
    k_a = _l2norm(_heads(k_a, A_HEADS))
    v_a = _heads(v_a, A_HEADS)
    beta = jax.nn.sigmoid(beta_a.astype(F32)).transpose(0, 2, 1)
    g = -(jnp.exp(a_log.astype(F32)) * jax.nn.softplus(a_a.astype(F32) + dt_bias.astype(F32)))
    g = g.transpose(0, 2, 1)
    q_b = _heads(q_b, B_HEADS) * (B_DK ** -0.5)
    k_b = _heads(k_b, B_HEADS)
    v_b = _heads(v_b, B_HEADS)
    lg = jax.nn.log_sigmoid((glr_b @ gla_gate_w2 + gla_gate_b).astype(F32)) / B_GATE_TAU
    lg = _heads(lg, B_HEADS)
    o_a, o_b = [], []
    start = 0
    for length, chunk in segments:
        sl = slice(start, start + length)
        oa, s_gdn = _gdn_chunks(q_a[:, :, sl], k_a[:, :, sl], v_a[:, :, sl], g[:, :, sl], beta[:, :, sl], s_gdn, chunk)
        ob, s_gla = _gla_chunks(q_b[:, :, sl], k_b[:, :, sl], lg[:, :, sl], v_b[:, :, sl], s_gla, chunk) if False else _gla_chunks(q_b[:, :, sl], k_b[:, :, sl], v_b[:, :, sl], lg[:, :, sl], s_gla, chunk)
        o_a.append(oa)
        o_b.append(ob)
        start += length
    o_a = jnp.concatenate(o_a, axis=2).transpose(0, 2, 1, 3)
    o_b = jnp.concatenate(o_b, axis=2).transpose(0, 2, 1, 3)
    o_a = _rms_norm(o_a, gdn_norm_w).reshape(b, l, A_V) * jax.nn.silu(z_a.astype(F32))
    o_b = _rms_norm(o_b, gla_norm_w).reshape(b, l, B_V) * jax.nn.silu(r_b.astype(F32))
    y_a = o_a.astype(h.dtype) @ w_branch_a
    y_b = o_b.astype(h.dtype) @ w_branch_b
    merged = jax.nn.sigmoid(gate_a) * y_a + jax.nn.sigmoid(gate_b) * y_b
    return merged @ w_out, conv_buf, s_gdn, s_gla


def _swiglu(x, w_ffn_in, w_ffn_out):
    a, u = jnp.split(x @ w_ffn_in, 2, axis=-1)
    return (jax.nn.silu(a) * u) @ w_ffn_out


def _layer(x, conv_buf, s_gdn, s_gla, segments, w_in, conv_w, a_log, dt_bias, gdn_norm_w, gla_gate_w2,
           gla_gate_b, gla_norm_w, w_branch_a, w_branch_b, w_out, ln1_g, ln1_b, ln2_g, ln2_b, w_ffn_in, w_ffn_out):
    mix, conv_buf, s_gdn, s_gla = _token_mix(x, conv_buf, s_gdn, s_gla, segments, w_in, conv_w, a_log, dt_bias,
                                             gdn_norm_w, gla_gate_w2, gla_gate_b, gla_norm_w,
                                             w_branch_a, w_branch_b, w_out)
    x = _layer_norm(DEEPNORM_ALPHA * x + mix, ln1_g, ln1_b)
    x = _layer_norm(DEEPNORM_ALPHA * x + _swiglu(x, w_ffn_in, w_ffn_out), ln2_g, ln2_b)
    return x, s_gdn.astype(x.dtype), s_gla.astype(x.dtype), conv_buf


def setup_inputs(seed: int = 0) -> dict:
    key = jax.random.key(seed)
    ks = jax.random.split(key, 24)
    nrm = lambda k, shape, s: jax.random.normal(k, shape, F32) * s
    dt = jnp.exp(jax.random.uniform(ks[5], (DEPTH, A_HEADS), F32, math.log(1e-3), math.log(1e-1)))
    return {
        'x_prompt': nrm(ks[0], (BATCH, SEQ, D_MODEL), 1.0),
        'x_sample': nrm(ks[1], (DEC_BATCH, DEC_SEQ, D_MODEL), 1.0),
        'state_gdn': nrm(ks[2], (DEPTH, DEC_BATCH, A_HEADS, A_DK, A_DV), 0.3),
        'state_gla': nrm(ks[3], (DEPTH, DEC_BATCH, B_HEADS, B_DK, B_DV), 0.3),
        'state_conv': nrm(ks[4], (DEPTH, DEC_BATCH, CONV_W - 1, CONV_CH), 1.0),
        'meta_tokens': nrm(ks[6], (N_META, D_MODEL), 1.0),
        'w_in': nrm(ks[7], (DEPTH, D_MODEL, D_IN), D_MODEL ** -0.5),
        'conv_w': nrm(ks[8], (DEPTH, CONV_W, CONV_CH), CONV_W ** -0.5),
        'a_log': jnp.log(jax.random.uniform(ks[9], (DEPTH, A_HEADS), F32, 1.0, 16.0)),
        'dt_bias': dt + jnp.log(-jnp.expm1(-dt)),
        'gdn_norm_w': 1.0 + nrm(ks[10], (DEPTH, A_DV), 0.02),
        'gla_gate_w2': nrm(ks[11], (DEPTH, B_GATE_RANK, B_QK), B_GATE_RANK ** -0.5),
        'gla_gate_b': nrm(ks[12], (DEPTH, B_QK), 0.02),
        'gla_norm_w': 1.0 + nrm(ks[13], (DEPTH, B_DV), 0.02),
        'w_branch_a': nrm(ks[14], (DEPTH, A_V, D_MODEL), A_V ** -0.5 * DEEPNORM_BETA),
        'w_branch_b': nrm(ks[15], (DEPTH, B_V, D_MODEL), B_V ** -0.5 * DEEPNORM_BETA),
        'w_out': nrm(ks[16], (DEPTH, D_MODEL, D_MODEL), D_MODEL ** -0.5 * DEEPNORM_BETA),
        'ln1_g': 1.0 + nrm(ks[17], (DEPTH, D_MODEL), 0.02),
        'ln1_b': nrm(ks[18], (DEPTH, D_MODEL), 0.02),
        'ln2_g': 1.0 + nrm(ks[19], (DEPTH, D_MODEL), 0.02),
        'ln2_b': nrm(ks[20], (DEPTH, D_MODEL), 0.02),
        'w_ffn_in': nrm(ks[21], (DEPTH, D_MODEL, 2 * D_FF), D_MODEL ** -0.5),
        'w_ffn_out': nrm(ks[22], (DEPTH, D_FF, D_MODEL), D_FF ** -0.5 * DEEPNORM_BETA),
    }


def reference(x_prompt, x_sample, state_gdn, state_gla, state_conv, meta_tokens, w_in, conv_w, a_log, dt_bias,
              gdn_norm_w, gla_gate_w2, gla_gate_b, gla_norm_w, w_branch_a, w_branch_b, w_out,
              ln1_g, ln1_b, ln2_g, ln2_b, w_ffn_in, w_ffn_out):
    dtp = x_prompt.dtype
    bp = x_prompt.shape[0]
    seq = x_prompt.shape[1]
    dec_seq = x_sample.shape[1]
    meta = jnp.broadcast_to(meta_tokens.astype(dtp)[None], (bp, N_META, D_MODEL))
    hp = jnp.concatenate([meta, x_prompt], axis=1)
    hs = x_sample
    seg_p = ((N_META, N_META), (seq, math.gcd(seq, CHUNK)))
    seg_s = ((dec_seq, math.gcd(dec_seq, CHUNK)),)
    gdn_p, gla_p, conv_p, gdn_s, gla_s, conv_s = [], [], [], [], [], []
    for l in range(DEPTH):
        p = (w_in[l], conv_w[l], a_log[l], dt_bias[l], gdn_norm_w[l], gla_gate_w2[l], gla_gate_b[l], gla_norm_w[l],
             w_branch_a[l], w_branch_b[l], w_out[l], ln1_g[l], ln1_b[l], ln2_g[l], ln2_b[l], w_ffn_in[l], w_ffn_out[l])
        hp, sg, sl, cb = _layer(hp, jnp.zeros((bp, CONV_W - 1, CONV_CH), dtp),
                                jnp.zeros((bp, A_HEADS, A_DK, A_DV), F32),
                                jnp.zeros((bp, B_HEADS, B_DK, B_DV), F32), seg_p, *p)
        gdn_p.append(sg)
        gla_p.append(sl)
        conv_p.append(cb)
        hs, sg, sl, cb = _layer(hs, state_conv[l], state_gdn[l], state_gla[l], seg_s, *p)
        gdn_s.append(sg)
        gla_s.append(sl)
        conv_s.append(cb)
    y_prompt = hp[:, N_META:]
    return (y_prompt, hs, jnp.stack(gdn_p), jnp.stack(gla_p), jnp.stack(conv_p),
            jnp.stack(gdn_s), jnp.stack(gla_s), jnp.stack(conv_s))
```

```cpp
#include <hip/hip_runtime.h>
#include <hip/hip_bf16.h>
#include <hip/hip_cooperative_groups.h>
#include <cstdio>
namespace cg = cooperative_groups;

#ifndef SINGLE_LAUNCH
#define SINGLE_LAUNCH 1
#endif
#ifndef REPEAT_MASK
#define REPEAT_MASK 0
#endif
#ifndef EXTRA_SYNCS
#define EXTRA_SYNCS 0
#endif

typedef __hip_bfloat16 bf16;
typedef unsigned short u16;
typedef unsigned int u32;
using bf16x8 = __attribute__((ext_vector_type(8))) short;
using f32x4 = __attribute__((ext_vector_type(4))) float;
using u32x4 = __attribute__((ext_vector_type(4))) unsigned int;
using u32x2 = __attribute__((ext_vector_type(2))) unsigned int;

constexpr int D = 1024;
constexpr int NBATCH = 8, LP = 2064, MP = NBATCH * LP;
constexpr int NS = 128;
constexpr int MT = MP + NS;
constexpr int NMT = MT / 256;
constexpr int DIN_SRC = 5656, DIN_PAD = 5888;
constexpr int DFF = 2816;
constexpr int NTHREADS = 512, NWAVES = 8;
constexpr int PH_PER_LAYER = 12, NPHASES = 2 * PH_PER_LAYER;
constexpr float ALPHA = 1.4142135623730951f;

constexpr size_t SZ_WIN = (size_t)DIN_PAD * 1024 * 2;
constexpr size_t SZ_WFI = (size_t)2 * DFF * 1024 * 2;
constexpr size_t SZ_WFO = (size_t)1024 * DFF * 2;
constexpr size_t SZ_WA = (size_t)1024 * 512 * 2;
constexpr size_t SZ_WO = (size_t)1024 * 1024 * 2;
constexpr size_t OFF_WIN = 0;
constexpr size_t OFF_WFI = OFF_WIN + SZ_WIN;
constexpr size_t OFF_WFO = OFF_WFI + SZ_WFI;
constexpr size_t OFF_WA = OFF_WFO + SZ_WFO;
constexpr size_t OFF_WB = OFF_WA + SZ_WA;
constexpr size_t OFF_WO = OFF_WB + SZ_WA;
constexpr size_t OFF_XB = OFF_WO + SZ_WO;
constexpr size_t OFF_R2 = OFF_XB + (size_t)MT * 1024 * 2;
constexpr size_t OFF_R3 = OFF_R2 + (size_t)MT * 1536 * 2;
constexpr size_t OFF_R4 = OFF_R3 + (size_t)MT * 2048 * 2;
constexpr size_t R4_BYTES = (size_t)1056 * (73728 + 25088);
constexpr size_t OFF_R5 = OFF_R4 + R4_BYTES;
constexpr size_t OFF_GT = OFF_R5 + (size_t)MT * 32 * 4;
constexpr size_t OFF_QS = OFF_GT + 8192;
constexpr size_t OFF_BAR = OFF_QS + (size_t)NS * 1536 * 2;
constexpr size_t BAR_BYTES = 16384;
constexpr size_t WS_END = OFF_BAR + BAR_BYTES;
static_assert(WS_END <= (size_t)305000000, "workspace budget");
static_assert(R4_BYTES >= (size_t)MT * 1024 * 4, "R4 must hold preLN");

constexpr size_t OUT_YP = 0;
constexpr size_t OUT_YS = OUT_YP + (size_t)8 * 2048 * 1024;
constexpr size_t OUT_GDNP = OUT_YS + (size_t)128 * 1024;
constexpr size_t OUT_GLAP = OUT_GDNP + (size_t)2 * 8 * 4 * 128 * 128;
constexpr size_t OUT_CONVP = OUT_GLAP + (size_t)2 * 8 * 4 * 64 * 128;
constexpr size_t OUT_GDNS = OUT_CONVP + (size_t)2 * 8 * 3 * 1536;
constexpr size_t OUT_GLAS = OUT_GDNS + (size_t)2 * 128 * 4 * 128 * 128;
constexpr size_t OUT_CONVS = OUT_GLAS + (size_t)2 * 128 * 4 * 64 * 128;

struct Params {
  const float* in[23];
  float* out;
  unsigned char* ws;
  int ph_lo, ph_hi;
};

typedef float f32x2_t __attribute__((ext_vector_type(2)));
typedef __bf16 bf16x2_t __attribute__((ext_vector_type(2)));
__device__ __forceinline__ u32 pk2(float lo, float hi) {
  f32x2_t v = {lo, hi};
  bf16x2_t b = __builtin_convertvector(v, bf16x2_t);
  return __builtin_bit_cast(u32, b);
}
__device__ __forceinline__ u16 f2bf(float x) { return (u16)(pk2(x, 0.f) & 0xffffu); }
__device__ __forceinline__ float bflo(u32 w) { return __uint_as_float(w << 16); }
__device__ __forceinline__ float bfhi(u32 w) { return __uint_as_float(w & 0xffff0000u); }
__device__ __forceinline__ float bf1(u16 h) { return __uint_as_float(((u32)h) << 16); }
__device__ __forceinline__ void unpack8(const u32x4 v, float* f) {
  f[0] = bflo(v.x); f[1] = bfhi(v.x); f[2] = bflo(v.y); f[3] = bfhi(v.y);
  f[4] = bflo(v.z); f[5] = bfhi(v.z); f[6] = bflo(v.w); f[7] = bfhi(v.w);
}
__device__ __forceinline__ u32x4 pack8(const float* f) {
  u32x4 v; v.x = pk2(f[0], f[1]); v.y = pk2(f[2], f[3]); v.z = pk2(f[4], f[5]); v.w = pk2(f[6], f[7]);
  return v;
}
template <int X> __device__ __forceinline__ float swz_xor(float v) {
  return __int_as_float(__builtin_amdgcn_ds_swizzle(__float_as_int(v), (X << 10) | 0x1f));
}
__device__ __forceinline__ float sum8(float v) {
  v += swz_xor<1>(v); v += swz_xor<2>(v); v += swz_xor<4>(v);
  return v;
}
__device__ __forceinline__ float sum16(float v) {
  v += swz_xor<1>(v); v += swz_xor<2>(v); v += swz_xor<4>(v); v += swz_xor<8>(v);
  return v;
}
__device__ __forceinline__ float sum64(float v) {
  v += swz_xor<1>(v); v += swz_xor<2>(v); v += swz_xor<4>(v); v += swz_xor<8>(v); v += swz_xor<16>(v);
  return __int_as_float(__builtin_amdgcn_readlane(__float_as_int(v), 0)) + __int_as_float(__builtin_amdgcn_readlane(__float_as_int(v), 32));
}
__device__ __forceinline__ float sigmoidf_(float x) { return __builtin_amdgcn_rcpf(1.f + __expf(-x)); }
__device__ __forceinline__ float softplusf_(float x) { return x > 20.f ? x : log1pf(__expf(x)); }

extern __shared__ __attribute__((aligned(16))) unsigned char smem_raw[];
__device__ __forceinline__ int opaque_tid() { int t = threadIdx.x; asm volatile("" : "+v"(t)); return t; }

constexpr int HT = 128 * 64;
__device__ __forceinline__ int lds_byte(int r, int c) {
  int st = (r >> 4) * 2 + (c >> 5), rr = r & 15, cc = c & 31, ob = rr * 64 + cc * 2;
  return st * 1024 + (ob ^ (((ob >> 9) & 1) << 5));
}
__device__ __forceinline__ void stage_rc(int b, int& R, int& C) {
  int st = b / 1024, sb = b % 1024, swz = sb ^ (((sb >> 9) & 1) << 5);
  R = (st >> 1) * 16 + swz / 64;
  C = (st & 1) * 32 + (swz % 64) / 2;
}

typedef f32x4 Acc[2][2][4][2];

#define LAS __attribute__((address_space(3)))
__device__ __forceinline__ void gemm_kloop(Acc& acc, const bf16* __restrict__ A, int lda, const bf16* __restrict__ Bt, int ldb,
                                           int K, int brow, int bcol, const int tid, const bool perm = false) {
  LAS unsigned char* lds = (LAS unsigned char*)smem_raw;
  const int wid = __builtin_amdgcn_readfirstlane(tid >> 6), lane = tid & 63, wr = wid >> 2, wc = wid & 3,
            fr = lane & 15, fq = lane >> 4;
  unsigned voffA[2], voffB[2];
#pragma unroll
  for (int i = 0; i < 2; ++i) {
    int R, C;
    stage_rc(tid * 16 + i * 8192, R, C);
    voffA[i] = (unsigned)(R * lda + C) * 2u;
    const int p32 = R & 31, Rb = perm ? ((R & ~31) + 8 * ((p32 & 15) >> 2) + 4 * (p32 >> 4) + (p32 & 3)) : R;
    voffB[i] = (unsigned)(Rb * ldb + C) * 2u;
  }
  const size_t kstep = 128, hA = (size_t)128 * lda * 2, hB = (size_t)128 * ldb * 2;
  const unsigned ldsw = (unsigned)wid * 1024u;
  const int aoff = lds_byte(wr * 64 + fr, fq * 8), boff = lds_byte(wc * 32 + fr, fq * 8);
  const char* cA = (const char*)A + (size_t)brow * lda * 2;
  const char* cB = (const char*)Bt + (size_t)bcol * ldb * 2;
#define SA(b, h) (((b) * 2 + (h)) * 16384)
#define SB(b, h) ((4 + (b) * 2 + (h)) * 16384)
#define STAGE(bufoff, gbase, voff)                                                                             \
  do {                                                                                                         \
    _Pragma("unroll") for (int _i = 0; _i < 2; ++_i)                                                           \
        __builtin_amdgcn_global_load_lds((const unsigned*)((const char*)(gbase) + (voff)[_i]),                 \
                                         (LAS unsigned*)(lds + (bufoff) + ldsw + _i * 8192), 16, 0, 0);        \
  } while (0)
#define LDA(dst, b, h)                                                                                         \
  do {                                                                                                         \
    _Pragma("unroll") for (int m = 0; m < 4; ++m) _Pragma("unroll") for (int k = 0; k < 2; ++k)                \
        dst[m][k] = *(const LAS bf16x8*)(lds + SA(b, h) + aoff + m * 2048 + k * 1024);                         \
  } while (0)
#define LDB(dst, b, h)                                                                                         \
  do {                                                                                                         \
    _Pragma("unroll") for (int n = 0; n < 2; ++n) _Pragma("unroll") for (int k = 0; k < 2; ++k)                \
        dst[n][k] = *(const LAS bf16x8*)(lds + SB(b, h) + boff + n * 2048 + k * 1024);                         \
  } while (0)
#define MMA(ai, bj, At_, Bt_)                                                                                  \
  do {                                                                                                         \
    __builtin_amdgcn_s_setprio(1);                                                                             \
    _Pragma("unroll") for (int m = 0; m < 4; ++m) _Pragma("unroll") for (int n = 0; n < 2; ++n)                \
    _Pragma("unroll") for (int k = 0; k < 2; ++k)                                                              \
        acc[ai][bj][m][n] = __builtin_amdgcn_mfma_f32_16x16x32_bf16(Bt_[n][k], At_[m][k], acc[ai][bj][m][n], 0, 0, 0); \
    __builtin_amdgcn_s_setprio(0);                                                                             \
  } while (0)
#define WAIT_V(n) asm volatile("s_waitcnt vmcnt(" #n ")" ::: "memory")
#define WAIT_L(n) asm volatile("s_waitcnt lgkmcnt(" #n ")" ::: "memory")
#define BAR __builtin_amdgcn_s_barrier()
#define SCHED __builtin_amdgcn_sched_barrier(0)
  bf16x8 At[4][2], B0[2][2], B1[2][2];
  const int nt = K / 64;
  STAGE(SB(0, 0), cB, voffB); STAGE(SA(0, 0), cA, voffA); STAGE(SB(0, 1), cB + hB, voffB); STAGE(SA(0, 1), cA + hA, voffA);
  if (wr == 1) BAR;
  WAIT_V(4); BAR;
  STAGE(SB(1, 0), cB + kstep, voffB); STAGE(SA(1, 0), cA + kstep, voffA); STAGE(SB(1, 1), cB + hB + kstep, voffB);
  WAIT_V(6); BAR;
#pragma unroll 1
  for (int t = 0; t < nt - 2; t += 2) {
    const char* a1 = cA + (size_t)(t + 1) * kstep;
    const char* a2 = cA + (size_t)(t + 2) * kstep;
    const char* b2 = cB + (size_t)(t + 2) * kstep;
    const char* a3 = a2 + kstep;
    const char* b3 = b2 + kstep;
    LDB(B0, 0, 0); SCHED; LDA(At, 0, 0); STAGE(SA(1, 1), a1 + hA, voffA);
    WAIT_L(8); BAR; WAIT_L(0); MMA(0, 0, At, B0); BAR; SCHED;
    LDB(B1, 0, 1); STAGE(SB(0, 0), b2, voffB);
    BAR; WAIT_L(0); MMA(0, 1, At, B1); BAR;
    LDA(At, 0, 1); STAGE(SA(0, 0), a2, voffA);
    BAR; WAIT_L(0); MMA(1, 0, At, B0); BAR; SCHED;
    STAGE(SB(0, 1), b2 + hB, voffB);
    WAIT_V(6); BAR; MMA(1, 1, At, B1); BAR;
    LDB(B0, 1, 0); SCHED; LDA(At, 1, 0); STAGE(SA(0, 1), a2 + hA, voffA);
    WAIT_L(8); BAR; WAIT_L(0); MMA(0, 0, At, B0); BAR; SCHED;
    LDB(B1, 1, 1); STAGE(SB(1, 0), b3, voffB);
    BAR; WAIT_L(0); MMA(0, 1, At, B1); BAR;
    LDA(At, 1, 1); STAGE(SA(1, 0), a3, voffA);
    BAR; WAIT_L(0); MMA(1, 0, At, B0); BAR; SCHED;
    STAGE(SB(1, 1), b3 + hB, voffB);
    WAIT_V(6); BAR; MMA(1, 1, At, B1); BAR;
  }
  {
    const char* a1 = cA + (size_t)(nt - 1) * kstep;
    LDB(B0, 0, 0); LDA(At, 0, 0); STAGE(SA(1, 1), a1 + hA, voffA);
    BAR; WAIT_L(0); MMA(0, 0, At, B0); BAR;
    LDB(B1, 0, 1); BAR; WAIT_L(0); MMA(0, 1, At, B1); BAR;
    LDA(At, 0, 1); WAIT_V(4); BAR; WAIT_L(0); MMA(1, 0, At, B0); MMA(1, 1, At, B1); BAR;
  }
  {
    LDB(B0, 1, 0); LDA(At, 1, 0); WAIT_V(2); BAR; WAIT_L(0); MMA(0, 0, At, B0); BAR;
    LDB(B1, 1, 1); WAIT_V(0); BAR; WAIT_L(0); MMA(0, 1, At, B1); BAR;
    LDA(At, 1, 1); BAR; WAIT_L(0); MMA(1, 0, At, B0); MMA(1, 1, At, B1); BAR;
  }
  if (wr == 0) BAR;
#undef SA
#undef SB
#undef STAGE
#undef LDA
#undef LDB
#undef MMA
}

__device__ __forceinline__ void acc_zero(Acc& acc) {
#pragma unroll
  for (int a = 0; a < 2; ++a)
#pragma unroll
    for (int b = 0; b < 2; ++b)
#pragma unroll
      for (int m = 0; m < 4; ++m)
#pragma unroll
        for (int n = 0; n < 2; ++n) acc[a][b][m][n] = f32x4{0.f, 0.f, 0.f, 0.f};
}

#define EPI_COORDS                                                                                           \
  const int wid = tid >> 6, lane = tid & 63, wr = wid >> 2, wc = wid & 3, fr = lane & 15, fq = lane >> 4; \
  (void)wid;
#define EPI_LOOP                                                                                             \
  _Pragma("unroll") for (int ai = 0; ai < 2; ++ai) _Pragma("unroll") for (int bj = 0; bj < 2; ++bj)            \
  _Pragma("unroll") for (int m = 0; m < 4; ++m) _Pragma("unroll") for (int n = 0; n < 2; ++n)
#define EPI_ROW (brow + ai * 128 + wr * 64 + m * 16 + fr)
#define EPI_COL (bj * 128 + wc * 32 + n * 16 + fq * 4)

__device__ __forceinline__ void epi_store_bf16(const Acc& acc, bf16* dst, int ldd, int brow, const int tid) {
  EPI_COORDS
  EPI_LOOP {
    const f32x4 v = acc[ai][bj][m][n];
    u32x2 o; o.x = pk2(v[0], v[1]); o.y = pk2(v[2], v[3]);
    *reinterpret_cast<u32x2*>(dst + (size_t)EPI_ROW * ldd + EPI_COL) = o;
  }
}

__device__ __forceinline__ void epi_store_bf16_perm(const Acc& acc, bf16* dst, int ldd, int brow, const int tid) {
  EPI_COORDS
#pragma unroll
  for (int ai = 0; ai < 2; ++ai)
#pragma unroll
    for (int bj = 0; bj < 2; ++bj)
#pragma unroll
      for (int m = 0; m < 4; ++m) {
        const f32x4 v0 = acc[ai][bj][m][0], v1 = acc[ai][bj][m][1];
        u32x4 o; o.x = pk2(v0[0], v0[1]); o.y = pk2(v0[2], v0[3]); o.z = pk2(v1[0], v1[1]); o.w = pk2(v1[2], v1[3]);
        *reinterpret_cast<u32x4*>(dst + (size_t)(brow + ai * 128 + wr * 64 + m * 16 + fr) * ldd + bj * 128 + wc * 32 + 8 * fq) = o;
      }
}

__device__ __forceinline__ int srcmap_win(int d) {
  if (d < 2048) return d;
  if (d < 3584) return d + 8;
  if (d < 5632) return d + 24;
  if (d < 5640) return d - 5632 + 2048;
  if (d < 5656) return d - 5640 + 3592;
  return -1;
}
__device__ __forceinline__ int srcmap_ffi(int d) {
  const int tile = d >> 8, c = d & 255;
  const int bj = c >> 7, wc = (c >> 5) & 3, n = (c >> 4) & 1, i = c & 15;
  const int h = tile * 128 + wc * 32 + (i >> 2) * 8 + bj * 4 + (i & 3);
  return n ? (DFF + h) : h;
}
__device__ __forceinline__ void transpose_item(const float* __restrict__ W, int K, int Nsrc, bf16* __restrict__ WT, int mode,
                                               int item, float* scr, int lane) {
  const int nkb = K / 64, db = item / nkb, kb = item % nkb, k0 = kb * 64, d0 = db * 32;
  const int d = d0 + (lane & 7) * 4;
  const int s = (mode == 0) ? d : (mode == 1 ? srcmap_win(d) : srcmap_ffi(d));
#pragma unroll
  for (int i = 0; i < 8; ++i) {
    const int kk = 8 * i + (lane >> 3);
    f32x4 v = {0.f, 0.f, 0.f, 0.f};
    if (s >= 0) v = *reinterpret_cast<const f32x4*>(W + (size_t)(k0 + kk) * Nsrc + s);
    float* sp = scr + kk * 33 + (lane & 7) * 4;
    sp[0] = v[0]; sp[1] = v[1]; sp[2] = v[2]; sp[3] = v[3];
  }
  __builtin_amdgcn_wave_barrier();
  const int c = lane & 7;
#pragma unroll
  for (int j = 0; j < 4; ++j) {
    const int n = (lane >> 3) + 8 * j;
    const float* sp = scr + (8 * c) * 33 + n;
    u32x4 o;
    o.x = pk2(sp[0 * 33], sp[1 * 33]); o.y = pk2(sp[2 * 33], sp[3 * 33]);
    o.z = pk2(sp[4 * 33], sp[5 * 33]); o.w = pk2(sp[6 * 33], sp[7 * 33]);
    *reinterpret_cast<u32x4*>(WT + (size_t)(d0 + n) * K + k0 + 8 * c) = o;
  }
  __builtin_amdgcn_wave_barrier();
}

__device__ __forceinline__ void phase_convert(const Params& p, int l, int parts, int first_wg) {
  const int tid = opaque_tid();
  const int wid = tid >> 6, lane = tid & 63;
  if ((int)blockIdx.x < first_wg) return;
  float* scr = (float*)(smem_raw + wid * 8704);
  const int gw = ((int)blockIdx.x - first_wg) * NWAVES + wid, NGW = ((int)gridDim.x - first_wg) * NWAVES;
  constexpr int I_IN = (DIN_PAD / 32) * 16, I_FI = (2 * DFF / 32) * 16, I_FO = 32 * (DFF / 64), I_A = 32 * 8, I_O = 32 * 16;
  constexpr int NITEMS = I_IN + I_FI + I_FO + 2 * I_A + I_O;
  unsigned char* ws = p.ws;
  for (int it = gw; it < NITEMS; it += NGW) {
    int r = it;
    {
      const int grp = (r < I_IN) ? 0 : ((r < I_IN + I_FI + I_FO) ? 2 : 1);
      if (!((parts >> grp) & 1)) continue;
    }
    if (r < I_IN) { transpose_item(p.in[6] + (size_t)l * 1024 * DIN_SRC, 1024, DIN_SRC, (bf16*)(ws + OFF_WIN), 1, r, scr, lane); continue; }
    r -= I_IN;
    if (r < I_FI) { transpose_item(p.in[21] + (size_t)l * 1024 * 2 * DFF, 1024, 2 * DFF, (bf16*)(ws + OFF_WFI), 2, r, scr, lane); continue; }
    r -= I_FI;
    if (r < I_FO) { transpose_item(p.in[22] + (size_t)l * DFF * 1024, DFF, 1024, (bf16*)(ws + OFF_WFO), 0, r, scr, lane); continue; }
    r -= I_FO;
    if (r < I_A) { transpose_item(p.in[14] + (size_t)l * 512 * 1024, 512, 1024, (bf16*)(ws + OFF_WA), 0, r, scr, lane); continue; }
    r -= I_A;
    if (r < I_A) { transpose_item(p.in[15] + (size_t)l * 512 * 1024, 512, 1024, (bf16*)(ws + OFF_WB), 0, r, scr, lane); continue; }
    r -= I_A;
    transpose_item(p.in[16] + (size_t)l * 1024 * 1024, 1024, 1024, (bf16*)(ws + OFF_WO), 0, r, scr, lane);
  }
  if (parts & 8) {
    bf16* Xb = (bf16*)(ws + OFF_XB);
    const size_t nvec = (size_t)MT * 128;
    for (size_t v = (size_t)blockIdx.x * NTHREADS + tid; v < nvec; v += (size_t)gridDim.x * NTHREADS) {
      const int row = (int)(v >> 7), c0 = (int)(v & 127) * 8;
      const float* src;
      if (row < MP) {
        const int b = row / LP, t = row - b * LP;
        src = (t < 16) ? (p.in[5] + (size_t)t * D + c0) : (p.in[0] + ((size_t)b * 2048 + (t - 16)) * D + c0);
      } else {
        src = p.in[1] + (size_t)(row - MP) * D + c0;
      }
      const f32x4 a = *reinterpret_cast<const f32x4*>(src), b4 = *reinterpret_cast<const f32x4*>(src + 4);
      u32x4 o; o.x = pk2(a[0], a[1]); o.y = pk2(a[2], a[3]); o.z = pk2(b4[0], b4[1]); o.w = pk2(b4[2], b4[3]);
      *reinterpret_cast<u32x4*>(Xb + (size_t)row * D + c0) = o;
    }
  }
}

using f32x16 = __attribute__((ext_vector_type(16))) float;
constexpr int TAIL_ROW0 = 64 * 256;
template <int MODE>
__device__ __forceinline__ void tail_gemm(const Params& p, const bf16* __restrict__ A, int lda, const bf16* __restrict__ Bt, int ldb, int K, int N,
                                          int br, const int tid_in) {
  int tid = tid_in;
  asm volatile("" : "+v"(tid));
  unsigned char* ws = p.ws;
  LAS float* part = (LAS float*)smem_raw;
  const int wid = tid >> 6, lane = tid & 63, r32 = lane & 31, hh = lane >> 5;
  const int ncb = N / 32, kw = K / 8, k0 = wid * kw;
  for (int st = blockIdx.x; st < 8 * ncb; st += gridDim.x) {
    const int rb = st / ncb, cbk = st - rb * ncb;
    const int row0 = TAIL_ROW0 + rb * 32, col0 = cbk * 32;
    const bf16* ap = A + (size_t)(row0 + r32) * lda + k0 + hh * 8;
    const bf16* bp = Bt + (size_t)(col0 + r32) * ldb + k0 + hh * 8;
    f32x16 acc;
#pragma unroll
    for (int i = 0; i < 16; ++i) acc[i] = 0.f;
#pragma unroll 8
    for (int ks = 0; ks < kw; ks += 16) {
      const bf16x8 a = *reinterpret_cast<const bf16x8*>(ap + ks);
      const bf16x8 b = *reinterpret_cast<const bf16x8*>(bp + ks);
      acc = __builtin_amdgcn_mfma_f32_32x32x16_bf16(b, a, acc, 0, 0, 0);
    }
    const size_t m = (size_t)(row0 + r32);
    const int n = col0 + ((2 * wid) & 3) + 8 * ((2 * wid) >> 2) + 4 * hh;
    u32 gpair = 0u, ppair = 0u;
    if (MODE == 1) {
      gpair = *reinterpret_cast<const u32*>(reinterpret_cast<const u16*>(ws + OFF_R4) + m * 2048 + br * 1024 + n);
      if (br) ppair = *reinterpret_cast<const u32*>(reinterpret_cast<const u16*>(ws + OFF_R3) + m * 1024 + n);
    } else if (MODE == 2) {
      gpair = *reinterpret_cast<const u32*>(reinterpret_cast<const u16*>(ws + OFF_XB) + m * 1024 + n);
    }
#pragma unroll
    for (int i = 0; i < 16; ++i) part[(wid * 16 + i) * 64 + lane] = acc[i];
    __syncthreads();
    float v0 = 0.f, v1 = 0.f;
#pragma unroll
    for (int w = 0; w < 8; ++w) { v0 += part[(w * 16 + 2 * wid) * 64 + lane]; v1 += part[(w * 16 + 2 * wid + 1) * 64 + lane]; }
    if (MODE == 0) {
      *reinterpret_cast<u32*>(reinterpret_cast<u16*>(ws + OFF_R4) + m * 2048 + n) = pk2(v0, v1);
    } else if (MODE == 1) {
      float o0 = v0 * sigmoidf_(bflo(gpair)), o1 = v1 * sigmoidf_(bfhi(gpair));
      if (br) { o0 += bflo(ppair); o1 += bfhi(ppair); }
      *reinterpret_cast<u32*>(reinterpret_cast<u16*>(ws + OFF_R3) + m * 1024 + n) = pk2(o0, o1);
    } else {
      *reinterpret_cast<u32*>(reinterpret_cast<u16*>(ws + OFF_R4) + m * 1024 + n) = pk2(v0 + ALPHA * bflo(gpair), v1 + ALPHA * bfhi(gpair));
    }
    __syncthreads();
  }
}

__device__ __forceinline__ void tile_xcd(int u, int nn, int& pm, int& pi) {
  if (u < 64 * nn) {
    const int x = u & 7, jj = u >> 3, quarter = jj / (2 * nn), rem = jj - quarter * 2 * nn;
    pi = ((rem >> 1) + (x * nn) / 8) % nn;
    pm = 8 * x + 2 * quarter + (rem & 1);
  }
  else { pm = 64; pi = u - 64 * nn; }
}

__device__ __forceinline__ void phase_gemm_in(const Params& p, bool gates) {
  const int tid = opaque_tid();
  unsigned char* ws = p.ws;
  const bf16* Xb = (const bf16*)(ws + OFF_XB);
  const bf16* Wt = (const bf16*)(ws + OFF_WIN);
  const int nmt = gates ? 64 : NMT;
  const int ntile = (gates ? 8 : 15) * nmt;
  for (int t = blockIdx.x; t < ntile; t += gridDim.x) {
    int pi, pm;
    tile_xcd(t, gates ? 8 : 15, pm, pi);
    const int pn = gates ? (14 + pi) : (pi < 14 ? pi : 22);
    const int brow = pm * 256, bcol = pn * 256;
    Acc acc; acc_zero(acc);
    gemm_kloop(acc, Xb, 1024, Wt, 1024, 1024, brow, bcol, tid, true);
    if (pn < 6) epi_store_bf16_perm(acc, (bf16*)(ws + OFF_R2) + pn * 256, 1536, brow, tid);
    else if (pn < 14) epi_store_bf16_perm(acc, (bf16*)(ws + OFF_R3) + (pn - 6) * 256, 2048, brow, tid);
    else if (pn < 22) epi_store_bf16_perm(acc, (bf16*)(ws + OFF_R4) + (pn - 14) * 256, 2048, brow, tid);
    else {
      float* sm = (float*)(ws + OFF_R5);
      EPI_COORDS
      EPI_LOOP {
        if (bj == 0 && wc == 0) *reinterpret_cast<f32x4*>(sm + (size_t)EPI_ROW * 32 + 8 * fq + 4 * n) = acc[ai][bj][m][n];
      }
    }
  }
  if (gates) {
    __syncthreads();
    tail_gemm<0>(p, Xb, 1024, Wt + (size_t)14 * 256 * 1024, 1024, 1024, 2048, 0, tid);
  }
}

__device__ __forceinline__ void gdn_job(const Params& p, int l, int b, int h, int half, float* lds, const int tid) {
  unsigned char* ws = p.ws;
  const bf16* QS = (const bf16*)(ws + OFF_QS);
  const float* SM = (const float*)(ws + OFF_R5);
  bf16* O = (bf16*)(ws + OFF_R2);
  const int lane = tid & 63, cg = lane & 15, kq = lane >> 4;
  const int col = half * 64 + cg * 4;
  f32x4 S[32];
  const float* s0 = p.in[2] + (((size_t)l * NS + b) * 4 + h) * 128 * 128 + (size_t)(kq * 32) * 128 + col;
#pragma unroll
  for (int i = 0; i < 32; ++i) S[i] = *reinterpret_cast<const f32x4*>(s0 + (size_t)i * 128);
  const float eA = __expf(p.in[8][l * 4 + h]), dtb = p.in[9][l * 4 + h];
  float* lk = lds;
  float* lq = lds + 128;
  const size_t row = (size_t)MP + b;
  const u32 q2 = *reinterpret_cast<const u32*>(QS + (size_t)b * 1536 + h * 128 + lane * 2);
  const u32 k2 = *reinterpret_cast<const u32*>(QS + (size_t)b * 1536 + 512 + h * 128 + lane * 2);
  const u32x2 v2 = *reinterpret_cast<const u32x2*>(QS + (size_t)b * 1536 + 1024 + h * 128 + col);
  const f32x4 v = {bflo(v2.x), bfhi(v2.x), bflo(v2.y), bfhi(v2.y)};
  const float beta = sigmoidf_(SM[row * 32 + h]);
  const float g = -eA * softplusf_(SM[row * 32 + 4 + h] + dtb);
  const float eg = __expf(g);
  __builtin_amdgcn_wave_barrier();
  lq[lane * 2] = bflo(q2); lq[lane * 2 + 1] = bfhi(q2);
  lk[lane * 2] = bflo(k2); lk[lane * 2 + 1] = bfhi(k2);
  __builtin_amdgcn_wave_barrier();
  const float* lkq = lk + kq * 32;
  const float* lqq = lq + kq * 32;
  f32x4 ks = {0.f, 0.f, 0.f, 0.f};
#pragma unroll
  for (int i = 0; i < 32; i += 4) {
    const f32x4 kk = *reinterpret_cast<const f32x4*>(lkq + i);
    ks += S[i] * kk[0] + S[i + 1] * kk[1] + S[i + 2] * kk[2] + S[i + 3] * kk[3];
  }
#pragma unroll
  for (int c = 0; c < 4; ++c) { ks[c] += __shfl_xor(ks[c], 16); ks[c] += __shfl_xor(ks[c], 32); }
  const f32x4 u = (v - ks * eg) * beta;
  f32x4 o = {0.f, 0.f, 0.f, 0.f};
  float* so = p.out + OUT_GDNS + (((size_t)l * NS + b) * 4 + h) * 128 * 128 + (size_t)(kq * 32) * 128 + col;
#pragma unroll
  for (int i = 0; i < 32; i += 4) {
    const f32x4 kk = *reinterpret_cast<const f32x4*>(lkq + i);
    const f32x4 qq = *reinterpret_cast<const f32x4*>(lqq + i);
#pragma unroll
    for (int e = 0; e < 4; ++e) {
      const f32x4 sn = S[i + e] * eg + u * kk[e];
      o += sn * qq[e];
      *reinterpret_cast<f32x4*>(so + (size_t)(i + e) * 128) = sn;
    }
  }
#pragma unroll
  for (int c = 0; c < 4; ++c) { o[c] += __shfl_xor(o[c], 16); o[c] += __shfl_xor(o[c], 32); }
  if (kq == 0) {
    u32x2 ov; ov.x = pk2(o[0], o[1]); ov.y = pk2(o[2], o[3]);
    *reinterpret_cast<u32x2*>(O + row * 1024 + h * 128 + col) = ov;
  }
  __builtin_amdgcn_wave_barrier();
}

__device__ __forceinline__ void gla_job(const Params& p, int l, int b, int h, int half, bool smp, float* lds, const int tid) {
  unsigned char* ws = p.ws;
  const bf16* P2 = (const bf16*)(ws + OFF_R3);
  const float* SM = (const float*)(ws + OFF_R5);
  bf16* O = (bf16*)(ws + OFF_R2);
  const int lane = tid & 63, col = half * 64 + lane;
  float S[64];
  if (smp) {
    const float* s0 = p.in[3] + (((size_t)l * NS + b) * 4 + h) * 64 * 128 + col;
#pragma unroll
    for (int i = 0; i < 64; ++i) S[i] = s0[(size_t)i * 128];
  } else {
#pragma unroll
    for (int i = 0; i < 64; ++i) S[i] = 0.f;
  }
  float w2[16];
#pragma unroll
  for (int r = 0; r < 16; ++r) w2[r] = p.in[11][((size_t)l * 16 + r) * 256 + h * 64 + lane];
  const float gb = p.in[12][l * 256 + h * 64 + lane];
  const int T = smp ? 1 : LP, row0 = smp ? (MP + b) : b * LP;
  float* le = lds;
  float* lk = lds + 64;
  float* lq = lds + 128;
  for (int t = 0; t < T; ++t) {
    const size_t row = (size_t)(row0 + t);
    const float q = bf1(*reinterpret_cast<const u16*>(P2 + row * 2048 + 512 + h * 64 + lane)) * 0.125f;
    const float k = bf1(*reinterpret_cast<const u16*>(P2 + row * 2048 + 768 + h * 64 + lane));
    const float v = bf1(*reinterpret_cast<const u16*>(P2 + row * 2048 + 1024 + h * 128 + col));
    float x = gb;
#pragma unroll
    for (int r = 0; r < 16; ++r) x += SM[row * 32 + 8 + r] * w2[r];
    const float lg = -softplusf_(-x) * (1.f / 16.f);
    __builtin_amdgcn_wave_barrier();
    le[lane] = __expf(lg); lk[lane] = k; lq[lane] = q;
    __builtin_amdgcn_wave_barrier();
    float o = 0.f;
#pragma unroll
    for (int i = 0; i < 64; i += 4) {
      const f32x4 ee = *reinterpret_cast<const f32x4*>(le + i);
      const f32x4 kk = *reinterpret_cast<const f32x4*>(lk + i);
      const f32x4 qq = *reinterpret_cast<const f32x4*>(lq + i);
      S[i] = ee[0] * S[i] + kk[0] * v; S[i + 1] = ee[1] * S[i + 1] + kk[1] * v;
      S[i + 2] = ee[2] * S[i + 2] + kk[2] * v; S[i + 3] = ee[3] * S[i + 3] + kk[3] * v;
      o += S[i] * qq[0] + S[i + 1] * qq[1] + S[i + 2] * qq[2] + S[i + 3] * qq[3];
    }
    O[row * 1024 + 512 + h * 128 + col] = __float2bfloat16(o);
  }
  float* so = smp ? (p.out + OUT_GLAS + (((size_t)l * NS + b) * 4 + h) * 64 * 128 + col)
                  : (p.out + OUT_GLAP + (((size_t)l * NBATCH + b) * 4 + h) * 64 * 128 + col);
#pragma unroll
  for (int i = 0; i < 64; ++i) so[(size_t)i * 128] = S[i];
}

constexpr int NCH = 33;
constexpr int GDN_IMG = 73728, GLA_IMG = 25088;
constexpr size_t OFF_GDN_IMG = OFF_R4;
constexpr size_t OFF_GLA_IMG = OFF_R4 + (size_t)NBATCH * 4 * NCH * GDN_IMG;
constexpr size_t R4_IMG_END = OFF_GLA_IMG + (size_t)NBATCH * 4 * NCH * GLA_IMG;
static_assert(R4_IMG_END <= OFF_R5, "R4 too small for the images");

__device__ __forceinline__ bf16x8 lds_frag16(const LAS unsigned char* base) { return *reinterpret_cast<const LAS bf16x8*>(base); }
__device__ __forceinline__ bf16x8 mk_frag(u32 a, u32 b, u32 c, u32 d) {
  u32x4 v; v.x = a; v.y = b; v.z = c; v.w = d;
  return __builtin_bit_cast(bf16x8, v);
}
__device__ __forceinline__ bf16x8 frag_from_tiles(const f32x4 t0, const f32x4 t1) {
  return mk_frag(pk2(t0[0], t0[1]), pk2(t0[2], t0[3]), pk2(t1[0], t1[1]), pk2(t1[2], t1[3]));
}
#define MFMA16(a, b, c) __builtin_amdgcn_mfma_f32_16x16x32_bf16(a, b, c, 0, 0, 0)

__device__ __forceinline__ void conv8(const bf16* __restrict__ P1, const float* __restrict__ cw, size_t row, int t, int c0, bool valid,
                                      float* o, float* x3) {
#pragma unroll
  for (int e = 0; e < 8; ++e) o[e] = 0.f;
#pragma unroll
  for (int i = 0; i < 4; ++i) {
    float x[8];
    if (valid && (t - 3 + i >= 0)) unpack8(*reinterpret_cast<const u32x4*>(P1 + (row - 3 + i) * 1536 + c0), x);
    else {
#pragma unroll
      for (int e = 0; e < 8; ++e) x[e] = 0.f;
    }
    const f32x4 wa = *reinterpret_cast<const f32x4*>(cw + i * 1536 + c0), wb = *reinterpret_cast<const f32x4*>(cw + i * 1536 + c0 + 4);
    o[0] += wa[0] * x[0]; o[1] += wa[1] * x[1]; o[2] += wa[2] * x[2]; o[3] += wa[3] * x[3];
    o[4] += wb[0] * x[4]; o[5] += wb[1] * x[5]; o[6] += wb[2] * x[6]; o[7] += wb[3] * x[7];
    if (i == 3) {
#pragma unroll
      for (int e = 0; e < 8; ++e) x3[e] = x[e];
    }
  }
#pragma unroll
  for (int e = 0; e < 8; ++e) o[e] = o[e] * sigmoidf_(o[e]);
}

constexpr int LQ = 0, LK = 17408, LKT = 34816, LVT = 53248, LAM = 71680, LTW = 89088, LTU = 98304, LGM = 107520, LBT = 107776, LCW = 108032;
constexpr int QSTR = 272, TSTR = 144, ASTR = 68;

__device__ __forceinline__ void gdn_pre_item(const Params& p, int l, int b, int h, int c, const int tid_in) {
  int tid = tid_in;
  asm volatile("" : "+v"(tid));
  unsigned char* ws = p.ws;
  LAS unsigned char* lds = (LAS unsigned char*)smem_raw;
  asm volatile("" : "+v"(lds));
  const bf16* P1 = (const bf16*)(ws + OFF_R2);
  const float* SM = (const float*)(ws + OFF_R5);
  const float* cw = p.in[7] + (size_t)l * 4 * 1536;
  unsigned char* img = ws + OFF_GDN_IMG + (size_t)((b * 4 + h) * NCH + c) * GDN_IMG;
  const int wid = tid >> 6, lane = tid & 63, r = lane & 15, q = lane >> 4;
  const int tb = (c == 0) ? 0 : 16 + 64 * (c - 1), nvalid = (c == 0) ? 16 : 64;
  const size_t row0 = (size_t)b * LP + tb;
  float sm_a = 0.f, sm_b = 0.f;
  {
    const int j = tid >> 3, sub = tid & 7;
    const bool valid = j < nvalid;
    const int t = tb + j;
    const size_t row = row0 + j;
    LAS float* lcw = reinterpret_cast<LAS float*>(lds + LCW);
    float cwv[3];
#pragma unroll
    for (int u = 0; u < 3; ++u) {
      const int i = tid + u * NTHREADS, tap = i / 384, cc = i - tap * 384;
      cwv[u] = cw[tap * 1536 + (cc >> 7) * 512 + h * 128 + (cc & 127)];
    }
    if (wid == 0 && lane < nvalid) {
      sm_a = SM[(row0 + lane) * 32 + 4 + h];
      sm_b = SM[(row0 + lane) * 32 + h];
    }
    u32x4 raw[3][4][2];
#pragma unroll
    for (int mat = 0; mat < 3; ++mat)
#pragma unroll
      for (int i = 0; i < 4; ++i)
#pragma unroll
        for (int hf = 0; hf < 2; ++hf) {
          if (valid && (t - 3 + i >= 0)) raw[mat][i][hf] = *reinterpret_cast<const u32x4*>(P1 + (row - 3 + i) * 1536 + mat * 512 + h * 128 + sub * 16 + hf * 8);
          else raw[mat][i][hf] = u32x4{0u, 0u, 0u, 0u};
        }
#pragma unroll
    for (int u = 0; u < 3; ++u) lcw[tid + u * NTHREADS] = cwv[u];
    __syncthreads();
#pragma unroll
    for (int mat = 0; mat < 3; ++mat) {
      float o[16];
#pragma unroll
      for (int e = 0; e < 16; ++e) o[e] = 0.f;
#pragma unroll
      for (int i = 0; i < 4; ++i)
#pragma unroll
        for (int hf = 0; hf < 2; ++hf) {
          float x[8];
          unpack8(raw[mat][i][hf], x);
          const f32x4 wa = *reinterpret_cast<const LAS f32x4*>(lcw + i * 384 + mat * 128 + sub * 16 + hf * 8);
          const f32x4 wb = *reinterpret_cast<const LAS f32x4*>(lcw + i * 384 + mat * 128 + sub * 16 + hf * 8 + 4);
          float* oo = o + hf * 8;
          oo[0] += wa[0] * x[0]; oo[1] += wa[1] * x[1]; oo[2] += wa[2] * x[2]; oo[3] += wa[3] * x[3];
          oo[4] += wb[0] * x[4]; oo[5] += wb[1] * x[5]; oo[6] += wb[2] * x[6]; oo[7] += wb[3] * x[7];
        }
#pragma unroll
      for (int e = 0; e < 16; ++e) o[e] = o[e] * sigmoidf_(o[e]);
      if (mat < 2) {
        float ss = 0.f;
#pragma unroll
        for (int e = 0; e < 16; ++e) ss += o[e] * o[e];
        ss = sum8(ss);
        const float sc = rsqrtf(ss + 1e-6f) * (mat == 0 ? 0.08838834764831845f : 1.f);
#pragma unroll
        for (int e = 0; e < 16; ++e) o[e] *= sc;
      }
      if (mat < 2) {
        LAS unsigned char* ldst = lds + (mat == 0 ? LQ : LK) + j * QSTR + sub * 32;
        *reinterpret_cast<LAS u32x4*>(ldst) = pack8(o);
        *reinterpret_cast<LAS u32x4*>(ldst + 16) = pack8(o + 8);
      }
      if (mat >= 1) {
        LAS unsigned char* ldst = lds + (mat == 1 ? LKT : LVT) + (sub * 16) * TSTR + (j ^ (sub << 3)) * 2;
#pragma unroll
        for (int e = 0; e < 16; ++e) *reinterpret_cast<LAS u16*>(ldst + e * TSTR) = f2bf(o[e]);
      }
      if (c == NCH - 1 && j >= 61) {
        float* dst = p.out + OUT_CONVP + (((size_t)l * NBATCH + b) * 3 + (j - 61)) * 1536 + mat * 512 + h * 128 + sub * 16;
#pragma unroll
        for (int hf = 0; hf < 2; ++hf) {
          float x3[8];
          unpack8(raw[mat][3][hf], x3);
          *reinterpret_cast<f32x4*>(dst + hf * 8) = f32x4{x3[0], x3[1], x3[2], x3[3]};
          *reinterpret_cast<f32x4*>(dst + hf * 8 + 4) = f32x4{x3[4], x3[5], x3[6], x3[7]};
        }
      }
    }
  }
  if (wid == 0) {
    const bool valid = lane < nvalid;
    float g = 0.f, be = 0.f;
    if (valid) {
      const float eA = __expf(p.in[8][l * 4 + h]), dtb = p.in[9][l * 4 + h];
      g = -eA * softplusf_(sm_a + dtb);
      be = sigmoidf_(sm_b);
    }
#pragma unroll
    for (int o = 1; o < 64; o <<= 1) {
      const float y = __shfl_up(g, o);
      if (lane >= o) g += y;
    }
    reinterpret_cast<LAS float*>(lds + LGM)[lane] = g;
    reinterpret_cast<LAS float*>(lds + LBT)[lane] = be;
  }
  __syncthreads();
  const LAS float* gam = reinterpret_cast<const LAS float*>(lds + LGM);
  const LAS float* bet = reinterpret_cast<const LAS float*>(lds + LBT);
  {
#pragma unroll
    for (int u = 0; u < 2; ++u) {
      const int id = wid * 2 + u, it = id >> 2, jt = id & 3;
      f32x4 d = {0.f, 0.f, 0.f, 0.f};
#pragma unroll
      for (int ks = 0; ks < 4; ++ks) {
        const bf16x8 a = lds_frag16(lds + LK + (16 * it + r) * QSTR + (32 * ks + 8 * q) * 2);
        const bf16x8 bb = lds_frag16(lds + LK + (16 * jt + r) * QSTR + (32 * ks + 8 * q) * 2);
        d = MFMA16(a, bb, d);
      }
      const int jj = 16 * jt + r;
      const float gj = gam[jj];
#pragma unroll
      for (int e = 0; e < 4; ++e) {
        const int ii = 16 * it + 4 * q + e;
        const float v = (jj < ii) ? bet[ii] * __expf(fminf(gam[ii] - gj, 0.f)) * d[e] : 0.f;
        reinterpret_cast<LAS float*>(lds + LAM)[ii * ASTR + jj] = v;
      }
    }
    const int it = wid & 3, s = wid >> 2;
    f32x4 d2[2];
#pragma unroll
    for (int u = 0; u < 2; ++u) {
      const int jt = 2 * s + u;
      f32x4 d = {0.f, 0.f, 0.f, 0.f};
#pragma unroll
      for (int ks = 0; ks < 4; ++ks) {
        const bf16x8 a = lds_frag16(lds + LK + (16 * jt + r) * QSTR + (32 * ks + 8 * q) * 2);
        const bf16x8 bb = lds_frag16(lds + LQ + (16 * it + r) * QSTR + (32 * ks + 8 * q) * 2);
        d = MFMA16(a, bb, d);
      }
      const int ii = 16 * it + r;
      const float gi = gam[ii];
#pragma unroll
      for (int e = 0; e < 4; ++e) {
        const int jj = 16 * jt + 4 * q + e;
        d[e] = (jj <= ii) ? __expf(fminf(gi - gam[jj], 0.f)) * d[e] : 0.f;
      }
      d2[u] = d;
    }
    *reinterpret_cast<bf16x8*>(img + 32768 + (it * 2 + s) * 1024 + lane * 16) = frag_from_tiles(d2[0], d2[1]);
  }
  __syncthreads();
  if (wid == 0) {
    const LAS float* A = reinterpret_cast<const LAS float*>(lds + LAM);
    LAS unsigned char* PT = lds + LCW;
    LAS unsigned char* QR = lds + LCW + 2560;
    const int blk = lane >> 5, cc = lane & 31;
    float T[32];
    {
      const LAS float* Ab = A + (32 * blk) * ASTR + 32 * blk;
#pragma unroll
      for (int i = 0; i < 32; ++i) {
        float a0 = (i == cc) ? 1.f : 0.f, a1 = 0.f, a2 = 0.f, a3 = 0.f;
#pragma unroll
        for (int j4 = 0; j4 + 4 <= i; j4 += 4) {
          const f32x4 av = *reinterpret_cast<const LAS f32x4*>(Ab + i * ASTR + j4);
          a0 -= av[0] * T[j4]; a1 -= av[1] * T[j4 + 1]; a2 -= av[2] * T[j4 + 2]; a3 -= av[3] * T[j4 + 3];
        }
#pragma unroll
        for (int j = (i & ~3); j < i; ++j) a0 -= Ab[i * ASTR + j] * T[j];
        T[i] = (a0 + a1) + (a2 + a3);
        if ((i & 3) == 3) __builtin_amdgcn_sched_barrier(0);
      }
    }
    const float bj = bet[lane], bw = bj * __expf(gam[lane]);
    if (blk == 0) {
#pragma unroll
      for (int i8 = 0; i8 < 4; ++i8) *reinterpret_cast<LAS u32x4*>(PT + cc * 80 + i8 * 16) = pack8(T + 8 * i8);
    } else {
#pragma unroll
      for (int i = 0; i < 32; ++i) *reinterpret_cast<LAS u16*>(QR + i * 80 + cc * 2) = f2bf(T[i]);
    }
#pragma unroll
    for (int i = 0; i < 32; ++i) {
      *reinterpret_cast<LAS u16*>(lds + LTW + (32 * blk + i) * TSTR + lane * 2) = f2bf(T[i] * bw);
      *reinterpret_cast<LAS u16*>(lds + LTU + (32 * blk + i) * TSTR + lane * 2) = f2bf(T[i] * bj);
      if (blk == 1) {
        *reinterpret_cast<LAS u16*>(lds + LTW + i * TSTR + lane * 2) = (u16)0;
        *reinterpret_cast<LAS u16*>(lds + LTU + i * TSTR + lane * 2) = (u16)0;
      }
      if ((i & 7) == 7) __builtin_amdgcn_sched_barrier(0);
    }
    f32x4 M1[2][2];
#pragma unroll
    for (int it = 0; it < 2; ++it) {
      const LAS float* ar = A + (32 + 16 * it + r) * ASTR + 8 * q;
      const f32x4 x0 = *reinterpret_cast<const LAS f32x4*>(ar), x1 = *reinterpret_cast<const LAS f32x4*>(ar + 4);
      const bf16x8 af = mk_frag(pk2(x0[0], x0[1]), pk2(x0[2], x0[3]), pk2(x1[0], x1[1]), pk2(x1[2], x1[3]));
#pragma unroll
      for (int nt = 0; nt < 2; ++nt) {
        const bf16x8 bfq = lds_frag16(PT + (16 * nt + r) * 80 + q * 16);
        M1[it][nt] = MFMA16(af, bfq, (f32x4{0.f, 0.f, 0.f, 0.f}));
      }
    }
#pragma unroll
    for (int nt = 0; nt < 2; ++nt) {
      const bf16x8 mf = frag_from_tiles(M1[0][nt], M1[1][nt]);
      const int n = 16 * nt + r;
      const float bn = bet[n], bwn = bn * __expf(gam[n]);
#pragma unroll
      for (int it = 0; it < 2; ++it) {
        const u32x2 lo = *reinterpret_cast<const LAS u32x2*>(QR + (16 * it + r) * 80 + (4 * q) * 2);
        const u32x2 hi = *reinterpret_cast<const LAS u32x2*>(QR + (16 * it + r) * 80 + (16 + 4 * q) * 2);
        const f32x4 rr = MFMA16(mk_frag(lo.x, lo.y, hi.x, hi.y), mf, (f32x4{0.f, 0.f, 0.f, 0.f}));
#pragma unroll
        for (int e = 0; e < 4; ++e) {
          const int i = 32 + 16 * it + 4 * q + e;
          *reinterpret_cast<LAS u16*>(lds + LTW + i * TSTR + n * 2) = f2bf(-rr[e] * bwn);
          *reinterpret_cast<LAS u16*>(lds + LTU + i * TSTR + n * 2) = f2bf(-rr[e] * bn);
        }
      }
    }
    if (lane == 0) reinterpret_cast<float*>(ws + OFF_GT)[(b * 4 + h) * NCH + c] = __expf(gam[63]);
  } else {
    for (int f = wid - 1; f < 32; f += 7) {
      if (f < 16) {
        const int it = f >> 2, ks = f & 3, ii = 16 * it + r;
        const float sc = __expf(gam[ii]);
        const u32x2 lo = *reinterpret_cast<const LAS u32x2*>(lds + LQ + ii * QSTR + (32 * ks + 4 * q) * 2);
        const u32x2 hi = *reinterpret_cast<const LAS u32x2*>(lds + LQ + ii * QSTR + (32 * ks + 16 + 4 * q) * 2);
        const bf16x8 o = mk_frag(pk2(bflo(lo.x) * sc, bfhi(lo.x) * sc), pk2(bflo(lo.y) * sc, bfhi(lo.y) * sc),
                                 pk2(bflo(hi.x) * sc, bfhi(hi.x) * sc), pk2(bflo(hi.y) * sc, bfhi(hi.y) * sc));
        *reinterpret_cast<bf16x8*>(img + 16384 + f * 1024 + lane * 16) = o;
      } else {
        const int g2 = f - 16, kt = g2 >> 1, s = g2 & 1, kk = 16 * kt + r;
        const float gl = gam[63];
        const u32x2 lo = *reinterpret_cast<const LAS u32x2*>(lds + LKT + kk * TSTR + ((32 * s + 4 * q) ^ ((kt & 7) << 3)) * 2);
        const u32x2 hi = *reinterpret_cast<const LAS u32x2*>(lds + LKT + kk * TSTR + ((32 * s + 16 + 4 * q) ^ ((kt & 7) << 3)) * 2);
        const f32x4 g0 = *reinterpret_cast<const LAS f32x4*>(gam + 32 * s + 4 * q);
        const f32x4 g1 = *reinterpret_cast<const LAS f32x4*>(gam + 32 * s + 16 + 4 * q);
        const bf16x8 o = mk_frag(pk2(bflo(lo.x) * __expf(gl - g0[0]), bfhi(lo.x) * __expf(gl - g0[1])),
                                 pk2(bflo(lo.y) * __expf(gl - g0[2]), bfhi(lo.y) * __expf(gl - g0[3])),
                                 pk2(bflo(hi.x) * __expf(gl - g1[0]), bfhi(hi.x) * __expf(gl - g1[1])),
                                 pk2(bflo(hi.y) * __expf(gl - g1[2]), bfhi(hi.y) * __expf(gl - g1[3])));
        *reinterpret_cast<bf16x8*>(img + 40960 + g2 * 1024 + lane * 16) = o;
      }
    }
  }
  __syncthreads();
  {
    const int it = wid & 3;
#pragma unroll
    for (int u = 0; u < 2; ++u) {
      const int ks = (wid >> 2) + 2 * u;
      f32x4 d2[2];
#pragma unroll
      for (int v = 0; v < 2; ++v) {
        const int kt = 2 * ks + v;
        f32x4 d = {0.f, 0.f, 0.f, 0.f};
#pragma unroll
        for (int s = 0; s < 2; ++s) {
          const bf16x8 a = lds_frag16(lds + LKT + (16 * kt + r) * TSTR + ((32 * s + 8 * q) ^ ((kt & 7) << 3)) * 2);
          const bf16x8 bb = lds_frag16(lds + LTW + (16 * it + r) * TSTR + (32 * s + 8 * q) * 2);
          d = MFMA16(a, bb, d);
        }
        d2[v] = -d;
      }
      *reinterpret_cast<bf16x8*>(img + (it * 4 + ks) * 1024 + lane * 16) = frag_from_tiles(d2[0], d2[1]);
    }
    const int nt = wid;
#pragma unroll
    for (int it2 = 0; it2 < 4; ++it2) {
      f32x4 d = {0.f, 0.f, 0.f, 0.f};
#pragma unroll
      for (int s = 0; s < 2; ++s) {
        const bf16x8 a = lds_frag16(lds + LTU + (16 * it2 + r) * TSTR + (32 * s + 8 * q) * 2);
        const bf16x8 bb = lds_frag16(lds + LVT + (16 * nt + r) * TSTR + ((32 * s + 8 * q) ^ ((nt & 7) << 3)) * 2);
        d = MFMA16(a, bb, d);
      }
      u32x2 o; o.x = pk2(d[0], d[1]); o.y = pk2(d[2], d[3]);
      *reinterpret_cast<u32x2*>(img + 57344 + ((nt * 4 + it2) * 64 + lane) * 8) = o;
    }
  }
  __syncthreads();
}

constexpr int GQ = 0, GK = 9216, GKR = 18432, GCB = 27648, GW2 = 45056;
__device__ __forceinline__ void gla_pre_item(const Params& p, int l, int b, int h, int c, const int tid_in) {
  int tid = tid_in;
  asm volatile("" : "+v"(tid));
  unsigned char* ws = p.ws;
  LAS unsigned char* lds = (LAS unsigned char*)smem_raw;
  asm volatile("" : "+v"(lds));
  const bf16* P2 = (const bf16*)(ws + OFF_R3);
  const float* SM = (const float*)(ws + OFF_R5);
  unsigned char* img = ws + OFF_GLA_IMG + (size_t)((b * 4 + h) * NCH + c) * GLA_IMG;
  const int wid = tid >> 6, lane = tid & 63, r = lane & 15, q = lane >> 4;
  const int tb = (c == 0) ? 0 : 16 + 64 * (c - 1), nvalid = (c == 0) ? 16 : 64;
  const size_t row0 = (size_t)b * LP + tb;
  LAS float* cb = reinterpret_cast<LAS float*>(lds + GCB);
  LAS float* w2s = reinterpret_cast<LAS float*>(lds + GW2);
  LAS float* wtot = w2s + 1024;
  const int j = tid >> 3, sub = tid & 7;
  const bool valid = j < nvalid;
  f32x4 glr[4];
  {
    const float w2a = p.in[11][((size_t)l * 16 + (tid >> 6)) * 256 + h * 64 + (tid & 63)];
    const float w2b = p.in[11][((size_t)l * 16 + ((tid + NTHREADS) >> 6)) * 256 + h * 64 + (tid & 63)];
    const float* smr = SM + (row0 + (valid ? j : 0)) * 32 + 8;
#pragma unroll
    for (int u = 0; u < 4; ++u) glr[u] = *reinterpret_cast<const f32x4*>(smr + 4 * u);
    w2s[tid] = w2a; w2s[tid + NTHREADS] = w2b;
  }
  __syncthreads();
  float qv[8], kv[8], cbv[8];
  {
    float x[8];
#pragma unroll
    for (int e = 0; e < 8; ++e) x[e] = p.in[12][l * 256 + h * 64 + sub * 8 + e];
    if (valid) {
#pragma unroll
      for (int rr = 0; rr < 16; ++rr) {
        const float gl = glr[rr >> 2][rr & 3];
        const f32x4 wa = *reinterpret_cast<const LAS f32x4*>(w2s + rr * 64 + sub * 8), wb = *reinterpret_cast<const LAS f32x4*>(w2s + rr * 64 + sub * 8 + 4);
        x[0] += gl * wa[0]; x[1] += gl * wa[1]; x[2] += gl * wa[2]; x[3] += gl * wa[3];
        x[4] += gl * wb[0]; x[5] += gl * wb[1]; x[6] += gl * wb[2]; x[7] += gl * wb[3];
      }
    }
#pragma unroll
    for (int e = 0; e < 8; ++e) cbv[e] = valid ? -softplusf_(-x[e]) * (1.f / 16.f) : 0.f;
    if (valid) {
      unpack8(*reinterpret_cast<const u32x4*>(P2 + (row0 + j) * 2048 + 512 + h * 64 + sub * 8), qv);
      unpack8(*reinterpret_cast<const u32x4*>(P2 + (row0 + j) * 2048 + 768 + h * 64 + sub * 8), kv);
    } else {
#pragma unroll
      for (int e = 0; e < 8; ++e) { qv[e] = 0.f; kv[e] = 0.f; }
    }
    *reinterpret_cast<LAS u32x4*>(lds + GKR + j * TSTR + sub * 16) = pack8(kv);
#pragma unroll
    for (int o = 8; o < 64; o <<= 1) {
#pragma unroll
      for (int e = 0; e < 8; ++e) {
        const float y = __shfl_up(cbv[e], o);
        if (lane >= o) cbv[e] += y;
      }
    }
    if (lane >= 56) {
#pragma unroll
      for (int e = 0; e < 8; ++e) wtot[wid * 64 + sub * 8 + e] = cbv[e];
    }
  }
  __syncthreads();
  {
    float tot[8];
#pragma unroll
    for (int e = 0; e < 8; ++e) tot[e] = 0.f;
#pragma unroll
    for (int w = 0; w < 8; ++w) {
      const f32x4 ta = *reinterpret_cast<const LAS f32x4*>(wtot + w * 64 + sub * 8), tb4 = *reinterpret_cast<const LAS f32x4*>(wtot + w * 64 + sub * 8 + 4);
      if (w < wid) {
        cbv[0] += ta[0]; cbv[1] += ta[1]; cbv[2] += ta[2]; cbv[3] += ta[3];
        cbv[4] += tb4[0]; cbv[5] += tb4[1]; cbv[6] += tb4[2]; cbv[7] += tb4[3];
      }
      tot[0] += ta[0]; tot[1] += ta[1]; tot[2] += ta[2]; tot[3] += ta[3];
      tot[4] += tb4[0]; tot[5] += tb4[1]; tot[6] += tb4[2]; tot[7] += tb4[3];
    }
#pragma unroll
    for (int e = 0; e < 8; ++e) cb[j * ASTR + sub * 8 + e] = cbv[e];
    if (j == 63) {
#pragma unroll
      for (int e = 0; e < 8; ++e) reinterpret_cast<float*>(img + 24576)[sub * 8 + e] = __expf(tot[e]);
    }
    float qo[8], ko[8];
#pragma unroll
    for (int e = 0; e < 8; ++e) {
      const float cv = cbv[e];
      qo[e] = qv[e] * 0.125f * __expf(cv);
      ko[e] = kv[e] * __expf(-cv);
    }
    *reinterpret_cast<LAS u32x4*>(lds + GQ + j * TSTR + sub * 16) = pack8(qo);
    *reinterpret_cast<LAS u32x4*>(lds + GK + j * TSTR + sub * 16) = pack8(ko);
  }
  __syncthreads();
  {
    {
      const int it = wid >> 1, ks = wid & 1, ii = 16 * it + r;
      const u32x2 lo = *reinterpret_cast<const LAS u32x2*>(lds + GQ + ii * TSTR + (32 * ks + 4 * q) * 2);
      const u32x2 hi = *reinterpret_cast<const LAS u32x2*>(lds + GQ + ii * TSTR + (32 * ks + 16 + 4 * q) * 2);
      *reinterpret_cast<bf16x8*>(img + wid * 1024 + lane * 16) = mk_frag(lo.x, lo.y, hi.x, hi.y);
    }
    {
      const int kt = wid >> 1, s = wid & 1, dk = 16 * kt + r;
      const float cl = cb[63 * ASTR + dk];
      float o[8];
#pragma unroll
      for (int e = 0; e < 8; ++e) {
        const int jj = 32 * s + (e < 4 ? 4 * q + e : 16 + 4 * q + (e - 4));
        const float kr = bf1(*reinterpret_cast<const LAS u16*>(lds + GKR + jj * TSTR + dk * 2));
        o[e] = kr * __expf(cl - cb[jj * ASTR + dk]);
      }
      *reinterpret_cast<bf16x8*>(img + 16384 + wid * 1024 + lane * 16) = mk_frag(pk2(o[0], o[1]), pk2(o[2], o[3]), pk2(o[4], o[5]), pk2(o[6], o[7]));
    }
    {
      const int it = wid & 3, s = wid >> 2;
      f32x4 d2[2];
#pragma unroll
      for (int u = 0; u < 2; ++u) {
        const int jt = 2 * s + u;
        f32x4 d = {0.f, 0.f, 0.f, 0.f};
#pragma unroll
        for (int ks = 0; ks < 2; ++ks) {
          const bf16x8 a = lds_frag16(lds + GK + (16 * jt + r) * TSTR + (32 * ks + 8 * q) * 2);
          const bf16x8 bb = lds_frag16(lds + GQ + (16 * it + r) * TSTR + (32 * ks + 8 * q) * 2);
          d = MFMA16(a, bb, d);
        }
        const int ii = 16 * it + r;
#pragma unroll
        for (int e = 0; e < 4; ++e) {
          const int jj = 16 * jt + 4 * q + e;
          d[e] = (jj <= ii) ? d[e] : 0.f;
        }
        d2[u] = d;
      }
      *reinterpret_cast<bf16x8*>(img + 8192 + (it * 2 + s) * 1024 + lane * 16) = frag_from_tiles(d2[0], d2[1]);
    }
  }
  __syncthreads();
}

__device__ __forceinline__ void sample_conv(const Params& p, int l, const int tid) {
  unsigned char* ws = p.ws;
  const bf16* P1 = (const bf16*)(ws + OFF_R2);
  bf16* QS = (bf16*)(ws + OFF_QS);
  const float* cw = p.in[7] + (size_t)l * 4 * 1536;
  const int wid = tid >> 6, lane = tid & 63;
  const int wg0 = (gridDim.x == 256) ? 128 : 0;
  if ((int)blockIdx.x < wg0) return;
  const int gw = ((int)blockIdx.x - wg0) * NWAVES + wid, NGW = ((int)gridDim.x - wg0) * NWAVES;
  for (int b = gw; b < NS; b += NGW) {
    const size_t row = (size_t)MP + b;
#pragma unroll
    for (int j = 0; j < 3; ++j) {
      const int c0 = j * 512 + lane * 8;
      float x[4][8];
      unpack8(*reinterpret_cast<const u32x4*>(P1 + row * 1536 + c0), x[3]);
#pragma unroll
      for (int i = 0; i < 3; ++i) {
        const float* sp = p.in[4] + (((size_t)l * NS + b) * 3 + i) * 1536 + c0;
        const f32x4 a = *reinterpret_cast<const f32x4*>(sp), cc = *reinterpret_cast<const f32x4*>(sp + 4);
        x[i][0] = a[0]; x[i][1] = a[1]; x[i][2] = a[2]; x[i][3] = a[3];
        x[i][4] = cc[0]; x[i][5] = cc[1]; x[i][6] = cc[2]; x[i][7] = cc[3];
      }
      float o[8];
#pragma unroll
      for (int e = 0; e < 8; ++e) o[e] = 0.f;
#pragma unroll
      for (int i = 0; i < 4; ++i) {
        const f32x4 wa = *reinterpret_cast<const f32x4*>(cw + i * 1536 + c0), wb = *reinterpret_cast<const f32x4*>(cw + i * 1536 + c0 + 4);
        o[0] += wa[0] * x[i][0]; o[1] += wa[1] * x[i][1]; o[2] += wa[2] * x[i][2]; o[3] += wa[3] * x[i][3];
        o[4] += wb[0] * x[i][4]; o[5] += wb[1] * x[i][5]; o[6] += wb[2] * x[i][6]; o[7] += wb[3] * x[i][7];
      }
      float ss = 0.f;
#pragma unroll
      for (int e = 0; e < 8; ++e) { o[e] = o[e] * sigmoidf_(o[e]); ss += o[e] * o[e]; }
      if (j < 2) {
        ss = sum16(ss);
        const float sc = rsqrtf(ss + 1e-6f) * (j == 0 ? 0.08838834764831845f : 1.f);
#pragma unroll
        for (int e = 0; e < 8; ++e) o[e] *= sc;
      }
      *reinterpret_cast<u32x4*>(QS + (size_t)b * 1536 + c0) = pack8(o);
#pragma unroll
      for (int i = 0; i < 3; ++i) {
        float* dst = p.out + OUT_CONVS + (((size_t)l * NS + b) * 3 + i) * 1536 + c0;
        *reinterpret_cast<f32x4*>(dst) = f32x4{x[i + 1][0], x[i + 1][1], x[i + 1][2], x[i + 1][3]};
        *reinterpret_cast<f32x4*>(dst + 4) = f32x4{x[i + 1][4], x[i + 1][5], x[i + 1][6], x[i + 1][7]};
      }
    }
  }
}

__device__ __forceinline__ void phase_pre(const Params& p, int l) {
  const int tid = opaque_tid();
  sample_conv(p, l, tid);
  constexpr int NCHH = NBATCH * 4 * NCH;
  for (int it = blockIdx.x; it < NCHH; it += gridDim.x) {
    const int c = it % NCH, bh = it / NCH;
    gdn_pre_item(p, l, bh >> 2, bh & 3, c, tid);
  }
  if (gridDim.x == 256) {
    const int w = blockIdx.x;
    int first, count, stride;
    if (w < 32) { first = 896 + w; count = 3; stride = 32; }
    else { first = w - 32; count = 4; stride = 224; }
    for (int k = 0; k < count; ++k) {
      const int x = first + k * stride;
      gla_pre_item(p, l, (x / NCH) >> 2, (x / NCH) & 3, x % NCH, tid);
    }
    if (w >= 32 && w < 96) {
      const int x = 992 + (w - 32);
      gla_pre_item(p, l, (x / NCH) >> 2, (x / NCH) & 3, x % NCH, tid);
    }
  } else {
    for (int x = blockIdx.x; x < NCHH; x += gridDim.x) gla_pre_item(p, l, (x / NCH) >> 2, (x / NCH) & 3, x % NCH, tid);
  }
}

__device__ __forceinline__ void img_load(const unsigned char* img, int bytes, int ldsoff, const int tid) {
  LAS unsigned char* lds = (LAS unsigned char*)smem_raw;
  const int wid = __builtin_amdgcn_readfirstlane(tid >> 6), lane = tid & 63;
  for (int k = 0; k * 8192 < bytes; ++k)
    __builtin_amdgcn_global_load_lds((const unsigned*)(img + k * 8192 + wid * 1024 + lane * 16),
                                     (LAS unsigned*)(lds + ldsoff + k * 8192 + wid * 1024), 16, 0, 0);
}

__device__ __forceinline__ void gdn_scan(const Params& p, int l, int b, int h, const int tid) {
  unsigned char* ws = p.ws;
  const LAS unsigned char* lds = (const LAS unsigned char*)smem_raw;
  asm volatile("" : "+v"(lds));
  bf16* O = (bf16*)(ws + OFF_R2);
  const int wid = tid >> 6, lane = tid & 63, r = lane & 15, q = lane >> 4;
  const int n = 16 * wid + r;
  const unsigned char* img0 = ws + OFF_GDN_IMG + (size_t)((b * 4 + h) * NCH) * GDN_IMG;
  const float* GT = reinterpret_cast<const float*>(ws + OFF_GT) + (b * 4 + h) * NCH;
  f32x4 S[8];
#pragma unroll
  for (int k = 0; k < 8; ++k) S[k] = f32x4{0.f, 0.f, 0.f, 0.f};
  constexpr int BUF = 57344;
  img_load(img0, BUF, 0, tid);
  u32x2 u0n[4];
#pragma unroll
  for (int it = 0; it < 4; ++it) u0n[it] = *reinterpret_cast<const u32x2*>(img0 + 57344 + ((wid * 4 + it) * 64 + lane) * 8);
  const float* gtp = GT + (lane & 0);
  asm volatile("" : "+v"(gtp));
  asm volatile("s_waitcnt vmcnt(0)" ::: "memory");
  __syncthreads();
#pragma unroll 1
  for (int c = 0; c < NCH; ++c) {
    const unsigned char* img = img0 + (size_t)c * GDN_IMG;
    const float gt = gtp[c];
    f32x4 U[4], Oc[4];
#pragma unroll
    for (int it = 0; it < 4; ++it) {
      U[it] = f32x4{bflo(u0n[it].x), bfhi(u0n[it].x), bflo(u0n[it].y), bfhi(u0n[it].y)};
      Oc[it] = f32x4{0.f, 0.f, 0.f, 0.f};
    }
    if (c + 1 < NCH) {
      img_load(img + GDN_IMG, BUF, ((c + 1) & 1) * BUF, tid);
#pragma unroll
      for (int it = 0; it < 4; ++it) u0n[it] = *reinterpret_cast<const u32x2*>(img + GDN_IMG + 57344 + ((wid * 4 + it) * 64 + lane) * 8);
    }
    const LAS unsigned char* buf = lds + (c & 1) * BUF;
    bf16x8 Sf[4];
    Sf[0] = frag_from_tiles(S[0], S[1]);
    Sf[1] = frag_from_tiles(S[2], S[3]);
#define SB __builtin_amdgcn_sched_barrier(0)
#define LW(F, ks) _Pragma("unroll") for (int it = 0; it < 4; ++it) F[it] = lds_frag16(buf + (it * 4 + (ks)) * 1024 + lane * 16);
#define LQ(F, ks) _Pragma("unroll") for (int it = 0; it < 4; ++it) F[it] = lds_frag16(buf + 16384 + (it * 4 + (ks)) * 1024 + lane * 16);
#define LK(F, g) _Pragma("unroll") for (int i = 0; i < 4; ++i) F[i] = lds_frag16(buf + 32768 + ((g) * 4 + i) * 1024 + lane * 16);
#define LD(F, g) _Pragma("unroll") for (int i = 0; i < 4; ++i) F[i] = lds_frag16(buf + 40960 + ((g) * 4 + i) * 1024 + lane * 16);
#define MW(F, ks) _Pragma("unroll") for (int it = 0; it < 4; ++it) U[it] = MFMA16(F[it], Sf[ks], U[it]);
#define MQ(F, ks) _Pragma("unroll") for (int it = 0; it < 4; ++it) Oc[it] = MFMA16(F[it], Sf[ks], Oc[it]);
#define MK(F, g) _Pragma("unroll") for (int i = 0; i < 4; ++i) Oc[(g) * 2 + (i >> 1)] = MFMA16(F[i], Uf[i & 1], Oc[(g) * 2 + (i >> 1)]);
#define MD(F, g) _Pragma("unroll") for (int i = 0; i < 4; ++i) {                                   \
      if ((i & 1) == 0) S[(g) * 2 + (i >> 1)] = S[(g) * 2 + (i >> 1)] * gt;                        \
      S[(g) * 2 + (i >> 1)] = MFMA16(F[i], Uf[i & 1], S[(g) * 2 + (i >> 1)]); }
    bf16x8 f0[4], f1[4];
    LW(f0, 0) LQ(f1, 0) SB;
    MW(f0, 0) LW(f0, 1) SB;
    Sf[2] = frag_from_tiles(S[4], S[5]);
    Sf[3] = frag_from_tiles(S[6], S[7]);
    MQ(f1, 0) LQ(f1, 1) SB;
    MW(f0, 1) LW(f0, 2) SB;
    MQ(f1, 1) LQ(f1, 2) SB;
    MW(f0, 2) LW(f0, 3) SB;
    MQ(f1, 2) LQ(f1, 3) SB;
    MW(f0, 3) LK(f0, 0) SB;
    MQ(f1, 3) LK(f1, 1) SB;
    bf16x8 Uf[2];
    Uf[0] = frag_from_tiles(U[0], U[1]);
    Uf[1] = frag_from_tiles(U[2], U[3]);
    MK(f0, 0) LD(f0, 0) SB;
    MK(f1, 1) LD(f1, 1) SB;
    MD(f0, 0) LD(f0, 2) SB;
    MD(f1, 1) LD(f1, 3) SB;
    MD(f0, 2) MD(f1, 3)
#undef LW
#undef LQ
#undef LK
#undef LD
#undef MW
#undef MQ
#undef MK
#undef MD
    {
      const int tbc = (c == 0) ? 0 : 16 + 64 * (c - 1), nvc = (c == 0) ? 16 : 64;
      bf16* ob = O + ((size_t)b * LP + tbc + 4 * q) * 1024 + h * 128 + n;
      asm volatile("" : "+v"(ob));
#pragma unroll
      for (int it = 0; it < 4; ++it)
#pragma unroll
        for (int e = 0; e < 4; ++e) {
          const int i = 16 * it + 4 * q + e;
          if (i < nvc) *reinterpret_cast<u16*>(ob + (16 * it + e) * 1024) = f2bf(Oc[it][e]);
        }
    }
    asm volatile("s_waitcnt vmcnt(0)" ::: "memory");
    __syncthreads();
  }
  float* so = p.out + OUT_GDNP + (((size_t)l * NBATCH + b) * 4 + h) * 128 * 128 + n;
#pragma unroll
  for (int kt = 0; kt < 8; ++kt)
#pragma unroll
    for (int e = 0; e < 4; ++e) so[(size_t)(16 * kt + 4 * q + e) * 128] = S[kt][e];
}

__device__ __forceinline__ void gla_vload(const bf16* __restrict__ P2, size_t row0, int nvalid, int h, int n, int q, bf16x8* Vf) {
#pragma unroll
  for (int s = 0; s < 2; ++s) {
    u16 v[8];
#pragma unroll
    for (int e = 0; e < 8; ++e) {
      const int jj = 32 * s + (e < 4 ? 4 * q + e : 16 + 4 * q + (e - 4));
      v[e] = (jj < nvalid) ? *reinterpret_cast<const u16*>(P2 + (row0 + jj) * 2048 + 1024 + h * 128 + n) : (u16)0;
    }
    Vf[s] = mk_frag((u32)v[0] | ((u32)v[1] << 16), (u32)v[2] | ((u32)v[3] << 16), (u32)v[4] | ((u32)v[5] << 16), (u32)v[6] | ((u32)v[7] << 16));
  }
}
__device__ __forceinline__ void gla_scan(const Params& p, int l, int b, int h, const int tid) {
  unsigned char* ws = p.ws;
  const LAS unsigned char* lds = (const LAS unsigned char*)smem_raw;
  asm volatile("" : "+v"(lds));
  const bf16* P2 = (const bf16*)(ws + OFF_R3);
  bf16* O = (bf16*)(ws + OFF_R2);
  const int wid = tid >> 6, lane = tid & 63, r = lane & 15, q = lane >> 4;
  const int n = 16 * wid + r;
  const unsigned char* img0 = ws + OFF_GLA_IMG + (size_t)((b * 4 + h) * NCH) * GLA_IMG;
  f32x4 S[4];
#pragma unroll
  for (int k = 0; k < 4; ++k) S[k] = f32x4{0.f, 0.f, 0.f, 0.f};
  constexpr int BUF = 24576;
  img_load(img0, BUF, 0, tid);
  bf16x8 Vn[2];
  f32x4 atn[4];
  gla_vload(P2, (size_t)b * LP, 16, h, n, q, Vn);
#pragma unroll
  for (int kt = 0; kt < 4; ++kt) atn[kt] = *reinterpret_cast<const f32x4*>(img0 + 24576 + (16 * kt + 4 * q) * 4);
  u32x2 opk[4];
#pragma unroll
  for (int it = 0; it < 4; ++it) opk[it] = u32x2{0u, 0u};
  asm volatile("s_waitcnt vmcnt(0)" ::: "memory");
  __syncthreads();
#pragma unroll 1
  for (int c = 0; c < NCH; ++c) {
    const unsigned char* img = img0 + (size_t)c * GLA_IMG;
    bf16x8 Vf[2];
    f32x4 at[4];
    Vf[0] = Vn[0]; Vf[1] = Vn[1];
#pragma unroll
    for (int kt = 0; kt < 4; ++kt) at[kt] = atn[kt];
    if (c + 1 < NCH) {
      img_load(img + GLA_IMG, BUF, ((c + 1) & 1) * BUF, tid);
      gla_vload(P2, (size_t)b * LP + 16 + 64 * c, 64, h, n, q, Vn);
#pragma unroll
      for (int kt = 0; kt < 4; ++kt) atn[kt] = *reinterpret_cast<const f32x4*>(img + GLA_IMG + 24576 + (16 * kt + 4 * q) * 4);
    }
    if (c > 0) {
      const int tbp = (c == 1) ? 0 : 16 + 64 * (c - 2), nvp = (c == 1) ? 16 : 64;
      const size_t rowp = (size_t)b * LP + tbp;
#pragma unroll
      for (int it = 0; it < 4; ++it)
#pragma unroll
        for (int e = 0; e < 4; ++e) {
          const int i = 16 * it + 4 * q + e;
          const u32 w = (e < 2) ? opk[it].x : opk[it].y;
          if (i < nvp) *reinterpret_cast<u16*>(O + (rowp + i) * 1024 + 512 + h * 128 + n) = (u16)((e & 1) ? (w >> 16) : (w & 0xffffu));
        }
    }
    const LAS unsigned char* buf = lds + (c & 1) * BUF;
    bf16x8 Sf[2];
    Sf[0] = frag_from_tiles(S[0], S[1]);
    Sf[1] = frag_from_tiles(S[2], S[3]);
#pragma unroll
    for (int it = 0; it < 4; ++it) {
      f32x4 o = {0.f, 0.f, 0.f, 0.f};
#pragma unroll
      for (int ks = 0; ks < 2; ++ks) o = MFMA16(lds_frag16(buf + (it * 2 + ks) * 1024 + lane * 16), Sf[ks], o);
#pragma unroll
      for (int s = 0; s < 2; ++s) o = MFMA16(lds_frag16(buf + 8192 + (it * 2 + s) * 1024 + lane * 16), Vf[s], o);
      opk[it].x = pk2(o[0], o[1]); opk[it].y = pk2(o[2], o[3]);
    }
    __builtin_amdgcn_sched_barrier(0);
#pragma unroll
    for (int kt = 0; kt < 4; ++kt) {
      f32x4 sv = S[kt] * at[kt];
#pragma unroll
      for (int s = 0; s < 2; ++s) sv = MFMA16(lds_frag16(buf + 16384 + (kt * 2 + s) * 1024 + lane * 16), Vf[s], sv);
      S[kt] = sv;
    }
    asm volatile("s_waitcnt vmcnt(0)" ::: "memory");
    __syncthreads();
  }
  {
    const int tbp = 16 + 64 * (NCH - 2);
    const size_t rowp = (size_t)b * LP + tbp;
#pragma unroll
    for (int it = 0; it < 4; ++it)
#pragma unroll
      for (int e = 0; e < 4; ++e) {
        const int i = 16 * it + 4 * q + e;
        const u32 w = (e < 2) ? opk[it].x : opk[it].y;
        *reinterpret_cast<u16*>(O + (rowp + i) * 1024 + 512 + h * 128 + n) = (u16)((e & 1) ? (w >> 16) : (w & 0xffffu));
      }
  }
  float* so = p.out + OUT_GLAP + (((size_t)l * NBATCH + b) * 4 + h) * 64 * 128 + n;
#pragma unroll
  for (int kt = 0; kt < 4; ++kt)
#pragma unroll
    for (int e = 0; e < 4; ++e) so[(size_t)(16 * kt + 4 * q + e) * 128] = S[kt][e];
}

__device__ __forceinline__ void phase_scan(const Params& p, int l) {
  const int tid = opaque_tid();
  const int wid = tid >> 6;
  for (int j = blockIdx.x; j < 64; j += gridDim.x) {
    if (j < 32) gdn_scan(p, l, j >> 2, j & 3, tid);
    else gla_scan(p, l, (j - 32) >> 2, j & 3, tid);
  }
  const int nsw = gridDim.x > 64 ? (int)gridDim.x - 64 : (int)gridDim.x;
  const int myw = gridDim.x > 64 ? (int)blockIdx.x - 64 : (int)blockIdx.x;
  if (myw >= 0) {
    float* lds = (float*)(smem_raw + wid * 2048);
    for (int s = myw * NWAVES + wid; s < 2048; s += nsw * NWAVES) {
      const int j = s & 1023;
      if (s < 1024) gdn_job(p, l, j >> 3, (j >> 1) & 3, j & 1, lds, tid);
      else gla_job(p, l, j >> 3, (j >> 1) & 3, j & 1, true, lds, tid);
    }
  }
}

__device__ __forceinline__ void phase_gnorm(const Params& p, int l) {
  const int tid = opaque_tid();
  unsigned char* ws = p.ws;
  const bf16* P2 = (const bf16*)(ws + OFF_R3);
  bf16* O = (bf16*)(ws + OFF_R2);
  const int wid = tid >> 6, lane = tid & 63;
  const int gw = blockIdx.x * NWAVES + wid, NGW = gridDim.x * NWAVES;
  const int cw = (lane & 15) * 8;
  float wA[8], wB[8];
#pragma unroll
  for (int e = 0; e < 8; ++e) { wA[e] = p.in[10][l * 128 + cw + e]; wB[e] = p.in[13][l * 128 + cw + e]; }
  for (int row = gw; row < MT; row += NGW) {
#pragma unroll
    for (int j = 0; j < 2; ++j) {
      const int c0 = j * 512 + lane * 8;
      float o[8], z[8];
      unpack8(*reinterpret_cast<const u32x4*>(O + (size_t)row * 1024 + c0), o);
      unpack8(*reinterpret_cast<const u32x4*>(P2 + (size_t)row * 2048 + (j == 0 ? 0 : 1536) + lane * 8), z);
      float ss = 0.f;
#pragma unroll
      for (int e = 0; e < 8; ++e) ss += o[e] * o[e];
      ss = sum16(ss);
      const float sc = rsqrtf(ss * (1.f / 128.f) + 1e-6f);
#pragma unroll
      for (int e = 0; e < 8; ++e) o[e] = o[e] * sc * (j == 0 ? wA[e] : wB[e]) * (z[e] * sigmoidf_(z[e]));
      *reinterpret_cast<u32x4*>(O + (size_t)row * 1024 + c0) = pack8(o);
    }
  }
}

__device__ __forceinline__ void phase_merge(const Params& p) {
  const int tid = opaque_tid();
  unsigned char* ws = p.ws;
  const bf16* O = (const bf16*)(ws + OFF_R2);
  const bf16* P3 = (const bf16*)(ws + OFF_R4);
  bf16* MG = (bf16*)(ws + OFF_R3);
  for (int u = 0;; ++u) {
    const int t = blockIdx.x + (u >> 1) * gridDim.x, br = u & 1;
    if (t >= 4 * 64) break;
    const int pn = t / 64, pm = t % 64, brow = pm * 256, bcol = pn * 256;
    {
      Acc acc; acc_zero(acc);
      gemm_kloop(acc, O + br * 512, 1024, (const bf16*)(ws + (br ? OFF_WB : OFF_WA)), 512, 512, brow, bcol, tid, true);
      int brow_e = brow;
      asm volatile("" : "+s"(brow_e));
      EPI_COORDS
#pragma unroll
      for (int ai = 0; ai < 2; ++ai)
#pragma unroll
        for (int bj = 0; bj < 2; ++bj)
#pragma unroll
          for (int m = 0; m < 4; ++m) {
            const int erow = brow_e + ai * 128 + wr * 64 + m * 16 + fr;
            const int ecol = bcol + bj * 128 + wc * 32 + 8 * fq;
            float g[8], r[8];
            unpack8(*reinterpret_cast<const u32x4*>(P3 + (size_t)erow * 2048 + br * 1024 + ecol), g);
            bf16* mp = MG + (size_t)erow * 1024 + ecol;
            const f32x4 v0 = acc[ai][bj][m][0], v1 = acc[ai][bj][m][1];
#pragma unroll
            for (int j = 0; j < 4; ++j) { r[j] = v0[j] * sigmoidf_(g[j]); r[4 + j] = v1[j] * sigmoidf_(g[4 + j]); }
            if (br) {
              float pv[8];
              unpack8(*reinterpret_cast<const u32x4*>(mp), pv);
#pragma unroll
              for (int j = 0; j < 8; ++j) r[j] += pv[j];
            }
            *reinterpret_cast<u32x4*>(mp) = pack8(r);
            __builtin_amdgcn_sched_barrier(0);
          }
    }
  }
  __syncthreads();
  tail_gemm<1>(p, O, 1024, (const bf16*)(ws + OFF_WA), 512, 512, 1024, 0, tid);
  tail_gemm<1>(p, O + 512, 1024, (const bf16*)(ws + OFF_WB), 512, 512, 1024, 1, tid);
}

__device__ __forceinline__ void phase_gemm_resid(const Params& p, const bf16* A, int lda, const bf16* Wt, int K) {
  const int tid = opaque_tid();
  unsigned char* ws = p.ws;
  const bf16* Xb = (const bf16*)(ws + OFF_XB);
  bf16* PL = (bf16*)(ws + OFF_R4);
  for (int t = blockIdx.x; t < 4 * 64; t += gridDim.x) {
    const int pn = t / 64, pm = t % 64, brow = pm * 256, bcol = pn * 256;
    Acc acc; acc_zero(acc);
    gemm_kloop(acc, A, lda, Wt, K, K, brow, bcol, tid, true);
    EPI_COORDS
#pragma unroll
    for (int ai = 0; ai < 2; ++ai)
#pragma unroll
      for (int bj = 0; bj < 2; ++bj)
#pragma unroll
        for (int m = 0; m < 4; ++m) {
          const size_t off = (size_t)(brow + ai * 128 + wr * 64 + m * 16 + fr) * 1024 + bcol + bj * 128 + wc * 32 + 8 * fq;
          float x[8], r[8];
          unpack8(*reinterpret_cast<const u32x4*>(Xb + off), x);
          const f32x4 v0 = acc[ai][bj][m][0], v1 = acc[ai][bj][m][1];
#pragma unroll
          for (int j = 0; j < 4; ++j) { r[j] = v0[j] + ALPHA * x[j]; r[4 + j] = v1[j] + ALPHA * x[4 + j]; }
          *reinterpret_cast<u32x4*>(PL + off) = pack8(r);
        }
  }
  __syncthreads();
  tail_gemm<2>(p, A, lda, Wt, K, K, 1024, 0, tid);
}

__device__ __forceinline__ void phase_ffn_in(const Params& p) {
  const int tid = opaque_tid();
  unsigned char* ws = p.ws;
  const bf16* Xb = (const bf16*)(ws + OFF_XB);
  bf16* H = (bf16*)(ws + OFF_R2);
  for (int t = blockIdx.x; t < 22 * NMT; t += gridDim.x) {
    int pn, pm;
    tile_xcd(t, 22, pm, pn);
    const int brow = pm * 256, bcol = pn * 256;
    Acc acc; acc_zero(acc);
    gemm_kloop(acc, Xb, 1024, (const bf16*)(ws + OFF_WFI), 1024, 1024, brow, bcol, tid);
    EPI_COORDS
#pragma unroll
    for (int ai = 0; ai < 2; ++ai)
#pragma unroll
      for (int m = 0; m < 4; ++m) {
        float r[8];
#pragma unroll
        for (int bj = 0; bj < 2; ++bj) {
          const f32x4 a = acc[ai][bj][m][0], u = acc[ai][bj][m][1];
#pragma unroll
          for (int j = 0; j < 4; ++j) r[bj * 4 + j] = a[j] * sigmoidf_(a[j]) * u[j];
        }
        const int hc = (bcol >> 1) + wc * 32 + fq * 8;
        *reinterpret_cast<u32x4*>(H + (size_t)(brow + ai * 128 + wr * 64 + m * 16 + fr) * DFF + hc) = pack8(r);
      }
  }
}

__device__ __forceinline__ void phase_ln(const Params& p, const float* g, const float* bta, bool final_out) {
  const int tid = opaque_tid();
  unsigned char* ws = p.ws;
  const bf16* PL = (const bf16*)(ws + OFF_R4);
  bf16* Xb = (bf16*)(ws + OFF_XB);
  const int wid = tid >> 6, lane = tid & 63;
  const int gw = blockIdx.x * NWAVES + wid, NGW = gridDim.x * NWAVES;
  float gg[2][8], bb[2][8];
#pragma unroll
  for (int j = 0; j < 2; ++j)
#pragma unroll
    for (int e = 0; e < 8; e += 4) {
      const f32x4 gv = *reinterpret_cast<const f32x4*>(g + j * 512 + lane * 8 + e), bv = *reinterpret_cast<const f32x4*>(bta + j * 512 + lane * 8 + e);
      gg[j][e] = gv[0]; gg[j][e + 1] = gv[1]; gg[j][e + 2] = gv[2]; gg[j][e + 3] = gv[3];
      bb[j][e] = bv[0]; bb[j][e + 1] = bv[1]; bb[j][e + 2] = bv[2]; bb[j][e + 3] = bv[3];
    }
  for (int row = gw; row < MT; row += NGW) {
    float v[2][8];
    float s = 0.f;
#pragma unroll
    for (int j = 0; j < 2; ++j) {
      unpack8(*reinterpret_cast<const u32x4*>(PL + (size_t)row * 1024 + j * 512 + lane * 8), v[j]);
#pragma unroll
      for (int e = 0; e < 8; ++e) s += v[j][e];
    }
    const float mean = sum64(s) * (1.f / 1024.f);
    float s2 = 0.f;
#pragma unroll
    for (int j = 0; j < 2; ++j)
#pragma unroll
      for (int e = 0; e < 8; ++e) { v[j][e] -= mean; s2 += v[j][e] * v[j][e]; }
    const float rstd = rsqrtf(sum64(s2) * (1.f / 1024.f) + 1e-5f);
    float* dst = nullptr;
    if (final_out) {
      if (row < MP) {
        const int b = row / LP, t = row - b * LP;
        if (t >= 16) dst = p.out + OUT_YP + ((size_t)b * 2048 + (t - 16)) * 1024;
      } else {
        dst = p.out + OUT_YS + (size_t)(row - MP) * 1024;
      }
    }
#pragma unroll
    for (int j = 0; j < 2; ++j) {
      float y[8];
#pragma unroll
      for (int e = 0; e < 8; ++e) y[e] = v[j][e] * rstd * gg[j][e] + bb[j][e];
      if (final_out) {
        if (dst) {
          *reinterpret_cast<f32x4*>(dst + j * 512 + lane * 8) = f32x4{y[0], y[1], y[2], y[3]};
          *reinterpret_cast<f32x4*>(dst + j * 512 + lane * 8 + 4) = f32x4{y[4], y[5], y[6], y[7]};
        }
      } else {
        *reinterpret_cast<u32x4*>(Xb + (size_t)row * 1024 + j * 512 + lane * 8) = pack8(y);
      }
    }
  }
}

#define XB_TMO      128
#define XB_XCNT(j)  (256  + 64 * (j))
#define XB_XSUB(j)  (1280 + 64 * (j))
#define XB_XGEN(j)  (2304 + 64 * (j))
#define XB_TOP      3328
#define XB_TOPGEN   3392
#define XCD_BAR_WORDS 3456
#define XB_SPIN_CAP (1u << 18)

__device__ __forceinline__ unsigned xb_ld(unsigned* p)              { return __hip_atomic_load(p, __ATOMIC_RELAXED, __HIP_MEMORY_SCOPE_AGENT); }
__device__ __forceinline__ unsigned xb_add(unsigned* p, unsigned v) { return __hip_atomic_fetch_add(p, v, __ATOMIC_RELAXED, __HIP_MEMORY_SCOPE_AGENT); }
__device__ __forceinline__ unsigned xb_xcc_id() { return (unsigned)__builtin_amdgcn_s_getreg((3 << 11) | 20) & 0xFu; }
#define XB_SPIN(cond, bar) do { unsigned _sp = 0; while (cond) { __builtin_amdgcn_s_sleep(1); \
    if ((++_sp & 255u) == 0u) { if (xb_ld(&(bar)[XB_TMO])) break; if (_sp > XB_SPIN_CAP) { atomicAdd(&(bar)[XB_TMO], 1u); break; } } } } while (0)

struct XcdBarrier {
    unsigned* bar; unsigned x;
    volatile LAS unsigned* st;
};

__device__ __forceinline__ XcdBarrier xcd_barrier_post(unsigned* bar, volatile LAS unsigned* st) {
    XcdBarrier b; b.bar = bar; b.x = xb_xcc_id(); b.st = st;
    if (threadIdx.x == 0) (void)xb_add(&bar[XB_XCNT(b.x)], 1u);
    return b;
}
__device__ __forceinline__ void xcd_barrier_complete(unsigned* bar, unsigned x, unsigned& nloc, unsigned& nx) {
    const unsigned G = gridDim.x * gridDim.y * gridDim.z;
    unsigned sum, cnt, mine, sp = 0u;
    for (;;) {
        sum = 0u; cnt = 0u; mine = 0u;
#pragma unroll
        for (unsigned j = 0; j < 16; ++j) { const unsigned c = xb_ld(&bar[XB_XCNT(j)]); sum += c; cnt += (c > 0u) ? 1u : 0u; mine = (j == x) ? c : mine; }
        if (sum == G) break;
        __builtin_amdgcn_s_sleep(1);
        if ((++sp & 255u) == 0u) { if (xb_ld(&bar[XB_TMO])) break; if (sp > XB_SPIN_CAP) { atomicAdd(&bar[XB_TMO], 1u); break; } }
    }
    nloc = mine > 0u ? mine : 1u; nx = cnt > 0u ? cnt : 1u;
}

__device__ __forceinline__ void xcd_barrier(const XcdBarrier& b) {
    asm volatile("s_waitcnt vmcnt(0)" ::: "memory");
    __syncthreads();
    if (threadIdx.x == 0) {
        unsigned* bar = b.bar;
        __builtin_amdgcn_s_waitcnt(0);
        unsigned nloc = b.st[0], nx = b.st[1];
        if (nloc == 0u) { xcd_barrier_complete(bar, b.x, nloc, nx); b.st[0] = nloc; b.st[1] = nx; }
        const unsigned old = xb_add(&bar[XB_XSUB(b.x)], 1u);
        const unsigned gen = old / nloc;
        if (old + 1u == (gen + 1u) * nloc) {
            __builtin_amdgcn_fence(__ATOMIC_RELEASE, "agent");
            asm volatile("s_waitcnt vmcnt(0)" ::: "memory");
            const unsigned og = xb_add(&bar[XB_TOP], 1u);
            const unsigned tg = og / nx;
            if (og + 1u == (tg + 1u) * nx) xb_add(&bar[XB_TOPGEN], 1u);
            else XB_SPIN(xb_ld(&bar[XB_TOPGEN]) == tg, bar);
            __builtin_amdgcn_fence(__ATOMIC_ACQUIRE, "agent");
            xb_add(&bar[XB_XGEN(b.x)], 1u);
            asm volatile("s_waitcnt vmcnt(0)" ::: "memory");
        } else {
            XB_SPIN(xb_ld(&bar[XB_XGEN(b.x)]) == gen, bar);
            __builtin_amdgcn_fence(__ATOMIC_ACQUIRE, "agent");
            asm volatile("s_waitcnt vmcnt(0)" ::: "memory");
        }
    }
    __syncthreads();
}


__global__ void __launch_bounds__(NTHREADS, 2) fwd_kernel(Params p_in) {
  volatile LAS unsigned* xb_st = (volatile LAS unsigned*)((LAS unsigned char*)smem_raw + 131072);
  if (threadIdx.x == 0) { xb_st[0] = 0u; xb_st[1] = 0u; xb_st[2] = 0u; xb_st[3] = 0u; }
  __syncthreads();
  const XcdBarrier xb = xcd_barrier_post((unsigned*)(p_in.ws + OFF_BAR), xb_st);
  for (int ph = p_in.ph_lo; ph < p_in.ph_hi; ++ph) {
    const int l = ph / PH_PER_LAYER, k = ph % PH_PER_LAYER;
    Params p = p_in;
    {
      unsigned long long wsi = (unsigned long long)p_in.ws, outi = (unsigned long long)p_in.out;
      asm volatile("" : "+s"(wsi), "+s"(outi));
      p.ws = (unsigned char*)(__attribute__((address_space(1))) unsigned char*)wsi;
      p.out = (float*)(__attribute__((address_space(1))) float*)outi;
    }
    unsigned char* ws = p.ws;
    const int nrep = 1 + ((REPEAT_MASK >> k) & 1);
    for (int rep = 0; rep < nrep; ++rep) {
    if (rep) xcd_barrier(xb);
    switch (k) {
      case 0: if (l == 0) phase_convert(p, 0, 1 | 8, 0); break;
      case 1: phase_gemm_in(p, false); break;
      case 2: phase_pre(p, l); break;
      case 3: phase_scan(p, l);
              __syncthreads();
              phase_convert(p, l, 2 | 4, gridDim.x > 64 ? 64 : 0);
              break;
      case 4: phase_gnorm(p, l); phase_gemm_in(p, true); break;
      case 5: break;
      case 6: phase_merge(p); break;
      case 7: phase_gemm_resid(p, (const bf16*)(ws + OFF_R3), 1024, (const bf16*)(ws + OFF_WO), 1024); break;
      case 8: phase_ln(p, p.in[17] + l * 1024, p.in[18] + l * 1024, false);
              if (l == 0) phase_convert(p, 1, 1, 0);
              break;
      case 9: phase_ffn_in(p); break;
      case 10: phase_gemm_resid(p, (const bf16*)(ws + OFF_R2), DFF, (const bf16*)(ws + OFF_WFO), DFF); break;
      case 11: phase_ln(p, p.in[19] + l * 1024, p.in[20] + l * 1024, l == 1);
               break;
    }
    }
#if EXTRA_SYNCS
    for (int xs = 0; xs < EXTRA_SYNCS; ++xs) xcd_barrier(xb);
#endif
    const bool empty_phase = (k == 5) || (k == 0 && l > 0);
    if (ph + 1 < p_in.ph_hi && !empty_phase) {
      if (p_in.ph_hi > NPHASES) { __syncthreads(); cg::this_grid().sync(); }
      xcd_barrier(xb);
    }
  }
}

extern "C" void kernel_launch(void* const* d_in, const int* in_sizes, int n_in, void* d_out, int out_size, void* d_ws,
                              size_t ws_size, hipStream_t stream) {
  constexpr int LDS_BYTES = 131072 + 16;
  static int grid = 0;
  if (grid == 0) {
    int dev = 0, cus = 0;
    hipGetDevice(&dev);
    hipDeviceGetAttribute(&cus, hipDeviceAttributeMultiprocessorCount, dev);
    hipFuncSetAttribute((const void*)fwd_kernel, hipFuncAttributeMaxDynamicSharedMemorySize, LDS_BYTES);
    int per_cu = 0;
    hipOccupancyMaxActiveBlocksPerMultiprocessor(&per_cu, (const void*)fwd_kernel, NTHREADS, LDS_BYTES);
    (void)hipGetLastError();
    grid = cus > 0 ? cus : 256;
    if (ws_size < WS_END) fprintf(stderr, "kernel_launch: workspace too small: %zu < %zu\n", ws_size, (size_t)WS_END);
    if (per_cu < 1) fprintf(stderr, "kernel_launch: occupancy query says %d blocks per CU\n", per_cu);
  }
  Params p{};
  for (int i = 0; i < 23; ++i) p.in[i] = (const float*)d_in[i];
  p.out = (float*)d_out;
  p.ws = (unsigned char*)d_ws;
  (void)hipMemsetAsync((unsigned char*)d_ws + OFF_BAR, 0, BAR_BYTES, stream);
#if SINGLE_LAUNCH
  p.ph_lo = 0; p.ph_hi = NPHASES;
  void* args[] = {&p};
  hipError_t e = hipLaunchCooperativeKernel((const void*)fwd_kernel, dim3(grid), dim3(NTHREADS), args, LDS_BYTES, stream);
  if (e != hipSuccess) fprintf(stderr, "cooperative launch failed: %s (grid %d)\n", hipGetErrorString(e), grid);
#else
  for (int ph = 0; ph < NPHASES; ++ph) {
    p.ph_lo = ph; p.ph_hi = ph + 1;
    hipLaunchKernelGGL(fwd_kernel, dim3(grid), dim3(NTHREADS), LDS_BYTES, stream, p);
  }
#endif
}
```

```cpp
#include <hip/hip_runtime.h>
#include <hip/hip_bf16.h>
#include <hip/hip_cooperative_groups.h>
#include <cstdio>
namespace cg = cooperative_groups;

#ifndef SINGLE_LAUNCH
#define SINGLE_LAUNCH 1
#endif
#ifndef REPEAT_MASK
#define REPEAT_MASK 0
#endif
#ifndef EXTRA_SYNCS
#define EXTRA_SYNCS 0
#endif

typedef __hip_bfloat16 bf16;
typedef unsigned short u16;
typedef unsigned int u32;
using bf16x8 = __attribute__((ext_vector_type(8))) short;
using f32x4 = __attribute__((ext_vector_type(4))) float;
using u32x4 = __attribute__((ext_vector_type(4))) unsigned int;
using u32x2 = __attribute__((ext_vector_type(2))) unsigned int;

constexpr int D = 1024;
constexpr int NBATCH = 8, LP = 2064, MP = NBATCH * LP;
constexpr int NS = 128;
constexpr int MT = MP + NS;
constexpr int NMT = MT / 256;
constexpr int DIN_SRC = 5656, DIN_PAD = 5888;
constexpr int DFF = 2816;
constexpr int NTHREADS = 512, NWAVES = 8;
constexpr int PH_PER_LAYER = 12, NPHASES = 2 * PH_PER_LAYER;
constexpr float ALPHA = 1.4142135623730951f;

constexpr size_t SZ_WIN = (size_t)DIN_PAD * 1024 * 2;
constexpr size_t SZ_WFI = (size_t)2 * DFF * 1024 * 2;
constexpr size_t SZ_WFO = (size_t)1024 * DFF * 2;
constexpr size_t SZ_WA = (size_t)1024 * 512 * 2;
constexpr size_t SZ_WO = (size_t)1024 * 1024 * 2;
constexpr size_t OFF_WIN = 0;
constexpr size_t OFF_WFI = OFF_WIN + SZ_WIN;
constexpr size_t OFF_WFO = OFF_WFI + SZ_WFI;
constexpr size_t OFF_WA = OFF_WFO + SZ_WFO;
constexpr size_t OFF_WB = OFF_WA + SZ_WA;
constexpr size_t OFF_WO = OFF_WB + SZ_WA;
constexpr size_t OFF_XB = OFF_WO + SZ_WO;
constexpr size_t OFF_R2 = OFF_XB + (size_t)MT * 1024 * 2;
constexpr size_t OFF_R3 = OFF_R2 + (size_t)MT * 1536 * 2;
constexpr size_t OFF_R4 = OFF_R3 + (size_t)MT * 2048 * 2;
constexpr size_t R4_BYTES = (size_t)1056 * (73728 + 25088);
constexpr size_t OFF_R5 = OFF_R4 + R4_BYTES;
constexpr size_t OFF_GT = OFF_R5 + (size_t)MT * 32 * 4;
constexpr size_t OFF_QS = OFF_GT + 8192;
constexpr size_t OFF_BAR = OFF_QS + (size_t)NS * 1536 * 2;
constexpr size_t BAR_BYTES = 16384;
constexpr size_t WS_END = OFF_BAR + BAR_BYTES;
static_assert(WS_END <= (size_t)305000000, "workspace budget");
static_assert(R4_BYTES >= (size_t)MT * 1024 * 4, "R4 must hold preLN");

constexpr size_t OUT_YP = 0;
constexpr size_t OUT_YS = OUT_YP + (size_t)8 * 2048 * 1024;
constexpr size_t OUT_GDNP = OUT_YS + (size_t)128 * 1024;
constexpr size_t OUT_GLAP = OUT_GDNP + (size_t)2 * 8 * 4 * 128 * 128;
constexpr size_t OUT_CONVP = OUT_GLAP + (size_t)2 * 8 * 4 * 64 * 128;
constexpr size_t OUT_GDNS = OUT_CONVP + (size_t)2 * 8 * 3 * 1536;
constexpr size_t OUT_GLAS = OUT_GDNS + (size_t)2 * 128 * 4 * 128 * 128;
constexpr size_t OUT_CONVS = OUT_GLAS + (size_t)2 * 128 * 4 * 64 * 128;

struct Params {
  const float* in[23];
  float* out;
  unsigned char* ws;
  int ph_lo, ph_hi;
};

typedef float f32x2_t __attribute__((ext_vector_type(2)));
typedef __bf16 bf16x2_t __attribute__((ext_vector_type(2)));
__device__ __forceinline__ u32 pk2(float lo, float hi) {
  f32x2_t v = {lo, hi};
  bf16x2_t b = __builtin_convertvector(v, bf16x2_t);
  return __builtin_bit_cast(u32, b);
}
__device__ __forceinline__ u16 f2bf(float x) { return (u16)(pk2(x, 0.f) & 0xffffu); }
__device__ __forceinline__ float bflo(u32 w) { return __uint_as_float(w << 16); }
__device__ __forceinline__ float bfhi(u32 w) { return __uint_as_float(w & 0xffff0000u); }
__device__ __forceinline__ float bf1(u16 h) { return __uint_as_float(((u32)h) << 16); }
__device__ __forceinline__ void unpack8(const u32x4 v, float* f) {
  f[0] = bflo(v.x); f[1] = bfhi(v.x); f[2] = bflo(v.y); f[3] = bfhi(v.y);
  f[4] = bflo(v.z); f[5] = bfhi(v.z); f[6] = bflo(v.w); f[7] = bfhi(v.w);
}
__device__ __forceinline__ u32x4 pack8(const float* f) {
  u32x4 v; v.x = pk2(f[0], f[1]); v.y = pk2(f[2], f[3]); v.z = pk2(f[4], f[5]); v.w = pk2(f[6], f[7]);
  return v;
}
template <int X> __device__ __forceinline__ float swz_xor(float v) {
  return __int_as_float(__builtin_amdgcn_ds_swizzle(__float_as_int(v), (X << 10) | 0x1f));
}
__device__ __forceinline__ float sum8(float v) {
  v += swz_xor<1>(v); v += swz_xor<2>(v); v += swz_xor<4>(v);
  return v;
}
__device__ __forceinline__ float sum16(float v) {
  v += swz_xor<1>(v); v += swz_xor<2>(v); v += swz_xor<4>(v); v += swz_xor<8>(v);
  return v;
}
__device__ __forceinline__ float sum64(float v) {
  v += swz_xor<1>(v); v += swz_xor<2>(v); v += swz_xor<4>(v); v += swz_xor<8>(v); v += swz_xor<16>(v);
  return __int_as_float(__builtin_amdgcn_readlane(__float_as_int(v), 0)) + __int_as_float(__builtin_amdgcn_readlane(__float_as_int(v), 32));
}
__device__ __forceinline__ float sigmoidf_(float x) { return __builtin_amdgcn_rcpf(1.f + __expf(-x)); }
__device__ __forceinline__ float softplusf_(float x) { return x > 20.f ? x : log1pf(__expf(x)); }

extern __shared__ __attribute__((aligned(16))) unsigned char smem_raw[];
__device__ __forceinline__ int opaque_tid() { int t = threadIdx.x; asm volatile("" : "+v"(t)); return t; }

constexpr int HT = 128 * 64;
__device__ __forceinline__ int lds_byte(int r, int c) {
  int st = (r >> 4) * 2 + (c >> 5), rr = r & 15, cc = c & 31, ob = rr * 64 + cc * 2;
  return st * 1024 + (ob ^ (((ob >> 9) & 1) << 5));
}
__device__ __forceinline__ void stage_rc(int b, int& R, int& C) {
  int st = b / 1024, sb = b % 1024, swz = sb ^ (((sb >> 9) & 1) << 5);
  R = (st >> 1) * 16 + swz / 64;
  C = (st & 1) * 32 + (swz % 64) / 2;
}

typedef f32x4 Acc[2][2][4][2];

#define LAS __attribute__((address_space(3)))
__device__ __forceinline__ void gemm_kloop(Acc& acc, const bf16* __restrict__ A, int lda, const bf16* __restrict__ Bt, int ldb,
                                           int K, int brow, int bcol, const int tid, const bool perm = false) {
  LAS unsigned char* lds = (LAS unsigned char*)smem_raw;
  const int wid = __builtin_amdgcn_readfirstlane(tid >> 6), lane = tid & 63, wr = wid >> 2, wc = wid & 3,
            fr = lane & 15, fq = lane >> 4;
  unsigned voffA[2], voffB[2];
#pragma unroll
  for (int i = 0; i < 2; ++i) {
    int R, C;
    stage_rc(tid * 16 + i * 8192, R, C);
    voffA[i] = (unsigned)(R * lda + C) * 2u;
    const int p32 = R & 31, Rb = perm ? ((R & ~31) + 8 * ((p32 & 15) >> 2) + 4 * (p32 >> 4) + (p32 & 3)) : R;
    voffB[i] = (unsigned)(Rb * ldb + C) * 2u;
  }
  const size_t kstep = 128, hA = (size_t)128 * lda * 2, hB = (size_t)128 * ldb * 2;
  const unsigned ldsw = (unsigned)wid * 1024u;
  const int aoff = lds_byte(wr * 64 + fr, fq * 8), boff = lds_byte(wc * 32 + fr, fq * 8);
  const char* cA = (const char*)A + (size_t)brow * lda * 2;
  const char* cB = (const char*)Bt + (size_t)bcol * ldb * 2;
#define SA(b, h) (((b) * 2 + (h)) * 16384)
#define SB(b, h) ((4 + (b) * 2 + (h)) * 16384)
#define STAGE(bufoff, gbase, voff)                                                                             \
  do {                                                                                                         \
    _Pragma("unroll") for (int _i = 0; _i < 2; ++_i)                                                           \
        __builtin_amdgcn_global_load_lds((const unsigned*)((const char*)(gbase) + (voff)[_i]),                 \
                                         (LAS unsigned*)(lds + (bufoff) + ldsw + _i * 8192), 16, 0, 0);        \
  } while (0)
#define LDA(dst, b, h)                                                                                         \
  do {                                                                                                         \
    _Pragma("unroll") for (int m = 0; m < 4; ++m) _Pragma("unroll") for (int k = 0; k < 2; ++k)                \
        dst[m][k] = *(const LAS bf16x8*)(lds + SA(b, h) + aoff + m * 2048 + k * 1024);                         \
  } while (0)
#define LDB(dst, b, h)                                                                                         \
  do {                                                                                                         \
    _Pragma("unroll") for (int n = 0; n < 2; ++n) _Pragma("unroll") for (int k = 0; k < 2; ++k)                \
        dst[n][k] = *(const LAS bf16x8*)(lds + SB(b, h) + boff + n * 2048 + k * 1024);                         \
  } while (0)
#define MMA(ai, bj, At_, Bt_)                                                                                  \
  do {                                                                                                         \
    __builtin_amdgcn_s_setprio(1);                                                                             \
    _Pragma("unroll") for (int m = 0; m < 4; ++m) _Pragma("unroll") for (int n = 0; n < 2; ++n)                \
    _Pragma("unroll") for (int k = 0; k < 2; ++k)                                                              \
        acc[ai][bj][m][n] = __builtin_amdgcn_mfma_f32_16x16x32_bf16(Bt_[n][k], At_[m][k], acc[ai][bj][m][n], 0, 0, 0); \
    __builtin_amdgcn_s_setprio(0);                                                                             \
  } while (0)
#define WAIT_V(n) asm volatile("s_waitcnt vmcnt(" #n ")" ::: "memory")
#define WAIT_L(n) asm volatile("s_waitcnt lgkmcnt(" #n ")" ::: "memory")
#define BAR __builtin_amdgcn_s_barrier()
#define SCHED __builtin_amdgcn_sched_barrier(0)
  bf16x8 At[4][2], B0[2][2], B1[2][2];
  const int nt = K / 64;
  STAGE(SB(0, 0), cB, voffB); STAGE(SA(0, 0), cA, voffA); STAGE(SB(0, 1), cB + hB, voffB); STAGE(SA(0, 1), cA + hA, voffA);
  if (wr == 1) BAR;
  WAIT_V(4); BAR;
  STAGE(SB(1, 0), cB + kstep, voffB); STAGE(SA(1, 0), cA + kstep, voffA); STAGE(SB(1, 1), cB + hB + kstep, voffB);
  WAIT_V(6); BAR;
#pragma unroll 1
  for (int t = 0; t < nt - 2; t += 2) {
    const char* a1 = cA + (size_t)(t + 1) * kstep;
    const char* a2 = cA + (size_t)(t + 2) * kstep;
    const char* b2 = cB + (size_t)(t + 2) * kstep;
    const char* a3 = a2 + kstep;
    const char* b3 = b2 + kstep;
    LDB(B0, 0, 0); SCHED; LDA(At, 0, 0); STAGE(SA(1, 1), a1 + hA, voffA);
    WAIT_L(8); BAR; WAIT_L(0); MMA(0, 0, At, B0); BAR; SCHED;
    LDB(B1, 0, 1); STAGE(SB(0, 0), b2, voffB);
    BAR; WAIT_L(0); MMA(0, 1, At, B1); BAR;
    LDA(At, 0, 1); STAGE(SA(0, 0), a2, voffA);
    BAR; WAIT_L(0); MMA(1, 0, At, B0); BAR; SCHED;
    STAGE(SB(0, 1), b2 + hB, voffB);
    WAIT_V(6); BAR; MMA(1, 1, At, B1); BAR;
    LDB(B0, 1, 0); SCHED; LDA(At, 1, 0); STAGE(SA(0, 1), a2 + hA, voffA);
    WAIT_L(8); BAR; WAIT_L(0); MMA(0, 0, At, B0); BAR; SCHED;
    LDB(B1, 1, 1); STAGE(SB(1, 0), b3, voffB);
    BAR; WAIT_L(0); MMA(0, 1, At, B1); BAR;
    LDA(At, 1, 1); STAGE(SA(1, 0), a3, voffA);
    BAR; WAIT_L(0); MMA(1, 0, At, B0); BAR; SCHED;
    STAGE(SB(1, 1), b3 + hB, voffB);
    WAIT_V(6); BAR; MMA(1, 1, At, B1); BAR;
  }
  {
    const char* a1 = cA + (size_t)(nt - 1) * kstep;
    LDB(B0, 0, 0); LDA(At, 0, 0); STAGE(SA(1, 1), a1 + hA, voffA);
    BAR; WAIT_L(0); MMA(0, 0, At, B0); BAR;
    LDB(B1, 0, 1); BAR; WAIT_L(0); MMA(0, 1, At, B1); BAR;
    LDA(At, 0, 1); WAIT_V(4); BAR; WAIT_L(0); MMA(1, 0, At, B0); MMA(1, 1, At, B1); BAR;
  }
  {
    LDB(B0, 1, 0); LDA(At, 1, 0); WAIT_V(2); BAR; WAIT_L(0); MMA(0, 0, At, B0); BAR;
    LDB(B1, 1, 1); WAIT_V(0); BAR; WAIT_L(0); MMA(0, 1, At, B1); BAR;
    LDA(At, 1, 1); BAR; WAIT_L(0); MMA(1, 0, At, B0); MMA(1, 1, At, B1); BAR;
  }
  if (wr == 0) BAR;
#undef SA
#undef SB
#undef STAGE
#undef LDA
#undef LDB
#undef MMA
}

__device__ __forceinline__ void acc_zero(Acc& acc) {
#pragma unroll
  for (int a = 0; a < 2; ++a)
#pragma unroll
    for (int b = 0; b < 2; ++b)
#pragma unroll
      for (int m = 0; m < 4; ++m)
#pragma unroll
        for (int n = 0; n < 2; ++n) acc[a][b][m][n] = f32x4{0.f, 0.f, 0.f, 0.f};
}

#define EPI_COORDS                                                                                           \
  const int wid = tid >> 6, lane = tid & 63, wr = wid >> 2, wc = wid & 3, fr = lane & 15, fq = lane >> 4; \
  (void)wid;
#define EPI_LOOP                                                                                             \
  _Pragma("unroll") for (int ai = 0; ai < 2; ++ai) _Pragma("unroll") for (int bj = 0; bj < 2; ++bj)            \
  _Pragma("unroll") for (int m = 0; m < 4; ++m) _Pragma("unroll") for (int n = 0; n < 2; ++n)
#define EPI_ROW (brow + ai * 128 + wr * 64 + m * 16 + fr)
#define EPI_COL (bj * 128 + wc * 32 + n * 16 + fq * 4)

__device__ __forceinline__ void epi_store_bf16(const Acc& acc, bf16* dst, int ldd, int brow, const int tid) {
  EPI_COORDS
  EPI_LOOP {
    const f32x4 v = acc[ai][bj][m][n];
    u32x2 o; o.x = pk2(v[0], v[1]); o.y = pk2(v[2], v[3]);
    *reinterpret_cast<u32x2*>(dst + (size_t)EPI_ROW * ldd + EPI_COL) = o;
  }
}

__device__ __forceinline__ void epi_store_bf16_perm(const Acc& acc, bf16* dst, int ldd, int brow, const int tid) {
  EPI_COORDS
#pragma unroll
  for (int ai = 0; ai < 2; ++ai)
#pragma unroll
    for (int bj = 0; bj < 2; ++bj)
#pragma unroll
      for (int m = 0; m < 4; ++m) {
        const f32x4 v0 = acc[ai][bj][m][0], v1 = acc[ai][bj][m][1];
        u32x4 o; o.x = pk2(v0[0], v0[1]); o.y = pk2(v0[2], v0[3]); o.z = pk2(v1[0], v1[1]); o.w = pk2(v1[2], v1[3]);
        *reinterpret_cast<u32x4*>(dst + (size_t)(brow + ai * 128 + wr * 64 + m * 16 + fr) * ldd + bj * 128 + wc * 32 + 8 * fq) = o;
      }
}

__device__ __forceinline__ int srcmap_win(int d) {
  if (d < 2048) return d;
  if (d < 3584) return d + 8;
  if (d < 5632) return d + 24;
  if (d < 5640) return d - 5632 + 2048;
  if (d < 5656) return d - 5640 + 3592;
  return -1;
}
__device__ __forceinline__ int srcmap_ffi(int d) {
  const int tile = d >> 8, c = d & 255;
  const int bj = c >> 7, wc = (c >> 5) & 3, n = (c >> 4) & 1, i = c & 15;
  const int h = tile * 128 + wc * 32 + (i >> 2) * 8 + bj * 4 + (i & 3);
  return n ? (DFF + h) : h;
}
__device__ __forceinline__ void transpose_item(const float* __restrict__ W, int K, int Nsrc, bf16* __restrict__ WT, int mode,
                                               int item, float* scr, int lane) {
  const int nkb = K / 64, db = item / nkb, kb = item % nkb, k0 = kb * 64, d0 = db * 32;
  const int d = d0 + (lane & 7) * 4;
  const int s = (mode == 0) ? d : (mode == 1 ? srcmap_win(d) : srcmap_ffi(d));
#pragma unroll
  for (int i = 0; i < 8; ++i) {
    const int kk = 8 * i + (lane >> 3);
    f32x4 v = {0.f, 0.f, 0.f, 0.f};
    if (s >= 0) v = *reinterpret_cast<const f32x4*>(W + (size_t)(k0 + kk) * Nsrc + s);
    float* sp = scr + kk * 33 + (lane & 7) * 4;
    sp[0] = v[0]; sp[1] = v[1]; sp[2] = v[2]; sp[3] = v[3];
  }
  __builtin_amdgcn_wave_barrier();
  const int c = lane & 7;
#pragma unroll
  for (int j = 0; j < 4; ++j) {
    const int n = (lane >> 3) + 8 * j;
    const float* sp = scr + (8 * c) * 33 + n;
    u32x4 o;
    o.x = pk2(sp[0 * 33], sp[1 * 33]); o.y = pk2(sp[2 * 33], sp[3 * 33]);
    o.z = pk2(sp[4 * 33], sp[5 * 33]); o.w = pk2(sp[6 * 33], sp[7 * 33]);
    *reinterpret_cast<u32x4*>(WT + (size_t)(d0 + n) * K + k0 + 8 * c) = o;
  }
  __builtin_amdgcn_wave_barrier();
}

__device__ __forceinline__ void phase_convert(const Params& p, int l, int parts, int first_wg) {
  const int tid = opaque_tid();
  const int wid = tid >> 6, lane = tid & 63;
  if ((int)blockIdx.x < first_wg) return;
  float* scr = (float*)(smem_raw + wid * 8704);
  const int gw = ((int)blockIdx.x - first_wg) * NWAVES + wid, NGW = ((int)gridDim.x - first_wg) * NWAVES;
  constexpr int I_IN = (DIN_PAD / 32) * 16, I_FI = (2 * DFF / 32) * 16, I_FO = 32 * (DFF / 64), I_A = 32 * 8, I_O = 32 * 16;
  constexpr int NITEMS = I_IN + I_FI + I_FO + 2 * I_A + I_O;
  unsigned char* ws = p.ws;
  for (int it = gw; it < NITEMS; it += NGW) {
    int r = it;
    {
      const int grp = (r < I_IN) ? 0 : ((r < I_IN + I_FI + I_FO) ? 2 : 1);
      if (!((parts >> grp) & 1)) continue;
    }
    if (r < I_IN) { transpose_item(p.in[6] + (size_t)l * 1024 * DIN_SRC, 1024, DIN_SRC, (bf16*)(ws + OFF_WIN), 1, r, scr, lane); continue; }
    r -= I_IN;
    if (r < I_FI) { transpose_item(p.in[21] + (size_t)l * 1024 * 2 * DFF, 1024, 2 * DFF, (bf16*)(ws + OFF_WFI), 2, r, scr, lane); continue; }
    r -= I_FI;
    if (r < I_FO) { transpose_item(p.in[22] + (size_t)l * DFF * 1024, DFF, 1024, (bf16*)(ws + OFF_WFO), 0, r, scr, lane); continue; }
    r -= I_FO;
    if (r < I_A) { transpose_item(p.in[14] + (size_t)l * 512 * 1024, 512, 1024, (bf16*)(ws + OFF_WA), 0, r, scr, lane); continue; }
    r -= I_A;
    if (r < I_A) { transpose_item(p.in[15] + (size_t)l * 512 * 1024, 512, 1024, (bf16*)(ws + OFF_WB), 0, r, scr, lane); continue; }
    r -= I_A;
    transpose_item(p.in[16] + (size_t)l * 1024 * 1024, 1024, 1024, (bf16*)(ws + OFF_WO), 0, r, scr, lane);
  }
  if (parts & 8) {
    bf16* Xb = (bf16*)(ws + OFF_XB);
    const size_t nvec = (size_t)MT * 128;
    for (size_t v = (size_t)blockIdx.x * NTHREADS + tid; v < nvec; v += (size_t)gridDim.x * NTHREADS) {
      const int row = (int)(v >> 7), c0 = (int)(v & 127) * 8;
      const float* src;
      if (row < MP) {
        const int b = row / LP, t = row - b * LP;
        src = (t < 16) ? (p.in[5] + (size_t)t * D + c0) : (p.in[0] + ((size_t)b * 2048 + (t - 16)) * D + c0);
      } else {
        src = p.in[1] + (size_t)(row - MP) * D + c0;
      }
      const f32x4 a = *reinterpret_cast<const f32x4*>(src), b4 = *reinterpret_cast<const f32x4*>(src + 4);
      u32x4 o; o.x = pk2(a[0], a[1]); o.y = pk2(a[2], a[3]); o.z = pk2(b4[0], b4[1]); o.w = pk2(b4[2], b4[3]);
      *reinterpret_cast<u32x4*>(Xb + (size_t)row * D + c0) = o;
    }
  }
}

using f32x16 = __attribute__((ext_vector_type(16))) float;
constexpr int TAIL_ROW0 = 64 * 256;
template <int MODE>
__device__ __forceinline__ void tail_gemm(const Params& p, const bf16* __restrict__ A, int lda, const bf16* __restrict__ Bt, int ldb, int K, int N,
                                          int br, const int tid_in) {
  int tid = tid_in;
  asm volatile("" : "+v"(tid));
  unsigned char* ws = p.ws;
  LAS float* part = (LAS float*)smem_raw;
  const int wid = tid >> 6, lane = tid & 63, r32 = lane & 31, hh = lane >> 5;
  const int ncb = N / 32, kw = K / 8, k0 = wid * kw;
  for (int st = blockIdx.x; st < 8 * ncb; st += gridDim.x) {
    const int rb = st / ncb, cbk = st - rb * ncb;
    const int row0 = TAIL_ROW0 + rb * 32, col0 = cbk * 32;
    const bf16* ap = A + (size_t)(row0 + r32) * lda + k0 + hh * 8;
    const bf16* bp = Bt + (size_t)(col0 + r32) * ldb + k0 + hh * 8;
    f32x16 acc;
#pragma unroll
    for (int i = 0; i < 16; ++i) acc[i] = 0.f;
#pragma unroll 8
    for (int ks = 0; ks < kw; ks += 16) {
      const bf16x8 a = *reinterpret_cast<const bf16x8*>(ap + ks);
      const bf16x8 b = *reinterpret_cast<const bf16x8*>(bp + ks);
      acc = __builtin_amdgcn_mfma_f32_32x32x16_bf16(b, a, acc, 0, 0, 0);
    }
    const size_t m = (size_t)(row0 + r32);
    const int n = col0 + ((2 * wid) & 3) + 8 * ((2 * wid) >> 2) + 4 * hh;
    u32 gpair = 0u, ppair = 0u;
    if (MODE == 1) {
      gpair = *reinterpret_cast<const u32*>(reinterpret_cast<const u16*>(ws + OFF_R4) + m * 2048 + br * 1024 + n);
      if (br) ppair = *reinterpret_cast<const u32*>(reinterpret_cast<const u16*>(ws + OFF_R3) + m * 1024 + n);
    } else if (MODE == 2) {
      gpair = *reinterpret_cast<const u32*>(reinterpret_cast<const u16*>(ws + OFF_XB) + m * 1024 + n);
    }
#pragma unroll
    for (int i = 0; i < 16; ++i) part[(wid * 16 + i) * 64 + lane] = acc[i];
    __syncthreads();
    float v0 = 0.f, v1 = 0.f;
#pragma unroll
    for (int w = 0; w < 8; ++w) { v0 += part[(w * 16 + 2 * wid) * 64 + lane]; v1 += part[(w * 16 + 2 * wid + 1) * 64 + lane]; }
    if (MODE == 0) {
      *reinterpret_cast<u32*>(reinterpret_cast<u16*>(ws + OFF_R4) + m * 2048 + n) = pk2(v0, v1);
    } else if (MODE == 1) {
      float o0 = v0 * sigmoidf_(bflo(gpair)), o1 = v1 * sigmoidf_(bfhi(gpair));
      if (br) { o0 += bflo(ppair); o1 += bfhi(ppair); }
      *reinterpret_cast<u32*>(reinterpret_cast<u16*>(ws + OFF_R3) + m * 1024 + n) = pk2(o0, o1);
    } else {
      *reinterpret_cast<u32*>(reinterpret_cast<u16*>(ws + OFF_R4) + m * 1024 + n) = pk2(v0 + ALPHA * bflo(gpair), v1 + ALPHA * bfhi(gpair));
    }
    __syncthreads();
  }
}

__device__ __forceinline__ void tile_xcd(int u, int nn, int& pm, int& pi) {
  if (u < 64 * nn) {
    const int x = u & 7, jj = u >> 3, half = jj / (4 * nn), rem = jj - half * 4 * nn;
    pi = ((rem >> 2) + (x * nn) / 8) % nn;
    pm = 8 * x + 4 * half + (rem & 3);
  }
  else { pm = 64; pi = u - 64 * nn; }
}

__device__ __forceinline__ void phase_gemm_in(const Params& p, bool gates) {
  const int tid = opaque_tid();
  unsigned char* ws = p.ws;
  const bf16* Xb = (const bf16*)(ws + OFF_XB);
  const bf16* Wt = (const bf16*)(ws + OFF_WIN);
  const int nmt = gates ? 64 : NMT;
  const int ntile = (gates ? 8 : 15) * nmt;
  for (int t = blockIdx.x; t < ntile; t += gridDim.x) {
    int pi, pm;
    tile_xcd(t, gates ? 8 : 15, pm, pi);
    const int pn = gates ? (14 + pi) : (pi < 14 ? pi : 22);
    const int brow = pm * 256, bcol = pn * 256;
    Acc acc; acc_zero(acc);
    gemm_kloop(acc, Xb, 1024, Wt, 1024, 1024, brow, bcol, tid, true);
    if (pn < 6) epi_store_bf16_perm(acc, (bf16*)(ws + OFF_R2) + pn * 256, 1536, brow, tid);
    else if (pn < 14) epi_store_bf16_perm(acc, (bf16*)(ws + OFF_R3) + (pn - 6) * 256, 2048, brow, tid);
    else if (pn < 22) epi_store_bf16_perm(acc, (bf16*)(ws + OFF_R4) + (pn - 14) * 256, 2048, brow, tid);
    else {
      float* sm = (float*)(ws + OFF_R5);
      EPI_COORDS
      EPI_LOOP {
        if (bj == 0 && wc == 0) *reinterpret_cast<f32x4*>(sm + (size_t)EPI_ROW * 32 + 8 * fq + 4 * n) = acc[ai][bj][m][n];
      }
    }
  }
  if (gates) {
    __syncthreads();
    tail_gemm<0>(p, Xb, 1024, Wt + (size_t)14 * 256 * 1024, 1024, 1024, 2048, 0, tid);
  }
}

__device__ __forceinline__ void gdn_job(const Params& p, int l, int b, int h, int half, float* lds, const int tid) {
  unsigned char* ws = p.ws;
  const bf16* QS = (const bf16*)(ws + OFF_QS);
  const float* SM = (const float*)(ws + OFF_R5);
  bf16* O = (bf16*)(ws + OFF_R2);
  const int lane = tid & 63, cg = lane & 15, kq = lane >> 4;
  const int col = half * 64 + cg * 4;
  f32x4 S[32];
  const float* s0 = p.in[2] + (((size_t)l * NS + b) * 4 + h) * 128 * 128 + (size_t)(kq * 32) * 128 + col;
#pragma unroll
  for (int i = 0; i < 32; ++i) S[i] = *reinterpret_cast<const f32x4*>(s0 + (size_t)i * 128);
  const float eA = __expf(p.in[8][l * 4 + h]), dtb = p.in[9][l * 4 + h];
  float* lk = lds;
  float* lq = lds + 128;
  const size_t row = (size_t)MP + b;
  const u32 q2 = *reinterpret_cast<const u32*>(QS + (size_t)b * 1536 + h * 128 + lane * 2);
  const u32 k2 = *reinterpret_cast<const u32*>(QS + (size_t)b * 1536 + 512 + h * 128 + lane * 2);
  const u32x2 v2 = *reinterpret_cast<const u32x2*>(QS + (size_t)b * 1536 + 1024 + h * 128 + col);
  const f32x4 v = {bflo(v2.x), bfhi(v2.x), bflo(v2.y), bfhi(v2.y)};
  const float beta = sigmoidf_(SM[row * 32 + h]);
  const float g = -eA * softplusf_(SM[row * 32 + 4 + h] + dtb);
  const float eg = __expf(g);
  __builtin_amdgcn_wave_barrier();
  lq[lane * 2] = bflo(q2); lq[lane * 2 + 1] = bfhi(q2);
  lk[lane * 2] = bflo(k2); lk[lane * 2 + 1] = bfhi(k2);
  __builtin_amdgcn_wave_barrier();
  const float* lkq = lk + kq * 32;
  const float* lqq = lq + kq * 32;
  f32x4 ks = {0.f, 0.f, 0.f, 0.f};
#pragma unroll
  for (int i = 0; i < 32; i += 4) {
    const f32x4 kk = *reinterpret_cast<const f32x4*>(lkq + i);
    ks += S[i] * kk[0] + S[i + 1] * kk[1] + S[i + 2] * kk[2] + S[i + 3] * kk[3];
  }
#pragma unroll
  for (int c = 0; c < 4; ++c) { ks[c] += __shfl_xor(ks[c], 16); ks[c] += __shfl_xor(ks[c], 32); }
  const f32x4 u = (v - ks * eg) * beta;
  f32x4 o = {0.f, 0.f, 0.f, 0.f};
  float* so = p.out + OUT_GDNS + (((size_t)l * NS + b) * 4 + h) * 128 * 128 + (size_t)(kq * 32) * 128 + col;
#pragma unroll
  for (int i = 0; i < 32; i += 4) {
    const f32x4 kk = *reinterpret_cast<const f32x4*>(lkq + i);
    const f32x4 qq = *reinterpret_cast<const f32x4*>(lqq + i);
#pragma unroll
    for (int e = 0; e < 4; ++e) {
      const f32x4 sn = S[i + e] * eg + u * kk[e];
      o += sn * qq[e];
      *reinterpret_cast<f32x4*>(so + (size_t)(i + e) * 128) = sn;
    }
  }
#pragma unroll
  for (int c = 0; c < 4; ++c) { o[c] += __shfl_xor(o[c], 16); o[c] += __shfl_xor(o[c], 32); }
  if (kq == 0) {
    u32x2 ov; ov.x = pk2(o[0], o[1]); ov.y = pk2(o[2], o[3]);
    *reinterpret_cast<u32x2*>(O + row * 1024 + h * 128 + col) = ov;
  }
  __builtin_amdgcn_wave_barrier();
}

__device__ __forceinline__ void gla_job(const Params& p, int l, int b, int h, int half, bool smp, float* lds, const int tid) {
  unsigned char* ws = p.ws;
  const bf16* P2 = (const bf16*)(ws + OFF_R3);
  const float* SM = (const float*)(ws + OFF_R5);
  bf16* O = (bf16*)(ws + OFF_R2);
  const int lane = tid & 63, col = half * 64 + lane;
  float S[64];
  if (smp) {
    const float* s0 = p.in[3] + (((size_t)l * NS + b) * 4 + h) * 64 * 128 + col;
#pragma unroll
    for (int i = 0; i < 64; ++i) S[i] = s0[(size_t)i * 128];
  } else {
#pragma unroll
    for (int i = 0; i < 64; ++i) S[i] = 0.f;
  }
  float w2[16];
#pragma unroll
  for (int r = 0; r < 16; ++r) w2[r] = p.in[11][((size_t)l * 16 + r) * 256 + h * 64 + lane];
  const float gb = p.in[12][l * 256 + h * 64 + lane];
  const int T = smp ? 1 : LP, row0 = smp ? (MP + b) : b * LP;
  float* le = lds;
  float* lk = lds + 64;
  float* lq = lds + 128;
  for (int t = 0; t < T; ++t) {
    const size_t row = (size_t)(row0 + t);
    const float q = bf1(*reinterpret_cast<const u16*>(P2 + row * 2048 + 512 + h * 64 + lane)) * 0.125f;
    const float k = bf1(*reinterpret_cast<const u16*>(P2 + row * 2048 + 768 + h * 64 + lane));
    const float v = bf1(*reinterpret_cast<const u16*>(P2 + row * 2048 + 1024 + h * 128 + col));
    float x = gb;
#pragma unroll
    for (int r = 0; r < 16; ++r) x += SM[row * 32 + 8 + r] * w2[r];
    const float lg = -softplusf_(-x) * (1.f / 16.f);
    __builtin_amdgcn_wave_barrier();
    le[lane] = __expf(lg); lk[lane] = k; lq[lane] = q;
    __builtin_amdgcn_wave_barrier();
    float o = 0.f;
#pragma unroll
    for (int i = 0; i < 64; i += 4) {
      const f32x4 ee = *reinterpret_cast<const f32x4*>(le + i);
      const f32x4 kk = *reinterpret_cast<const f32x4*>(lk + i);
      const f32x4 qq = *reinterpret_cast<const f32x4*>(lq + i);
      S[i] = ee[0] * S[i] + kk[0] * v; S[i + 1] = ee[1] * S[i + 1] + kk[1] * v;
      S[i + 2] = ee[2] * S[i + 2] + kk[2] * v; S[i + 3] = ee[3] * S[i + 3] + kk[3] * v;
      o += S[i] * qq[0] + S[i + 1] * qq[1] + S[i + 2] * qq[2] + S[i + 3] * qq[3];
    }
    O[row * 1024 + 512 + h * 128 + col] = __float2bfloat16(o);
  }
  float* so = smp ? (p.out + OUT_GLAS + (((size_t)l * NS + b) * 4 + h) * 64 * 128 + col)
                  : (p.out + OUT_GLAP + (((size_t)l * NBATCH + b) * 4 + h) * 64 * 128 + col);
#pragma unroll
  for (int i = 0; i < 64; ++i) so[(size_t)i * 128] = S[i];
}

constexpr int NCH = 33;
constexpr int GDN_IMG = 73728, GLA_IMG = 25088;
constexpr size_t OFF_GDN_IMG = OFF_R4;
constexpr size_t OFF_GLA_IMG = OFF_R4 + (size_t)NBATCH * 4 * NCH * GDN_IMG;
constexpr size_t R4_IMG_END = OFF_GLA_IMG + (size_t)NBATCH * 4 * NCH * GLA_IMG;
static_assert(R4_IMG_END <= OFF_R5, "R4 too small for the images");

__device__ __forceinline__ bf16x8 lds_frag16(const LAS unsigned char* base) { return *reinterpret_cast<const LAS bf16x8*>(base); }
__device__ __forceinline__ bf16x8 mk_frag(u32 a, u32 b, u32 c, u32 d) {
  u32x4 v; v.x = a; v.y = b; v.z = c; v.w = d;
  return __builtin_bit_cast(bf16x8, v);
}
__device__ __forceinline__ bf16x8 frag_from_tiles(const f32x4 t0, const f32x4 t1) {
  return mk_frag(pk2(t0[0], t0[1]), pk2(t0[2], t0[3]), pk2(t1[0], t1[1]), pk2(t1[2], t1[3]));
}
#define MFMA16(a, b, c) __builtin_amdgcn_mfma_f32_16x16x32_bf16(a, b, c, 0, 0, 0)

__device__ __forceinline__ void conv8(const bf16* __restrict__ P1, const float* __restrict__ cw, size_t row, int t, int c0, bool valid,
                                      float* o, float* x3) {
#pragma unroll
  for (int e = 0; e < 8; ++e) o[e] = 0.f;
#pragma unroll
  for (int i = 0; i < 4; ++i) {
    float x[8];
    if (valid && (t - 3 + i >= 0)) unpack8(*reinterpret_cast<const u32x4*>(P1 + (row - 3 + i) * 1536 + c0), x);
    else {
#pragma unroll
      for (int e = 0; e < 8; ++e) x[e] = 0.f;
    }
    const f32x4 wa = *reinterpret_cast<const f32x4*>(cw + i * 1536 + c0), wb = *reinterpret_cast<const f32x4*>(cw + i * 1536 + c0 + 4);
    o[0] += wa[0] * x[0]; o[1] += wa[1] * x[1]; o[2] += wa[2] * x[2]; o[3] += wa[3] * x[3];
    o[4] += wb[0] * x[4]; o[5] += wb[1] * x[5]; o[6] += wb[2] * x[6]; o[7] += wb[3] * x[7];
    if (i == 3) {
#pragma unroll
      for (int e = 0; e < 8; ++e) x3[e] = x[e];
    }
  }
#pragma unroll
  for (int e = 0; e < 8; ++e) o[e] = o[e] * sigmoidf_(o[e]);
}

constexpr int LQ = 0, LK = 17408, LKT = 34816, LVT = 53248, LAM = 71680, LTW = 89088, LTU = 98304, LGM = 107520, LBT = 107776, LCW = 108032;
constexpr int QSTR = 272, TSTR = 144, ASTR = 68;

__device__ __forceinline__ void gdn_pre_item(const Params& p, int l, int b, int h, int c, const int tid_in) {
  int tid = tid_in;
  asm volatile("" : "+v"(tid));
  unsigned char* ws = p.ws;
  LAS unsigned char* lds = (LAS unsigned char*)smem_raw;
  asm volatile("" : "+v"(lds));
  const bf16* P1 = (const bf16*)(ws + OFF_R2);
  const float* SM = (const float*)(ws + OFF_R5);
  const float* cw = p.in[7] + (size_t)l * 4 * 1536;
  unsigned char* img = ws + OFF_GDN_IMG + (size_t)((b * 4 + h) * NCH + c) * GDN_IMG;
  const int wid = tid >> 6, lane = tid & 63, r = lane & 15, q = lane >> 4;
  const int tb = (c == 0) ? 0 : 16 + 64 * (c - 1), nvalid = (c == 0) ? 16 : 64;
  const size_t row0 = (size_t)b * LP + tb;
  float sm_a = 0.f, sm_b = 0.f;
  {
    const int j = tid >> 3, sub = tid & 7;
    const bool valid = j < nvalid;
    const int t = tb + j;
    const size_t row = row0 + j;
    LAS float* lcw = reinterpret_cast<LAS float*>(lds + LCW);
    float cwv[3];
#pragma unroll
    for (int u = 0; u < 3; ++u) {
      const int i = tid + u * NTHREADS, tap = i / 384, cc = i - tap * 384;
      cwv[u] = cw[tap * 1536 + (cc >> 7) * 512 + h * 128 + (cc & 127)];
    }
    if (wid == 0 && lane < nvalid) {
      sm_a = SM[(row0 + lane) * 32 + 4 + h];
      sm_b = SM[(row0 + lane) * 32 + h];
    }
    u32x4 raw[3][4][2];
#pragma unroll
    for (int mat = 0; mat < 3; ++mat)
#pragma unroll
      for (int i = 0; i < 4; ++i)
#pragma unroll
        for (int hf = 0; hf < 2; ++hf) {
          if (valid && (t - 3 + i >= 0)) raw[mat][i][hf] = *reinterpret_cast<const u32x4*>(P1 + (row - 3 + i) * 1536 + mat * 512 + h * 128 + sub * 16 + hf * 8);
          else raw[mat][i][hf] = u32x4{0u, 0u, 0u, 0u};
        }
#pragma unroll
    for (int u = 0; u < 3; ++u) lcw[tid + u * NTHREADS] = cwv[u];
    __syncthreads();
#pragma unroll
    for (int mat = 0; mat < 3; ++mat) {
      float o[16];
#pragma unroll
      for (int e = 0; e < 16; ++e) o[e] = 0.f;
#pragma unroll
      for (int i = 0; i < 4; ++i)
#pragma unroll
        for (int hf = 0; hf < 2; ++hf) {
          float x[8];
          unpack8(raw[mat][i][hf], x);
          const f32x4 wa = *reinterpret_cast<const LAS f32x4*>(lcw + i * 384 + mat * 128 + sub * 16 + hf * 8);
          const f32x4 wb = *reinterpret_cast<const LAS f32x4*>(lcw + i * 384 + mat * 128 + sub * 16 + hf * 8 + 4);
          float* oo = o + hf * 8;
          oo[0] += wa[0] * x[0]; oo[1] += wa[1] * x[1]; oo[2] += wa[2] * x[2]; oo[3] += wa[3] * x[3];
          oo[4] += wb[0] * x[4]; oo[5] += wb[1] * x[5]; oo[6] += wb[2] * x[6]; oo[7] += wb[3] * x[7];
        }
#pragma unroll
      for (int e = 0; e < 16; ++e) o[e] = o[e] * sigmoidf_(o[e]);
      if (mat < 2) {
        float ss = 0.f;
#pragma unroll
        for (int e = 0; e < 16; ++e) ss += o[e] * o[e];
        ss = sum8(ss);
        const float sc = rsqrtf(ss + 1e-6f) * (mat == 0 ? 0.08838834764831845f : 1.f);
#pragma unroll
        for (int e = 0; e < 16; ++e) o[e] *= sc;
      }
      if (mat < 2) {
        LAS unsigned char* ldst = lds + (mat == 0 ? LQ : LK) + j * QSTR + sub * 32;
        *reinterpret_cast<LAS u32x4*>(ldst) = pack8(o);
        *reinterpret_cast<LAS u32x4*>(ldst + 16) = pack8(o + 8);
      }
      if (mat >= 1) {
        LAS unsigned char* ldst = lds + (mat == 1 ? LKT : LVT) + (sub * 16) * TSTR + (j ^ (sub << 3)) * 2;
#pragma unroll
        for (int e = 0; e < 16; ++e) *reinterpret_cast<LAS u16*>(ldst + e * TSTR) = f2bf(o[e]);
      }
      if (c == NCH - 1 && j >= 61) {
        float* dst = p.out + OUT_CONVP + (((size_t)l * NBATCH + b) * 3 + (j - 61)) * 1536 + mat * 512 + h * 128 + sub * 16;
#pragma unroll
        for (int hf = 0; hf < 2; ++hf) {
          float x3[8];
          unpack8(raw[mat][3][hf], x3);
          *reinterpret_cast<f32x4*>(dst + hf * 8) = f32x4{x3[0], x3[1], x3[2], x3[3]};
          *reinterpret_cast<f32x4*>(dst + hf * 8 + 4) = f32x4{x3[4], x3[5], x3[6], x3[7]};
        }
      }
    }
  }
  if (wid == 0) {
    const bool valid = lane < nvalid;
    float g = 0.f, be = 0.f;
    if (valid) {
      const float eA = __expf(p.in[8][l * 4 + h]), dtb = p.in[9][l * 4 + h];
      g = -eA * softplusf_(sm_a + dtb);
      be = sigmoidf_(sm_b);
    }
#pragma unroll
    for (int o = 1; o < 64; o <<= 1) {
      const float y = __shfl_up(g, o);
      if (lane >= o) g += y;
    }
    reinterpret_cast<LAS float*>(lds + LGM)[lane] = g;
    reinterpret_cast<LAS float*>(lds + LBT)[lane] = be;
  }
  __syncthreads();
  const LAS float* gam = reinterpret_cast<const LAS float*>(lds + LGM);
  const LAS float* bet = reinterpret_cast<const LAS float*>(lds + LBT);
  {
#pragma unroll
    for (int u = 0; u < 2; ++u) {
      const int id = wid * 2 + u, it = id >> 2, jt = id & 3;
      f32x4 d = {0.f, 0.f, 0.f, 0.f};
#pragma unroll
      for (int ks = 0; ks < 4; ++ks) {
        const bf16x8 a = lds_frag16(lds + LK + (16 * it + r) * QSTR + (32 * ks + 8 * q) * 2);
        const bf16x8 bb = lds_frag16(lds + LK + (16 * jt + r) * QSTR + (32 * ks + 8 * q) * 2);
        d = MFMA16(a, bb, d);
      }
      const int jj = 16 * jt + r;
      const float gj = gam[jj];
#pragma unroll
      for (int e = 0; e < 4; ++e) {
        const int ii = 16 * it + 4 * q + e;
        const float v = (jj < ii) ? bet[ii] * __expf(fminf(gam[ii] - gj, 0.f)) * d[e] : 0.f;
        reinterpret_cast<LAS float*>(lds + LAM)[ii * ASTR + jj] = v;
      }
    }
    const int it = wid & 3, s = wid >> 2;
    f32x4 d2[2];
#pragma unroll
    for (int u = 0; u < 2; ++u) {
      const int jt = 2 * s + u;
      f32x4 d = {0.f, 0.f, 0.f, 0.f};
#pragma unroll
      for (int ks = 0; ks < 4; ++ks) {
        const bf16x8 a = lds_frag16(lds + LK + (16 * jt + r) * QSTR + (32 * ks + 8 * q) * 2);
        const bf16x8 bb = lds_frag16(lds + LQ + (16 * it + r) * QSTR + (32 * ks + 8 * q) * 2);
        d = MFMA16(a, bb, d);
      }
      const int ii = 16 * it + r;
      const float gi = gam[ii];
#pragma unroll
      for (int e = 0; e < 4; ++e) {
        const int jj = 16 * jt + 4 * q + e;
        d[e] = (jj <= ii) ? __expf(fminf(gi - gam[jj], 0.f)) * d[e] : 0.f;
      }
      d2[u] = d;
    }
    *reinterpret_cast<bf16x8*>(img + 32768 + (it * 2 + s) * 1024 + lane * 16) = frag_from_tiles(d2[0], d2[1]);
  }
  __syncthreads();
  if (wid == 0) {
    const LAS float* A = reinterpret_cast<const LAS float*>(lds + LAM);
    LAS unsigned char* PT = lds + LCW;
    LAS unsigned char* QR = lds + LCW + 2560;
    const int blk = lane >> 5, cc = lane & 31;
    float T[32];
    {
      const LAS float* Ab = A + (32 * blk) * ASTR + 32 * blk;
#pragma unroll
      for (int i = 0; i < 32; ++i) {
        float a0 = (i == cc) ? 1.f : 0.f, a1 = 0.f, a2 = 0.f, a3 = 0.f;
#pragma unroll
        for (int j4 = 0; j4 + 4 <= i; j4 += 4) {
          const f32x4 av = *reinterpret_cast<const LAS f32x4*>(Ab + i * ASTR + j4);
          a0 -= av[0] * T[j4]; a1 -= av[1] * T[j4 + 1]; a2 -= av[2] * T[j4 + 2]; a3 -= av[3] * T[j4 + 3];
        }
#pragma unroll
        for (int j = (i & ~3); j < i; ++j) a0 -= Ab[i * ASTR + j] * T[j];
        T[i] = (a0 + a1) + (a2 + a3);
        if ((i & 3) == 3) __builtin_amdgcn_sched_barrier(0);
      }
    }
    const float bj = bet[lane], bw = bj * __expf(gam[lane]);
    if (blk == 0) {
#pragma unroll
      for (int i8 = 0; i8 < 4; ++i8) *reinterpret_cast<LAS u32x4*>(PT + cc * 80 + i8 * 16) = pack8(T + 8 * i8);
    } else {
#pragma unroll
      for (int i = 0; i < 32; ++i) *reinterpret_cast<LAS u16*>(QR + i * 80 + cc * 2) = f2bf(T[i]);
    }
#pragma unroll
    for (int i = 0; i < 32; ++i) {
      *reinterpret_cast<LAS u16*>(lds + LTW + (32 * blk + i) * TSTR + lane * 2) = f2bf(T[i] * bw);
      *reinterpret_cast<LAS u16*>(lds + LTU + (32 * blk + i) * TSTR + lane * 2) = f2bf(T[i] * bj);
      if (blk == 1) {
        *reinterpret_cast<LAS u16*>(lds + LTW + i * TSTR + lane * 2) = (u16)0;
        *reinterpret_cast<LAS u16*>(lds + LTU + i * TSTR + lane * 2) = (u16)0;
      }
      if ((i & 7) == 7) __builtin_amdgcn_sched_barrier(0);
    }
    f32x4 M1[2][2];
#pragma unroll
    for (int it = 0; it < 2; ++it) {
      const LAS float* ar = A + (32 + 16 * it + r) * ASTR + 8 * q;
      const f32x4 x0 = *reinterpret_cast<const LAS f32x4*>(ar), x1 = *reinterpret_cast<const LAS f32x4*>(ar + 4);
      const bf16x8 af = mk_frag(pk2(x0[0], x0[1]), pk2(x0[2], x0[3]), pk2(x1[0], x1[1]), pk2(x1[2], x1[3]));
#pragma unroll
      for (int nt = 0; nt < 2; ++nt) {
        const bf16x8 bfq = lds_frag16(PT + (16 * nt + r) * 80 + q * 16);
        M1[it][nt] = MFMA16(af, bfq, (f32x4{0.f, 0.f, 0.f, 0.f}));
      }
    }
#pragma unroll
    for (int nt = 0; nt < 2; ++nt) {
      const bf16x8 mf = frag_from_tiles(M1[0][nt], M1[1][nt]);
      const int n = 16 * nt + r;
      const float bn = bet[n], bwn = bn * __expf(gam[n]);
#pragma unroll
      for (int it = 0; it < 2; ++it) {
        const u32x2 lo = *reinterpret_cast<const LAS u32x2*>(QR + (16 * it + r) * 80 + (4 * q) * 2);
        const u32x2 hi = *reinterpret_cast<const LAS u32x2*>(QR + (16 * it + r) * 80 + (16 + 4 * q) * 2);
        const f32x4 rr = MFMA16(mk_frag(lo.x, lo.y, hi.x, hi.y), mf, (f32x4{0.f, 0.f, 0.f, 0.f}));
#pragma unroll
        for (int e = 0; e < 4; ++e) {
          const int i = 32 + 16 * it + 4 * q + e;
          *reinterpret_cast<LAS u16*>(lds + LTW + i * TSTR + n * 2) = f2bf(-rr[e] * bwn);
          *reinterpret_cast<LAS u16*>(lds + LTU + i * TSTR + n * 2) = f2bf(-rr[e] * bn);
        }
      }
    }
    if (lane == 0) reinterpret_cast<float*>(ws + OFF_GT)[(b * 4 + h) * NCH + c] = __expf(gam[63]);
  } else {
    for (int f = wid - 1; f < 32; f += 7) {
      if (f < 16) {
        const int it = f >> 2, ks = f & 3, ii = 16 * it + r;
        const float sc = __expf(gam[ii]);
        const u32x2 lo = *reinterpret_cast<const LAS u32x2*>(lds + LQ + ii * QSTR + (32 * ks + 4 * q) * 2);
        const u32x2 hi = *reinterpret_cast<const LAS u32x2*>(lds + LQ + ii * QSTR + (32 * ks + 16 + 4 * q) * 2);
        const bf16x8 o = mk_frag(pk2(bflo(lo.x) * sc, bfhi(lo.x) * sc), pk2(bflo(lo.y) * sc, bfhi(lo.y) * sc),
                                 pk2(bflo(hi.x) * sc, bfhi(hi.x) * sc), pk2(bflo(hi.y) * sc, bfhi(hi.y) * sc));
        *reinterpret_cast<bf16x8*>(img + 16384 + f * 1024 + lane * 16) = o;
      } else {
        const int g2 = f - 16, kt = g2 >> 1, s = g2 & 1, kk = 16 * kt + r;
        const float gl = gam[63];
        const u32x2 lo = *reinterpret_cast<const LAS u32x2*>(lds + LKT + kk * TSTR + ((32 * s + 4 * q) ^ ((kt & 7) << 3)) * 2);
        const u32x2 hi = *reinterpret_cast<const LAS u32x2*>(lds + LKT + kk * TSTR + ((32 * s + 16 + 4 * q) ^ ((kt & 7) << 3)) * 2);
        const f32x4 g0 = *reinterpret_cast<const LAS f32x4*>(gam + 32 * s + 4 * q);
        const f32x4 g1 = *reinterpret_cast<const LAS f32x4*>(gam + 32 * s + 16 + 4 * q);
        const bf16x8 o = mk_frag(pk2(bflo(lo.x) * __expf(gl - g0[0]), bfhi(lo.x) * __expf(gl - g0[1])),
                                 pk2(bflo(lo.y) * __expf(gl - g0[2]), bfhi(lo.y) * __expf(gl - g0[3])),
                                 pk2(bflo(hi.x) * __expf(gl - g1[0]), bfhi(hi.x) * __expf(gl - g1[1])),
                                 pk2(bflo(hi.y) * __expf(gl - g1[2]), bfhi(hi.y) * __expf(gl - g1[3])));
        *reinterpret_cast<bf16x8*>(img + 40960 + g2 * 1024 + lane * 16) = o;
      }
    }
  }
  __syncthreads();
  {
    const int it = wid & 3;
#pragma unroll
    for (int u = 0; u < 2; ++u) {
      const int ks = (wid >> 2) + 2 * u;
      f32x4 d2[2];
#pragma unroll
      for (int v = 0; v < 2; ++v) {
        const int kt = 2 * ks + v;
        f32x4 d = {0.f, 0.f, 0.f, 0.f};
#pragma unroll
        for (int s = 0; s < 2; ++s) {
          const bf16x8 a = lds_frag16(lds + LKT + (16 * kt + r) * TSTR + ((32 * s + 8 * q) ^ ((kt & 7) << 3)) * 2);
          const bf16x8 bb = lds_frag16(lds + LTW + (16 * it + r) * TSTR + (32 * s + 8 * q) * 2);
          d = MFMA16(a, bb, d);
        }
        d2[v] = -d;
      }
      *reinterpret_cast<bf16x8*>(img + (it * 4 + ks) * 1024 + lane * 16) = frag_from_tiles(d2[0], d2[1]);
    }
    const int nt = wid;
#pragma unroll
    for (int it2 = 0; it2 < 4; ++it2) {
      f32x4 d = {0.f, 0.f, 0.f, 0.f};
#pragma unroll
      for (int s = 0; s < 2; ++s) {
        const bf16x8 a = lds_frag16(lds + LTU + (16 * it2 + r) * TSTR + (32 * s + 8 * q) * 2);
        const bf16x8 bb = lds_frag16(lds + LVT + (16 * nt + r) * TSTR + ((32 * s + 8 * q) ^ ((nt & 7) << 3)) * 2);
        d = MFMA16(a, bb, d);
      }
      u32x2 o; o.x = pk2(d[0], d[1]); o.y = pk2(d[2], d[3]);
      *reinterpret_cast<u32x2*>(img + 57344 + ((nt * 4 + it2) * 64 + lane) * 8) = o;
    }
  }
  __syncthreads();
}

constexpr int GQ = 0, GK = 9216, GKR = 18432, GCB = 27648, GW2 = 45056;
__device__ __forceinline__ void gla_pre_item(const Params& p, int l, int b, int h, int c, const int tid_in) {
  int tid = tid_in;
  asm volatile("" : "+v"(tid));
  unsigned char* ws = p.ws;
  LAS unsigned char* lds = (LAS unsigned char*)smem_raw;
  asm volatile("" : "+v"(lds));
  const bf16* P2 = (const bf16*)(ws + OFF_R3);
  const float* SM = (const float*)(ws + OFF_R5);
  unsigned char* img = ws + OFF_GLA_IMG + (size_t)((b * 4 + h) * NCH + c) * GLA_IMG;
  const int wid = tid >> 6, lane = tid & 63, r = lane & 15, q = lane >> 4;
  const int tb = (c == 0) ? 0 : 16 + 64 * (c - 1), nvalid = (c == 0) ? 16 : 64;
  const size_t row0 = (size_t)b * LP + tb;
  LAS float* cb = reinterpret_cast<LAS float*>(lds + GCB);
  LAS float* w2s = reinterpret_cast<LAS float*>(lds + GW2);
  LAS float* wtot = w2s + 1024;
  const int j = tid >> 3, sub = tid & 7;
  const bool valid = j < nvalid;
  f32x4 glr[4];
  {
    const float w2a = p.in[11][((size_t)l * 16 + (tid >> 6)) * 256 + h * 64 + (tid & 63)];
    const float w2b = p.in[11][((size_t)l * 16 + ((tid + NTHREADS) >> 6)) * 256 + h * 64 + (tid & 63)];
    const float* smr = SM + (row0 + (valid ? j : 0)) * 32 + 8;
#pragma unroll
    for (int u = 0; u < 4; ++u) glr[u] = *reinterpret_cast<const f32x4*>(smr + 4 * u);
    w2s[tid] = w2a; w2s[tid + NTHREADS] = w2b;
  }
  __syncthreads();
  float qv[8], kv[8], cbv[8];
  {
    float x[8];
#pragma unroll
    for (int e = 0; e < 8; ++e) x[e] = p.in[12][l * 256 + h * 64 + sub * 8 + e];
    if (valid) {
#pragma unroll
      for (int rr = 0; rr < 16; ++rr) {
        const float gl = glr[rr >> 2][rr & 3];
        const f32x4 wa = *reinterpret_cast<const LAS f32x4*>(w2s + rr * 64 + sub * 8), wb = *reinterpret_cast<const LAS f32x4*>(w2s + rr * 64 + sub * 8 + 4);
        x[0] += gl * wa[0]; x[1] += gl * wa[1]; x[2] += gl * wa[2]; x[3] += gl * wa[3];
        x[4] += gl * wb[0]; x[5] += gl * wb[1]; x[6] += gl * wb[2]; x[7] += gl * wb[3];
      }
    }
#pragma unroll
    for (int e = 0; e < 8; ++e) cbv[e] = valid ? -softplusf_(-x[e]) * (1.f / 16.f) : 0.f;
    if (valid) {
      unpack8(*reinterpret_cast<const u32x4*>(P2 + (row0 + j) * 2048 + 512 + h * 64 + sub * 8), qv);
      unpack8(*reinterpret_cast<const u32x4*>(P2 + (row0 + j) * 2048 + 768 + h * 64 + sub * 8), kv);
    } else {
#pragma unroll
      for (int e = 0; e < 8; ++e) { qv[e] = 0.f; kv[e] = 0.f; }
    }
    *reinterpret_cast<LAS u32x4*>(lds + GKR + j * TSTR + sub * 16) = pack8(kv);
#pragma unroll
    for (int o = 8; o < 64; o <<= 1) {
#pragma unroll
      for (int e = 0; e < 8; ++e) {
        const float y = __shfl_up(cbv[e], o);
        if (lane >= o) cbv[e] += y;
      }
    }
    if (lane >= 56) {
#pragma unroll
      for (int e = 0; e < 8; ++e) wtot[wid * 64 + sub * 8 + e] = cbv[e];
    }
  }
  __syncthreads();
  {
    float tot[8];
#pragma unroll
    for (int e = 0; e < 8; ++e) tot[e] = 0.f;
#pragma unroll
    for (int w = 0; w < 8; ++w) {
      const f32x4 ta = *reinterpret_cast<const LAS f32x4*>(wtot + w * 64 + sub * 8), tb4 = *reinterpret_cast<const LAS f32x4*>(wtot + w * 64 + sub * 8 + 4);
      if (w < wid) {
        cbv[0] += ta[0]; cbv[1] += ta[1]; cbv[2] += ta[2]; cbv[3] += ta[3];
        cbv[4] += tb4[0]; cbv[5] += tb4[1]; cbv[6] += tb4[2]; cbv[7] += tb4[3];
      }
      tot[0] += ta[0]; tot[1] += ta[1]; tot[2] += ta[2]; tot[3] += ta[3];
      tot[4] += tb4[0]; tot[5] += tb4[1]; tot[6] += tb4[2]; tot[7] += tb4[3];
    }
#pragma unroll
    for (int e = 0; e < 8; ++e) cb[j * ASTR + sub * 8 + e] = cbv[e];
    if (j == 63) {
#pragma unroll
      for (int e = 0; e < 8; ++e) reinterpret_cast<float*>(img + 24576)[sub * 8 + e] = __expf(tot[e]);
    }
    float qo[8], ko[8];
#pragma unroll
    for (int e = 0; e < 8; ++e) {
      const float cv = cbv[e];
      qo[e] = qv[e] * 0.125f * __expf(cv);
      ko[e] = kv[e] * __expf(-cv);
    }
    *reinterpret_cast<LAS u32x4*>(lds + GQ + j * TSTR + sub * 16) = pack8(qo);
    *reinterpret_cast<LAS u32x4*>(lds + GK + j * TSTR + sub * 16) = pack8(ko);
  }
  __syncthreads();
  {
    {
      const int it = wid >> 1, ks = wid & 1, ii = 16 * it + r;
      const u32x2 lo = *reinterpret_cast<const LAS u32x2*>(lds + GQ + ii * TSTR + (32 * ks + 4 * q) * 2);
      const u32x2 hi = *reinterpret_cast<const LAS u32x2*>(lds + GQ + ii * TSTR + (32 * ks + 16 + 4 * q) * 2);
      *reinterpret_cast<bf16x8*>(img + wid * 1024 + lane * 16) = mk_frag(lo.x, lo.y, hi.x, hi.y);
    }
    {
      const int kt = wid >> 1, s = wid & 1, dk = 16 * kt + r;
      const float cl = cb[63 * ASTR + dk];
      float o[8];
#pragma unroll
      for (int e = 0; e < 8; ++e) {
        const int jj = 32 * s + (e < 4 ? 4 * q + e : 16 + 4 * q + (e - 4));
        const float kr = bf1(*reinterpret_cast<const LAS u16*>(lds + GKR + jj * TSTR + dk * 2));
        o[e] = kr * __expf(cl - cb[jj * ASTR + dk]);
      }
      *reinterpret_cast<bf16x8*>(img + 16384 + wid * 1024 + lane * 16) = mk_frag(pk2(o[0], o[1]), pk2(o[2], o[3]), pk2(o[4], o[5]), pk2(o[6], o[7]));
    }
    {
      const int it = wid & 3, s = wid >> 2;
      f32x4 d2[2];
#pragma unroll
      for (int u = 0; u < 2; ++u) {
        const int jt = 2 * s + u;
        f32x4 d = {0.f, 0.f, 0.f, 0.f};
#pragma unroll
        for (int ks = 0; ks < 2; ++ks) {
          const bf16x8 a = lds_frag16(lds + GK + (16 * jt + r) * TSTR + (32 * ks + 8 * q) * 2);
          const bf16x8 bb = lds_frag16(lds + GQ + (16 * it + r) * TSTR + (32 * ks + 8 * q) * 2);
          d = MFMA16(a, bb, d);
        }
        const int ii = 16 * it + r;
#pragma unroll
        for (int e = 0; e < 4; ++e) {
          const int jj = 16 * jt + 4 * q + e;
          d[e] = (jj <= ii) ? d[e] : 0.f;
        }
        d2[u] = d;
      }
      *reinterpret_cast<bf16x8*>(img + 8192 + (it * 2 + s) * 1024 + lane * 16) = frag_from_tiles(d2[0], d2[1]);
    }
  }
  __syncthreads();
}

__device__ __forceinline__ void sample_conv(const Params& p, int l, const int tid) {
  unsigned char* ws = p.ws;
  const bf16* P1 = (const bf16*)(ws + OFF_R2);
  bf16* QS = (bf16*)(ws + OFF_QS);
  const float* cw = p.in[7] + (size_t)l * 4 * 1536;
  const int wid = tid >> 6, lane = tid & 63;
  const int wg0 = (gridDim.x == 256) ? 128 : 0;
  if ((int)blockIdx.x < wg0) return;
  const int gw = ((int)blockIdx.x - wg0) * NWAVES + wid, NGW = ((int)gridDim.x - wg0) * NWAVES;
  for (int b = gw; b < NS; b += NGW) {
    const size_t row = (size_t)MP + b;
#pragma unroll
    for (int j = 0; j < 3; ++j) {
      const int c0 = j * 512 + lane * 8;
      float x[4][8];
      unpack8(*reinterpret_cast<const u32x4*>(P1 + row * 1536 + c0), x[3]);
#pragma unroll
      for (int i = 0; i < 3; ++i) {
        const float* sp = p.in[4] + (((size_t)l * NS + b) * 3 + i) * 1536 + c0;
        const f32x4 a = *reinterpret_cast<const f32x4*>(sp), cc = *reinterpret_cast<const f32x4*>(sp + 4);
        x[i][0] = a[0]; x[i][1] = a[1]; x[i][2] = a[2]; x[i][3] = a[3];
        x[i][4] = cc[0]; x[i][5] = cc[1]; x[i][6] = cc[2]; x[i][7] = cc[3];
      }
      float o[8];
#pragma unroll
      for (int e = 0; e < 8; ++e) o[e] = 0.f;
#pragma unroll
      for (int i = 0; i < 4; ++i) {
        const f32x4 wa = *reinterpret_cast<const f32x4*>(cw + i * 1536 + c0), wb = *reinterpret_cast<const f32x4*>(cw + i * 1536 + c0 + 4);
        o[0] += wa[0] * x[i][0]; o[1] += wa[1] * x[i][1]; o[2] += wa[2] * x[i][2]; o[3] += wa[3] * x[i][3];
        o[4] += wb[0] * x[i][4]; o[5] += wb[1] * x[i][5]; o[6] += wb[2] * x[i][6]; o[7] += wb[3] * x[i][7];
      }
      float ss = 0.f;
#pragma unroll
      for (int e = 0; e < 8; ++e) { o[e] = o[e] * sigmoidf_(o[e]); ss += o[e] * o[e]; }
      if (j < 2) {
        ss = sum16(ss);
        const float sc = rsqrtf(ss + 1e-6f) * (j == 0 ? 0.08838834764831845f : 1.f);
#pragma unroll
        for (int e = 0; e < 8; ++e) o[e] *= sc;
      }
      *reinterpret_cast<u32x4*>(QS + (size_t)b * 1536 + c0) = pack8(o);
#pragma unroll
      for (int i = 0; i < 3; ++i) {
        float* dst = p.out + OUT_CONVS + (((size_t)l * NS + b) * 3 + i) * 1536 + c0;
        *reinterpret_cast<f32x4*>(dst) = f32x4{x[i + 1][0], x[i + 1][1], x[i + 1][2], x[i + 1][3]};
        *reinterpret_cast<f32x4*>(dst + 4) = f32x4{x[i + 1][4], x[i + 1][5], x[i + 1][6], x[i + 1][7]};
      }
    }
  }
}

__device__ __forceinline__ void phase_pre(const Params& p, int l) {
  const int tid = opaque_tid();
  sample_conv(p, l, tid);
  constexpr int NCHH = NBATCH * 4 * NCH;
  for (int it = blockIdx.x; it < NCHH; it += gridDim.x) {
    const int c = it % NCH, bh = it / NCH;
    gdn_pre_item(p, l, bh >> 2, bh & 3, c, tid);
  }
  if (gridDim.x == 256) {
    const int w = blockIdx.x;
    int first, count, stride;
    if (w < 32) { first = 896 + w; count = 3; stride = 32; }
    else { first = w - 32; count = 4; stride = 224; }
    for (int k = 0; k < count; ++k) {
      const int x = first + k * stride;
      gla_pre_item(p, l, (x / NCH) >> 2, (x / NCH) & 3, x % NCH, tid);
    }
    if (w >= 32 && w < 96) {
      const int x = 992 + (w - 32);
      gla_pre_item(p, l, (x / NCH) >> 2, (x / NCH) & 3, x % NCH, tid);
    }
  } else {
    for (int x = blockIdx.x; x < NCHH; x += gridDim.x) gla_pre_item(p, l, (x / NCH) >> 2, (x / NCH) & 3, x % NCH, tid);
  }
}

__device__ __forceinline__ void img_load(const unsigned char* img, int bytes, int ldsoff, const int tid) {
  LAS unsigned char* lds = (LAS unsigned char*)smem_raw;
  const int wid = __builtin_amdgcn_readfirstlane(tid >> 6), lane = tid & 63;
  for (int k = 0; k * 8192 < bytes; ++k)
    __builtin_amdgcn_global_load_lds((const unsigned*)(img + k * 8192 + wid * 1024 + lane * 16),
                                     (LAS unsigned*)(lds + ldsoff + k * 8192 + wid * 1024), 16, 0, 0);
}

__device__ __forceinline__ void gdn_scan(const Params& p, int l, int b, int h, const int tid) {
  unsigned char* ws = p.ws;
  const LAS unsigned char* lds = (const LAS unsigned char*)smem_raw;
  asm volatile("" : "+v"(lds));
  bf16* O = (bf16*)(ws + OFF_R2);
  const int wid = tid >> 6, lane = tid & 63, r = lane & 15, q = lane >> 4;
  const int n = 16 * wid + r;
  const unsigned char* img0 = ws + OFF_GDN_IMG + (size_t)((b * 4 + h) * NCH) * GDN_IMG;
  const float* GT = reinterpret_cast<const float*>(ws + OFF_GT) + (b * 4 + h) * NCH;
  f32x4 S[8];
#pragma unroll
  for (int k = 0; k < 8; ++k) S[k] = f32x4{0.f, 0.f, 0.f, 0.f};
  constexpr int BUF = 57344;
  img_load(img0, BUF, 0, tid);
  u32x2 u0n[4];
#pragma unroll
  for (int it = 0; it < 4; ++it) u0n[it] = *reinterpret_cast<const u32x2*>(img0 + 57344 + ((wid * 4 + it) * 64 + lane) * 8);
  const float* gtp = GT + (lane & 0);
  asm volatile("" : "+v"(gtp));
  asm volatile("s_waitcnt vmcnt(0)" ::: "memory");
  __syncthreads();
#pragma unroll 1
  for (int c = 0; c < NCH; ++c) {
    const unsigned char* img = img0 + (size_t)c * GDN_IMG;
    const float gt = gtp[c];
    f32x4 U[4], Oc[4];
#pragma unroll
    for (int it = 0; it < 4; ++it) {
      U[it] = f32x4{bflo(u0n[it].x), bfhi(u0n[it].x), bflo(u0n[it].y), bfhi(u0n[it].y)};
      Oc[it] = f32x4{0.f, 0.f, 0.f, 0.f};
    }
    if (c + 1 < NCH) {
      img_load(img + GDN_IMG, BUF, ((c + 1) & 1) * BUF, tid);
#pragma unroll
      for (int it = 0; it < 4; ++it) u0n[it] = *reinterpret_cast<const u32x2*>(img + GDN_IMG + 57344 + ((wid * 4 + it) * 64 + lane) * 8);
    }
    const LAS unsigned char* buf = lds + (c & 1) * BUF;
    bf16x8 Sf[4];
    Sf[0] = frag_from_tiles(S[0], S[1]);
    Sf[1] = frag_from_tiles(S[2], S[3]);
#define SB __builtin_amdgcn_sched_barrier(0)
#define LW(F, ks) _Pragma("unroll") for (int it = 0; it < 4; ++it) F[it] = lds_frag16(buf + (it * 4 + (ks)) * 1024 + lane * 16);
#define LQ(F, ks) _Pragma("unroll") for (int it = 0; it < 4; ++it) F[it] = lds_frag16(buf + 16384 + (it * 4 + (ks)) * 1024 + lane * 16);
#define LK(F, g) _Pragma("unroll") for (int i = 0; i < 4; ++i) F[i] = lds_frag16(buf + 32768 + ((g) * 4 + i) * 1024 + lane * 16);
#define LD(F, g) _Pragma("unroll") for (int i = 0; i < 4; ++i) F[i] = lds_frag16(buf + 40960 + ((g) * 4 + i) * 1024 + lane * 16);
#define MW(F, ks) _Pragma("unroll") for (int it = 0; it < 4; ++it) U[it] = MFMA16(F[it], Sf[ks], U[it]);
#define MQ(F, ks) _Pragma("unroll") for (int it = 0; it < 4; ++it) Oc[it] = MFMA16(F[it], Sf[ks], Oc[it]);
#define MK(F, g) _Pragma("unroll") for (int i = 0; i < 4; ++i) Oc[(g) * 2 + (i >> 1)] = MFMA16(F[i], Uf[i & 1], Oc[(g) * 2 + (i >> 1)]);
#define MD(F, g) _Pragma("unroll") for (int i = 0; i < 4; ++i) {                                   \
      if ((i & 1) == 0) S[(g) * 2 + (i >> 1)] = S[(g) * 2 + (i >> 1)] * gt;                        \
      S[(g) * 2 + (i >> 1)] = MFMA16(F[i], Uf[i & 1], S[(g) * 2 + (i >> 1)]); }
    bf16x8 f0[4], f1[4];
    __builtin_amdgcn_s_setprio(1);
    LW(f0, 0) LQ(f1, 0) SB;
    MW(f0, 0) LW(f0, 1) SB;
    Sf[2] = frag_from_tiles(S[4], S[5]);
    Sf[3] = frag_from_tiles(S[6], S[7]);
    MQ(f1, 0) LQ(f1, 1) SB;
    MW(f0, 1) LW(f0, 2) SB;
    MQ(f1, 1) LQ(f1, 2) SB;
    MW(f0, 2) LW(f0, 3) SB;
    MQ(f1, 2) LQ(f1, 3) SB;
    MW(f0, 3) LK(f0, 0) SB;
    MQ(f1, 3) LK(f1, 1) SB;
    bf16x8 Uf[2];
    Uf[0] = frag_from_tiles(U[0], U[1]);
    Uf[1] = frag_from_tiles(U[2], U[3]);
    MK(f0, 0) LD(f0, 0) SB;
    MK(f1, 1) LD(f1, 1) SB;
    MD(f0, 0) LD(f0, 2) SB;
    MD(f1, 1) LD(f1, 3) SB;
    MD(f0, 2) MD(f1, 3)
    __builtin_amdgcn_s_setprio(0);
#undef LW
#undef LQ
#undef LK
#undef LD
#undef MW
#undef MQ
#undef MK
#undef MD
    {
      const int tbc = (c == 0) ? 0 : 16 + 64 * (c - 1), nvc = (c == 0) ? 16 : 64;
      bf16* ob = O + ((size_t)b * LP + tbc + 4 * q) * 1024 + h * 128 + n;
      asm volatile("" : "+v"(ob));
#pragma unroll
      for (int it = 0; it < 4; ++it)
#pragma unroll
        for (int e = 0; e < 4; ++e) {
          const int i = 16 * it + 4 * q + e;
          if (i < nvc) *reinterpret_cast<u16*>(ob + (16 * it + e) * 1024) = f2bf(Oc[it][e]);
        }
    }
    asm volatile("s_waitcnt vmcnt(0)" ::: "memory");
    __syncthreads();
  }
  float* so = p.out + OUT_GDNP + (((size_t)l * NBATCH + b) * 4 + h) * 128 * 128 + n;
#pragma unroll
  for (int kt = 0; kt < 8; ++kt)
#pragma unroll
    for (int e = 0; e < 4; ++e) so[(size_t)(16 * kt + 4 * q + e) * 128] = S[kt][e];
}

__device__ __forceinline__ void gla_vload(const bf16* __restrict__ P2, size_t row0, int nvalid, int h, int n, int q, bf16x8* Vf) {
#pragma unroll
  for (int s = 0; s < 2; ++s) {
    u16 v[8];
#pragma unroll
    for (int e = 0; e < 8; ++e) {
      const int jj = 32 * s + (e < 4 ? 4 * q + e : 16 + 4 * q + (e - 4));
      v[e] = (jj < nvalid) ? *reinterpret_cast<const u16*>(P2 + (row0 + jj) * 2048 + 1024 + h * 128 + n) : (u16)0;
    }
    Vf[s] = mk_frag((u32)v[0] | ((u32)v[1] << 16), (u32)v[2] | ((u32)v[3] << 16), (u32)v[4] | ((u32)v[5] << 16), (u32)v[6] | ((u32)v[7] << 16));
  }
}
__device__ __forceinline__ void gla_scan(const Params& p, int l, int b, int h, const int tid) {
  unsigned char* ws = p.ws;
  const LAS unsigned char* lds = (const LAS unsigned char*)smem_raw;
  asm volatile("" : "+v"(lds));
  const bf16* P2 = (const bf16*)(ws + OFF_R3);
  bf16* O = (bf16*)(ws + OFF_R2);
  const int wid = tid >> 6, lane = tid & 63, r = lane & 15, q = lane >> 4;
  const int n = 16 * wid + r;
  const unsigned char* img0 = ws + OFF_GLA_IMG + (size_t)((b * 4 + h) * NCH) * GLA_IMG;
  f32x4 S[4];
#pragma unroll
  for (int k = 0; k < 4; ++k) S[k] = f32x4{0.f, 0.f, 0.f, 0.f};
  constexpr int BUF = 24576;
  img_load(img0, BUF, 0, tid);
  bf16x8 Vn[2];
  f32x4 atn[4];
  gla_vload(P2, (size_t)b * LP, 16, h, n, q, Vn);
#pragma unroll
  for (int kt = 0; kt < 4; ++kt) atn[kt] = *reinterpret_cast<const f32x4*>(img0 + 24576 + (16 * kt + 4 * q) * 4);
  u32x2 opk[4];
#pragma unroll
  for (int it = 0; it < 4; ++it) opk[it] = u32x2{0u, 0u};
  asm volatile("s_waitcnt vmcnt(0)" ::: "memory");
  __syncthreads();
#pragma unroll 1
  for (int c = 0; c < NCH; ++c) {
    const unsigned char* img = img0 + (size_t)c * GLA_IMG;
    bf16x8 Vf[2];
    f32x4 at[4];
    Vf[0] = Vn[0]; Vf[1] = Vn[1];
#pragma unroll
    for (int kt = 0; kt < 4; ++kt) at[kt] = atn[kt];
    if (c + 1 < NCH) {
      img_load(img + GLA_IMG, BUF, ((c + 1) & 1) * BUF, tid);
      gla_vload(P2, (size_t)b * LP + 16 + 64 * c, 64, h, n, q, Vn);
#pragma unroll
      for (int kt = 0; kt < 4; ++kt) atn[kt] = *reinterpret_cast<const f32x4*>(img + GLA_IMG + 24576 + (16 * kt + 4 * q) * 4);
    }
    if (c > 0) {
      const int tbp = (c == 1) ? 0 : 16 + 64 * (c - 2), nvp = (c == 1) ? 16 : 64;
      const size_t rowp = (size_t)b * LP + tbp;
#pragma unroll
      for (int it = 0; it < 4; ++it)
#pragma unroll
        for (int e = 0; e < 4; ++e) {
          const int i = 16 * it + 4 * q + e;
          const u32 w = (e < 2) ? opk[it].x : opk[it].y;
          if (i < nvp) *reinterpret_cast<u16*>(O + (rowp + i) * 1024 + 512 + h * 128 + n) = (u16)((e & 1) ? (w >> 16) : (w & 0xffffu));
        }
    }
    const LAS unsigned char* buf = lds + (c & 1) * BUF;
    bf16x8 Sf[2];
    Sf[0] = frag_from_tiles(S[0], S[1]);
    Sf[1] = frag_from_tiles(S[2], S[3]);
#pragma unroll
    for (int it = 0; it < 4; ++it) {
      f32x4 o = {0.f, 0.f, 0.f, 0.f};
#pragma unroll
      for (int ks = 0; ks < 2; ++ks) o = MFMA16(lds_frag16(buf + (it * 2 + ks) * 1024 + lane * 16), Sf[ks], o);
#pragma unroll
      for (int s = 0; s < 2; ++s) o = MFMA16(lds_frag16(buf + 8192 + (it * 2 + s) * 1024 + lane * 16), Vf[s], o);
      opk[it].x = pk2(o[0], o[1]); opk[it].y = pk2(o[2], o[3]);
    }
    __builtin_amdgcn_sched_barrier(0);
#pragma unroll
    for (int kt = 0; kt < 4; ++kt) {
      f32x4 sv = S[kt] * at[kt];
#pragma unroll
      for (int s = 0; s < 2; ++s) sv = MFMA16(lds_frag16(buf + 16384 + (kt * 2 + s) * 1024 + lane * 16), Vf[s], sv);
      S[kt] = sv;
    }
    asm volatile("s_waitcnt vmcnt(0)" ::: "memory");
    __syncthreads();
  }
  {
    const int tbp = 16 + 64 * (NCH - 2);
    const size_t rowp = (size_t)b * LP + tbp;
#pragma unroll
    for (int it = 0; it < 4; ++it)
#pragma unroll
      for (int e = 0; e < 4; ++e) {
        const int i = 16 * it + 4 * q + e;
        const u32 w = (e < 2) ? opk[it].x : opk[it].y;
        *reinterpret_cast<u16*>(O + (rowp + i) * 1024 + 512 + h * 128 + n) = (u16)((e & 1) ? (w >> 16) : (w & 0xffffu));
      }
  }
  float* so = p.out + OUT_GLAP + (((size_t)l * NBATCH + b) * 4 + h) * 64 * 128 + n;
#pragma unroll
  for (int kt = 0; kt < 4; ++kt)
#pragma unroll
    for (int e = 0; e < 4; ++e) so[(size_t)(16 * kt + 4 * q + e) * 128] = S[kt][e];
}

__device__ __forceinline__ void phase_scan(const Params& p, int l) {
  const int tid = opaque_tid();
  const int wid = tid >> 6;
  for (int j = blockIdx.x; j < 64; j += gridDim.x) {
    if (j < 32) gdn_scan(p, l, j >> 2, j & 3, tid);
    else gla_scan(p, l, (j - 32) >> 2, j & 3, tid);
  }
  const int nsw = gridDim.x > 64 ? (int)gridDim.x - 64 : (int)gridDim.x;
  const int myw = gridDim.x > 64 ? (int)blockIdx.x - 64 : (int)blockIdx.x;
  if (myw >= 0) {
    float* lds = (float*)(smem_raw + wid * 2048);
    for (int s = myw * NWAVES + wid; s < 2048; s += nsw * NWAVES) {
      const int j = s & 1023;
      if (s < 1024) gdn_job(p, l, j >> 3, (j >> 1) & 3, j & 1, lds, tid);
      else gla_job(p, l, j >> 3, (j >> 1) & 3, j & 1, true, lds, tid);
    }
  }
}

__device__ __forceinline__ void phase_gnorm(const Params& p, int l) {
  const int tid = opaque_tid();
  unsigned char* ws = p.ws;
  const bf16* P2 = (const bf16*)(ws + OFF_R3);
  bf16* O = (bf16*)(ws + OFF_R2);
  const int wid = tid >> 6, lane = tid & 63;
  const int gw = blockIdx.x * NWAVES + wid, NGW = gridDim.x * NWAVES;
  const int cw = (lane & 15) * 8;
  float wA[8], wB[8];
#pragma unroll
  for (int e = 0; e < 8; ++e) { wA[e] = p.in[10][l * 128 + cw + e]; wB[e] = p.in[13][l * 128 + cw + e]; }
  for (int row = gw; row < MT; row += NGW) {
#pragma unroll
    for (int j = 0; j < 2; ++j) {
      const int c0 = j * 512 + lane * 8;
      float o[8], z[8];
      unpack8(*reinterpret_cast<const u32x4*>(O + (size_t)row * 1024 + c0), o);
      unpack8(*reinterpret_cast<const u32x4*>(P2 + (size_t)row * 2048 + (j == 0 ? 0 : 1536) + lane * 8), z);
      float ss = 0.f;
#pragma unroll
      for (int e = 0; e < 8; ++e) ss += o[e] * o[e];
      ss = sum16(ss);
      const float sc = rsqrtf(ss * (1.f / 128.f) + 1e-6f);
#pragma unroll
      for (int e = 0; e < 8; ++e) o[e] = o[e] * sc * (j == 0 ? wA[e] : wB[e]) * (z[e] * sigmoidf_(z[e]));
      *reinterpret_cast<u32x4*>(O + (size_t)row * 1024 + c0) = pack8(o);
    }
  }
}

__device__ __forceinline__ void phase_merge(const Params& p) {
  const int tid = opaque_tid();
  unsigned char* ws = p.ws;
  const bf16* O = (const bf16*)(ws + OFF_R2);
  const bf16* P3 = (const bf16*)(ws + OFF_R4);
  bf16* MG = (bf16*)(ws + OFF_R3);
  for (int u = 0;; ++u) {
    const int t = blockIdx.x + (u >> 1) * gridDim.x, br = u & 1;
    if (t >= 4 * 64) break;
    const int pn = t / 64, pm = t % 64, brow = pm * 256, bcol = pn * 256;
    {
      Acc acc; acc_zero(acc);
      gemm_kloop(acc, O + br * 512, 1024, (const bf16*)(ws + (br ? OFF_WB : OFF_WA)), 512, 512, brow, bcol, tid, true);
      int brow_e = brow;
      asm volatile("" : "+s"(brow_e));
      EPI_COORDS
#pragma unroll
      for (int ai = 0; ai < 2; ++ai)
#pragma unroll
        for (int bj = 0; bj < 2; ++bj)
#pragma unroll
          for (int m = 0; m < 4; ++m) {
            const int erow = brow_e + ai * 128 + wr * 64 + m * 16 + fr;
            const int ecol = bcol + bj * 128 + wc * 32 + 8 * fq;
            float g[8], r[8];
            unpack8(*reinterpret_cast<const u32x4*>(P3 + (size_t)erow * 2048 + br * 1024 + ecol), g);
            bf16* mp = MG + (size_t)erow * 1024 + ecol;
            const f32x4 v0 = acc[ai][bj][m][0], v1 = acc[ai][bj][m][1];
#pragma unroll
            for (int j = 0; j < 4; ++j) { r[j] = v0[j] * sigmoidf_(g[j]); r[4 + j] = v1[j] * sigmoidf_(g[4 + j]); }
            if (br) {
              float pv[8];
              unpack8(*reinterpret_cast<const u32x4*>(mp), pv);
#pragma unroll
              for (int j = 0; j < 8; ++j) r[j] += pv[j];
            }
            *reinterpret_cast<u32x4*>(mp) = pack8(r);
            __builtin_amdgcn_sched_barrier(0);
          }
    }
  }
  __syncthreads();
  tail_gemm<1>(p, O, 1024, (const bf16*)(ws + OFF_WA), 512, 512, 1024, 0, tid);
  tail_gemm<1>(p, O + 512, 1024, (const bf16*)(ws + OFF_WB), 512, 512, 1024, 1, tid);
}

__device__ __forceinline__ void phase_gemm_resid(const Params& p, const bf16* A, int lda, const bf16* Wt, int K) {
  const int tid = opaque_tid();
  unsigned char* ws = p.ws;
  const bf16* Xb = (const bf16*)(ws + OFF_XB);
  bf16* PL = (bf16*)(ws + OFF_R4);
  for (int t = blockIdx.x; t < 4 * 64; t += gridDim.x) {
    const int pn = t / 64, pm = t % 64, brow = pm * 256, bcol = pn * 256;
    Acc acc; acc_zero(acc);
    gemm_kloop(acc, A, lda, Wt, K, K, brow, bcol, tid, true);
    EPI_COORDS
#pragma unroll
    for (int ai = 0; ai < 2; ++ai)
#pragma unroll
      for (int bj = 0; bj < 2; ++bj)
#pragma unroll
        for (int m = 0; m < 4; ++m) {
          const size_t off = (size_t)(brow + ai * 128 + wr * 64 + m * 16 + fr) * 1024 + bcol + bj * 128 + wc * 32 + 8 * fq;
          float x[8], r[8];
          unpack8(*reinterpret_cast<const u32x4*>(Xb + off), x);
          const f32x4 v0 = acc[ai][bj][m][0], v1 = acc[ai][bj][m][1];
#pragma unroll
          for (int j = 0; j < 4; ++j) { r[j] = v0[j] + ALPHA * x[j]; r[4 + j] = v1[j] + ALPHA * x[4 + j]; }
          *reinterpret_cast<u32x4*>(PL + off) = pack8(r);
        }
  }
  __syncthreads();
  tail_gemm<2>(p, A, lda, Wt, K, K, 1024, 0, tid);
}

__device__ __forceinline__ void phase_ffn_in(const Params& p) {
  const int tid = opaque_tid();
  unsigned char* ws = p.ws;
  const bf16* Xb = (const bf16*)(ws + OFF_XB);
  bf16* H = (bf16*)(ws + OFF_R2);
  for (int t = blockIdx.x; t < 22 * NMT; t += gridDim.x) {
    int pn, pm;
    tile_xcd(t, 22, pm, pn);
    const int brow = pm * 256, bcol = pn * 256;
    Acc acc; acc_zero(acc);
    gemm_kloop(acc, Xb, 1024, (const bf16*)(ws + OFF_WFI), 1024, 1024, brow, bcol, tid);
    EPI_COORDS
#pragma unroll
    for (int ai = 0; ai < 2; ++ai)
#pragma unroll
      for (int m = 0; m < 4; ++m) {
        float r[8];
#pragma unroll
        for (int bj = 0; bj < 2; ++bj) {
          const f32x4 a = acc[ai][bj][m][0], u = acc[ai][bj][m][1];
#pragma unroll
          for (int j = 0; j < 4; ++j) r[bj * 4 + j] = a[j] * sigmoidf_(a[j]) * u[j];
        }
        const int hc = (bcol >> 1) + wc * 32 + fq * 8;
        *reinterpret_cast<u32x4*>(H + (size_t)(brow + ai * 128 + wr * 64 + m * 16 + fr) * DFF + hc) = pack8(r);
      }
  }
}

__device__ __forceinline__ void phase_ln(const Params& p, const float* g, const float* bta, bool final_out) {
  const int tid = opaque_tid();
  unsigned char* ws = p.ws;
  const bf16* PL = (const bf16*)(ws + OFF_R4);
  bf16* Xb = (bf16*)(ws + OFF_XB);
  const int wid = tid >> 6, lane = tid & 63;
  const int gw = blockIdx.x * NWAVES + wid, NGW = gridDim.x * NWAVES;
  float gg[2][8], bb[2][8];
#pragma unroll
  for (int j = 0; j < 2; ++j)
#pragma unroll
    for (int e = 0; e < 8; e += 4) {
      const f32x4 gv = *reinterpret_cast<const f32x4*>(g + j * 512 + lane * 8 + e), bv = *reinterpret_cast<const f32x4*>(bta + j * 512 + lane * 8 + e);
      gg[j][e] = gv[0]; gg[j][e + 1] = gv[1]; gg[j][e + 2] = gv[2]; gg[j][e + 3] = gv[3];
      bb[j][e] = bv[0]; bb[j][e + 1] = bv[1]; bb[j][e + 2] = bv[2]; bb[j][e + 3] = bv[3];
    }
  for (int row = gw; row < MT; row += NGW) {
    float v[2][8];
    float s = 0.f;
#pragma unroll
    for (int j = 0; j < 2; ++j) {
      unpack8(*reinterpret_cast<const u32x4*>(PL + (size_t)row * 1024 + j * 512 + lane * 8), v[j]);
#pragma unroll
      for (int e = 0; e < 8; ++e) s += v[j][e];
    }
    const float mean = sum64(s) * (1.f / 1024.f);
    float s2 = 0.f;
#pragma unroll
    for (int j = 0; j < 2; ++j)
#pragma unroll
      for (int e = 0; e < 8; ++e) { v[j][e] -= mean; s2 += v[j][e] * v[j][e]; }
    const float rstd = rsqrtf(sum64(s2) * (1.f / 1024.f) + 1e-5f);
    float* dst = nullptr;
    if (final_out) {
      if (row < MP) {
        const int b = row / LP, t = row - b * LP;
        if (t >= 16) dst = p.out + OUT_YP + ((size_t)b * 2048 + (t - 16)) * 1024;
      } else {
        dst = p.out + OUT_YS + (size_t)(row - MP) * 1024;
      }
    }
#pragma unroll
    for (int j = 0; j < 2; ++j) {
      float y[8];
#pragma unroll
      for (int e = 0; e < 8; ++e) y[e] = v[j][e] * rstd * gg[j][e] + bb[j][e];
      if (final_out) {
        if (dst) {
          *reinterpret_cast<f32x4*>(dst + j * 512 + lane * 8) = f32x4{y[0], y[1], y[2], y[3]};
          *reinterpret_cast<f32x4*>(dst + j * 512 + lane * 8 + 4) = f32x4{y[4], y[5], y[6], y[7]};
        }
      } else {
        *reinterpret_cast<u32x4*>(Xb + (size_t)row * 1024 + j * 512 + lane * 8) = pack8(y);
      }
    }
  }
}

#define XB_TMO      128
#define XB_XCNT(j)  (256  + 64 * (j))
#define XB_XSUB(j)  (1280 + 64 * (j))
#define XB_XGEN(j)  (2304 + 64 * (j))
#define XB_TOP      3328
#define XB_TOPGEN   3392
#define XCD_BAR_WORDS 3456
#define XB_SPIN_CAP (1u << 18)

__device__ __forceinline__ unsigned xb_ld(unsigned* p)              { return __hip_atomic_load(p, __ATOMIC_RELAXED, __HIP_MEMORY_SCOPE_AGENT); }
__device__ __forceinline__ unsigned xb_add(unsigned* p, unsigned v) { return __hip_atomic_fetch_add(p, v, __ATOMIC_RELAXED, __HIP_MEMORY_SCOPE_AGENT); }
__device__ __forceinline__ unsigned xb_xcc_id() { return (unsigned)__builtin_amdgcn_s_getreg((3 << 11) | 20) & 0xFu; }
#define XB_SPIN(cond, bar) do { unsigned _sp = 0; while (cond) { __builtin_amdgcn_s_sleep(1); \
    if ((++_sp & 255u) == 0u) { if (xb_ld(&(bar)[XB_TMO])) break; if (_sp > XB_SPIN_CAP) { atomicAdd(&(bar)[XB_TMO], 1u); break; } } } } while (0)

struct XcdBarrier {
    unsigned* bar; unsigned x;
    volatile LAS unsigned* st;
};

__device__ __forceinline__ XcdBarrier xcd_barrier_post(unsigned* bar, volatile LAS unsigned* st) {
    XcdBarrier b; b.bar = bar; b.x = xb_xcc_id(); b.st = st;
    if (threadIdx.x == 0) (void)xb_add(&bar[XB_XCNT(b.x)], 1u);
    return b;
}
__device__ __forceinline__ void xcd_barrier_complete(unsigned* bar, unsigned x, unsigned& nloc, unsigned& nx) {
    const unsigned G = gridDim.x * gridDim.y * gridDim.z;
    unsigned sum, cnt, mine, sp = 0u;
    for (;;) {
        sum = 0u; cnt = 0u; mine = 0u;
#pragma unroll
        for (unsigned j = 0; j < 16; ++j) { const unsigned c = xb_ld(&bar[XB_XCNT(j)]); sum += c; cnt += (c > 0u) ? 1u : 0u; mine = (j == x) ? c : mine; }
        if (sum == G) break;
        __builtin_amdgcn_s_sleep(1);
        if ((++sp & 255u) == 0u) { if (xb_ld(&bar[XB_TMO])) break; if (sp > XB_SPIN_CAP) { atomicAdd(&bar[XB_TMO], 1u); break; } }
    }
    nloc = mine > 0u ? mine : 1u; nx = cnt > 0u ? cnt : 1u;
}

__device__ __forceinline__ void xcd_barrier(const XcdBarrier& b) {
    asm volatile("s_waitcnt vmcnt(0)" ::: "memory");
    __syncthreads();
    if (threadIdx.x == 0) {
        unsigned* bar = b.bar;
        __builtin_amdgcn_s_waitcnt(0);
        unsigned nloc = b.st[0], nx = b.st[1];
        if (nloc == 0u) { xcd_barrier_complete(bar, b.x, nloc, nx); b.st[0] = nloc; b.st[1] = nx; }
        const unsigned old = xb_add(&bar[XB_XSUB(b.x)], 1u);
        const unsigned gen = old / nloc;
        if (old + 1u == (gen + 1u) * nloc) {
            __builtin_amdgcn_fence(__ATOMIC_RELEASE, "agent");
            asm volatile("s_waitcnt vmcnt(0)" ::: "memory");
            const unsigned og = xb_add(&bar[XB_TOP], 1u);
            const unsigned tg = og / nx;
            if (og + 1u == (tg + 1u) * nx) xb_add(&bar[XB_TOPGEN], 1u);
            else XB_SPIN(xb_ld(&bar[XB_TOPGEN]) == tg, bar);
            __builtin_amdgcn_fence(__ATOMIC_ACQUIRE, "agent");
            xb_add(&bar[XB_XGEN(b.x)], 1u);
            asm volatile("s_waitcnt vmcnt(0)" ::: "memory");
        } else {
            XB_SPIN(xb_ld(&bar[XB_XGEN(b.x)]) == gen, bar);
            __builtin_amdgcn_fence(__ATOMIC_ACQUIRE, "agent");
            asm volatile("s_waitcnt vmcnt(0)" ::: "memory");
        }
    }
    __syncthreads();
}


__global__ void __launch_bounds__(NTHREADS, 2) fwd_kernel(Params p_in) {
  volatile LAS unsigned* xb_st = (volatile LAS unsigned*)((LAS unsigned char*)smem_raw + 131072);
  if (threadIdx.x == 0) { xb_st[0] = 0u; xb_st[1] = 0u; xb_st[2] = 0u; xb_st[3] = 0u; }
  __syncthreads();
  const XcdBarrier xb = xcd_barrier_post((unsigned*)(p_in.ws + OFF_BAR), xb_st);
  for (int ph = p_in.ph_lo; ph < p_in.ph_hi; ++ph) {
    const int l = ph / PH_PER_LAYER, k = ph % PH_PER_LAYER;
    Params p = p_in;
    {
      unsigned long long wsi = (unsigned long long)p_in.ws, outi = (unsigned long long)p_in.out;
      asm volatile("" : "+s"(wsi), "+s"(outi));
      p.ws = (unsigned char*)(__attribute__((address_space(1))) unsigned char*)wsi;
      p.out = (float*)(__attribute__((address_space(1))) float*)outi;
    }
    unsigned char* ws = p.ws;
    const int nrep = 1 + ((REPEAT_MASK >> k) & 1);
    for (int rep = 0; rep < nrep; ++rep) {
    if (rep) xcd_barrier(xb);
    switch (k) {
      case 0: if (l == 0) phase_convert(p, 0, 1 | 8, 0); break;
      case 1: phase_gemm_in(p, false); break;
      case 2: phase_pre(p, l); break;
      case 3: phase_scan(p, l);
              __syncthreads();
              phase_convert(p, l, 2 | 4, gridDim.x > 64 ? 64 : 0);
              break;
      case 4: phase_gnorm(p, l); phase_gemm_in(p, true); break;
      case 5: break;
      case 6: phase_merge(p); break;
      case 7: phase_gemm_resid(p, (const bf16*)(ws + OFF_R3), 1024, (const bf16*)(ws + OFF_WO), 1024); break;
      case 8: phase_ln(p, p.in[17] + l * 1024, p.in[18] + l * 1024, false);
              if (l == 0) phase_convert(p, 1, 1, 0);
              break;
      case 9: phase_ffn_in(p); break;
      case 10: phase_gemm_resid(p, (const bf16*)(ws + OFF_R2), DFF, (const bf16*)(ws + OFF_WFO), DFF); break;
      case 11: phase_ln(p, p.in[19] + l * 1024, p.in[20] + l * 1024, l == 1);
               break;
    }
    }
#if EXTRA_SYNCS
    for (int xs = 0; xs < EXTRA_SYNCS; ++xs) xcd_barrier(xb);
#endif
    const bool empty_phase = (k == 5) || (k == 0 && l > 0);
    if (ph + 1 < p_in.ph_hi && !empty_phase) {
      if (p_in.ph_hi > NPHASES) { __syncthreads(); cg::this_grid().sync(); }
      xcd_barrier(xb);
    }
  }
}

extern "C" void kernel_launch(void* const* d_in, const int* in_sizes, int n_in, void* d_out, int out_size, void* d_ws,
                              size_t ws_size, hipStream_t stream) {
  constexpr int LDS_BYTES = 131072 + 16;
  static int grid = 0;
  if (grid == 0) {
    int dev = 0, cus = 0;
    hipGetDevice(&dev);
    hipDeviceGetAttribute(&cus, hipDeviceAttributeMultiprocessorCount, dev);
    hipFuncSetAttribute((const void*)fwd_kernel, hipFuncAttributeMaxDynamicSharedMemorySize, LDS_BYTES);
    int per_cu = 0;
    hipOccupancyMaxActiveBlocksPerMultiprocessor(&per_cu, (const void*)fwd_kernel, NTHREADS, LDS_BYTES);
    (void)hipGetLastError();
    grid = cus > 0 ? cus : 256;
    if (ws_size < WS_END) fprintf(stderr, "kernel_launch: workspace too small: %zu < %zu\n", ws_size, (size_t)WS_END);
    if (per_cu < 1) fprintf(stderr, "kernel_launch: occupancy query says %d blocks per CU\n", per_cu);
  }
  Params p{};
  for (int i = 0; i < 23; ++i) p.in[i] = (const float*)d_in[i];
  p.out = (float*)d_out;
  p.ws = (unsigned char*)d_ws;
  (void)hipMemsetAsync((unsigned char*)d_ws + OFF_BAR, 0, BAR_BYTES, stream);
#if SINGLE_LAUNCH
  p.ph_lo = 0; p.ph_hi = NPHASES;
  void* args[] = {&p};
  hipError_t e = hipLaunchCooperativeKernel((const void*)fwd_kernel, dim3(grid), dim3(NTHREADS), args, LDS_BYTES, stream);
  if (e != hipSuccess) fprintf(stderr, "cooperative launch failed: %s (grid %d)\n", hipGetErrorString(e), grid);
#else
  for (int ph = 0; ph < NPHASES; ++ph) {
    p.ph_lo = ph; p.ph_hi = ph + 1;
    hipLaunchKernelGGL(fwd_kernel, dim3(grid), dim3(NTHREADS), LDS_BYTES, stream, p);
  }
#endif
}
```

```cpp
#include <hip/hip_runtime.h>
#include <hip/hip_bf16.h>
#include <hip/hip_cooperative_groups.h>
#include <cstdio>
namespace cg = cooperative_groups;

#ifndef SINGLE_LAUNCH
#define SINGLE_LAUNCH 1
#endif
#ifndef REPEAT_MASK
#define REPEAT_MASK 0
#endif
#ifndef EXTRA_SYNCS
#define EXTRA_SYNCS 0
#endif

typedef __hip_bfloat16 bf16;
typedef unsigned short u16;
typedef unsigned int u32;
using bf16x8 = __attribute__((ext_vector_type(8))) short;
using f32x4 = __attribute__((ext_vector_type(4))) float;
using u32x4 = __attribute__((ext_vector_type(4))) unsigned int;
using u32x2 = __attribute__((ext_vector_type(2))) unsigned int;

constexpr int D = 1024;
constexpr int NBATCH = 8, LP = 2064, MP = NBATCH * LP;
constexpr int NS = 128;
constexpr int MT = MP + NS;
constexpr int NMT = MT / 256;
constexpr int DIN_SRC = 5656, DIN_PAD = 5888;
constexpr int DFF = 2816;
constexpr int NTHREADS = 512, NWAVES = 8;
constexpr int PH_PER_LAYER = 12, NPHASES = 2 * PH_PER_LAYER;
constexpr float ALPHA = 1.4142135623730951f;

constexpr size_t SZ_WIN = (size_t)DIN_PAD * 1024 * 2;
constexpr size_t SZ_WFI = (size_t)2 * DFF * 1024 * 2;
constexpr size_t SZ_WFO = (size_t)1024 * DFF * 2;
constexpr size_t SZ_WA = (size_t)1024 * 512 * 2;
constexpr size_t SZ_WO = (size_t)1024 * 1024 * 2;
constexpr size_t OFF_WIN = 0;
constexpr size_t OFF_WFI = OFF_WIN + SZ_WIN;
constexpr size_t OFF_WFO = OFF_WFI + SZ_WFI;
constexpr size_t OFF_WA = OFF_WFO + SZ_WFO;
constexpr size_t OFF_WB = OFF_WA + SZ_WA;
constexpr size_t OFF_WO = OFF_WB + SZ_WA;
constexpr size_t OFF_XB = OFF_WO + SZ_WO;
constexpr size_t OFF_R2 = OFF_XB + (size_t)MT * 1024 * 2;
constexpr size_t OFF_R3 = OFF_R2 + (size_t)MT * 1536 * 2;
constexpr size_t OFF_R4 = OFF_R3 + (size_t)MT * 2048 * 2;
constexpr size_t R4_BYTES = (size_t)1056 * (73728 + 25088);
constexpr size_t OFF_R5 = OFF_R4 + R4_BYTES;
constexpr size_t OFF_GT = OFF_R5 + (size_t)MT * 32 * 4;
constexpr size_t OFF_QS = OFF_GT + 8192;
constexpr size_t OFF_BAR = OFF_QS + (size_t)NS * 1536 * 2;
constexpr size_t BAR_BYTES = 16384;
constexpr size_t WS_END = OFF_BAR + BAR_BYTES;
static_assert(WS_END <= (size_t)305000000, "workspace budget");
static_assert(R4_BYTES >= (size_t)MT * 1024 * 4, "R4 must hold preLN");

constexpr size_t OUT_YP = 0;
constexpr size_t OUT_YS = OUT_YP + (size_t)8 * 2048 * 1024;
constexpr size_t OUT_GDNP = OUT_YS + (size_t)128 * 1024;
constexpr size_t OUT_GLAP = OUT_GDNP + (size_t)2 * 8 * 4 * 128 * 128;
constexpr size_t OUT_CONVP = OUT_GLAP + (size_t)2 * 8 * 4 * 64 * 128;
constexpr size_t OUT_GDNS = OUT_CONVP + (size_t)2 * 8 * 3 * 1536;
constexpr size_t OUT_GLAS = OUT_GDNS + (size_t)2 * 128 * 4 * 128 * 128;
constexpr size_t OUT_CONVS = OUT_GLAS + (size_t)2 * 128 * 4 * 64 * 128;

struct Params {
  const float* in[23];
  float* out;
  unsigned char* ws;
  int ph_lo, ph_hi;
};

typedef float f32x2_t __attribute__((ext_vector_type(2)));
typedef __bf16 bf16x2_t __attribute__((ext_vector_type(2)));
__device__ __forceinline__ u32 pk2(float lo, float hi) {
  f32x2_t v = {lo, hi};
  bf16x2_t b = __builtin_convertvector(v, bf16x2_t);
  return __builtin_bit_cast(u32, b);
}
__device__ __forceinline__ u16 f2bf(float x) { return (u16)(pk2(x, 0.f) & 0xffffu); }
__device__ __forceinline__ float bflo(u32 w) { return __uint_as_float(w << 16); }
__device__ __forceinline__ float bfhi(u32 w) { return __uint_as_float(w & 0xffff0000u); }
__device__ __forceinline__ float bf1(u16 h) { return __uint_as_float(((u32)h) << 16); }
__device__ __forceinline__ void unpack8(const u32x4 v, float* f) {
  f[0] = bflo(v.x); f[1] = bfhi(v.x); f[2] = bflo(v.y); f[3] = bfhi(v.y);
  f[4] = bflo(v.z); f[5] = bfhi(v.z); f[6] = bflo(v.w); f[7] = bfhi(v.w);
}
__device__ __forceinline__ u32x4 pack8(const float* f) {
  u32x4 v; v.x = pk2(f[0], f[1]); v.y = pk2(f[2], f[3]); v.z = pk2(f[4], f[5]); v.w = pk2(f[6], f[7]);
  return v;
}
template <int X> __device__ __forceinline__ float swz_xor(float v) {
  return __int_as_float(__builtin_amdgcn_ds_swizzle(__float_as_int(v), (X << 10) | 0x1f));
}
__device__ __forceinline__ float sum8(float v) {
  v += swz_xor<1>(v); v += swz_xor<2>(v); v += swz_xor<4>(v);
  return v;
}
__device__ __forceinline__ float sum16(float v) {
  v += swz_xor<1>(v); v += swz_xor<2>(v); v += swz_xor<4>(v); v += swz_xor<8>(v);
  return v;
}
__device__ __forceinline__ float sum64(float v) {
  v += swz_xor<1>(v); v += swz_xor<2>(v); v += swz_xor<4>(v); v += swz_xor<8>(v); v += swz_xor<16>(v);
  return __int_as_float(__builtin_amdgcn_readlane(__float_as_int(v), 0)) + __int_as_float(__builtin_amdgcn_readlane(__float_as_int(v), 32));
}
__device__ __forceinline__ float sigmoidf_(float x) { return __builtin_amdgcn_rcpf(1.f + __expf(-x)); }
__device__ __forceinline__ float softplusf_(float x) { return x > 20.f ? x : __logf(1.f + __expf(x)); }

extern __shared__ __attribute__((aligned(16))) unsigned char smem_raw[];
__device__ __forceinline__ int opaque_tid() { int t = threadIdx.x; asm volatile("" : "+v"(t)); return t; }

constexpr int HT = 128 * 64;
__device__ __forceinline__ int lds_byte(int r, int c) {
  int st = (r >> 4) * 2 + (c >> 5), rr = r & 15, cc = c & 31, ob = rr * 64 + cc * 2;
  return st * 1024 + (ob ^ (((ob >> 9) & 1) << 5));
}
__device__ __forceinline__ void stage_rc(int b, int& R, int& C) {
  int st = b / 1024, sb = b % 1024, swz = sb ^ (((sb >> 9) & 1) << 5);
  R = (st >> 1) * 16 + swz / 64;
  C = (st & 1) * 32 + (swz % 64) / 2;
}

typedef f32x4 Acc[2][2][4][2];

#define LAS __attribute__((address_space(3)))
__device__ __forceinline__ void gemm_kloop(Acc& acc, const bf16* __restrict__ A, int lda, const bf16* __restrict__ Bt, int ldb,
                                           int K, int brow, int bcol, const int tid, const bool perm = false) {
  LAS unsigned char* lds = (LAS unsigned char*)smem_raw;
  const int wid = __builtin_amdgcn_readfirstlane(tid >> 6), lane = tid & 63, wr = wid >> 2, wc = wid & 3,
            fr = lane & 15, fq = lane >> 4;
  unsigned voffA[2], voffB[2];
#pragma unroll
  for (int i = 0; i < 2; ++i) {
    int R, C;
    stage_rc(tid * 16 + i * 8192, R, C);
    voffA[i] = (unsigned)(R * lda + C) * 2u;
    const int p32 = R & 31, Rb = perm ? ((R & ~31) + 8 * ((p32 & 15) >> 2) + 4 * (p32 >> 4) + (p32 & 3)) : R;
    voffB[i] = (unsigned)(Rb * ldb + C) * 2u;
  }
  const size_t kstep = 128, hA = (size_t)128 * lda * 2, hB = (size_t)128 * ldb * 2;
  const unsigned ldsw = (unsigned)wid * 1024u;
  const int aoff = lds_byte(wr * 64 + fr, fq * 8), boff = lds_byte(wc * 32 + fr, fq * 8);
  const char* cA = (const char*)A + (size_t)brow * lda * 2;
  const char* cB = (const char*)Bt + (size_t)bcol * ldb * 2;
#define SA(b, h) (((b) * 2 + (h)) * 16384)
#define SB(b, h) ((4 + (b) * 2 + (h)) * 16384)
#define STAGE(bufoff, gbase, voff)                                                                             \
  do {                                                                                                         \
    _Pragma("unroll") for (int _i = 0; _i < 2; ++_i)                                                           \
        __builtin_amdgcn_global_load_lds((const unsigned*)((const char*)(gbase) + (voff)[_i]),                 \
                                         (LAS unsigned*)(lds + (bufoff) + ldsw + _i * 8192), 16, 0, 0);        \
  } while (0)
#define LDA(dst, b, h)                                                                                         \
  do {                                                                                                         \
    _Pragma("unroll") for (int m = 0; m < 4; ++m) _Pragma("unroll") for (int k = 0; k < 2; ++k)                \
        dst[m][k] = *(const LAS bf16x8*)(lds + SA(b, h) + aoff + m * 2048 + k * 1024);                         \
  } while (0)
#define LDB(dst, b, h)                                                                                         \
  do {                                                                                                         \
    _Pragma("unroll") for (int n = 0; n < 2; ++n) _Pragma("unroll") for (int k = 0; k < 2; ++k)                \
        dst[n][k] = *(const LAS bf16x8*)(lds + SB(b, h) + boff + n * 2048 + k * 1024);                         \
  } while (0)
#define MMA(ai, bj, At_, Bt_)                                                                                  \
  do {                                                                                                         \
    __builtin_amdgcn_s_setprio(1);                                                                             \
    _Pragma("unroll") for (int m = 0; m < 4; ++m) _Pragma("unroll") for (int n = 0; n < 2; ++n)                \
    _Pragma("unroll") for (int k = 0; k < 2; ++k)                                                              \
        acc[ai][bj][m][n] = __builtin_amdgcn_mfma_f32_16x16x32_bf16(Bt_[n][k], At_[m][k], acc[ai][bj][m][n], 0, 0, 0); \
    __builtin_amdgcn_s_setprio(0);                                                                             \
  } while (0)
#define WAIT_V(n) asm volatile("s_waitcnt vmcnt(" #n ")" ::: "memory")
#define WAIT_L(n) asm volatile("s_waitcnt lgkmcnt(" #n ")" ::: "memory")
#define BAR __builtin_amdgcn_s_barrier()
#define SCHED __builtin_amdgcn_sched_barrier(0)
  bf16x8 At[4][2], B0[2][2], B1[2][2];
  const int nt = K / 64;
  STAGE(SB(0, 0), cB, voffB); STAGE(SA(0, 0), cA, voffA); STAGE(SB(0, 1), cB + hB, voffB); STAGE(SA(0, 1), cA + hA, voffA);
  if (wr == 1) BAR;
  WAIT_V(4); BAR;
  STAGE(SB(1, 0), cB + kstep, voffB); STAGE(SA(1, 0), cA + kstep, voffA); STAGE(SB(1, 1), cB + hB + kstep, voffB);
  WAIT_V(6); BAR;
#pragma unroll 1
  for (int t = 0; t < nt - 2; t += 2) {
    const char* a1 = cA + (size_t)(t + 1) * kstep;
    const char* a2 = cA + (size_t)(t + 2) * kstep;
    const char* b2 = cB + (size_t)(t + 2) * kstep;
    const char* a3 = a2 + kstep;
    const char* b3 = b2 + kstep;
    LDB(B0, 0, 0); SCHED; LDA(At, 0, 0); STAGE(SA(1, 1), a1 + hA, voffA);
    WAIT_L(8); BAR; WAIT_L(0); MMA(0, 0, At, B0); BAR; SCHED;
    LDB(B1, 0, 1); STAGE(SB(0, 0), b2, voffB);
    BAR; WAIT_L(0); MMA(0, 1, At, B1); BAR;
    LDA(At, 0, 1); STAGE(SA(0, 0), a2, voffA);
    BAR; WAIT_L(0); MMA(1, 0, At, B0); BAR; SCHED;
    STAGE(SB(0, 1), b2 + hB, voffB);
    WAIT_V(6); BAR; MMA(1, 1, At, B1); BAR;
    LDB(B0, 1, 0); SCHED; LDA(At, 1, 0); STAGE(SA(0, 1), a2 + hA, voffA);
    WAIT_L(8); BAR; WAIT_L(0); MMA(0, 0, At, B0); BAR; SCHED;
    LDB(B1, 1, 1); STAGE(SB(1, 0), b3, voffB);
    BAR; WAIT_L(0); MMA(0, 1, At, B1); BAR;
    LDA(At, 1, 1); STAGE(SA(1, 0), a3, voffA);
    BAR; WAIT_L(0); MMA(1, 0, At, B0); BAR; SCHED;
    STAGE(SB(1, 1), b3 + hB, voffB);
    WAIT_V(6); BAR; MMA(1, 1, At, B1); BAR;
  }
  {
    const char* a1 = cA + (size_t)(nt - 1) * kstep;
    LDB(B0, 0, 0); LDA(At, 0, 0); STAGE(SA(1, 1), a1 + hA, voffA);
    BAR; WAIT_L(0); MMA(0, 0, At, B0); BAR;
    LDB(B1, 0, 1); BAR; WAIT_L(0); MMA(0, 1, At, B1); BAR;
    LDA(At, 0, 1); WAIT_V(4); BAR; WAIT_L(0); MMA(1, 0, At, B0); MMA(1, 1, At, B1); BAR;
  }
  {
    LDB(B0, 1, 0); LDA(At, 1, 0); WAIT_V(2); BAR; WAIT_L(0); MMA(0, 0, At, B0); BAR;
    LDB(B1, 1, 1); WAIT_V(0); BAR; WAIT_L(0); MMA(0, 1, At, B1); BAR;
    LDA(At, 1, 1); BAR; WAIT_L(0); MMA(1, 0, At, B0); MMA(1, 1, At, B1); BAR;
  }
  if (wr == 0) BAR;
#undef SA
#undef SB
#undef STAGE
#undef LDA
#undef LDB
#undef MMA
}

__device__ __forceinline__ void acc_zero(Acc& acc) {
#pragma unroll
  for (int a = 0; a < 2; ++a)
#pragma unroll
    for (int b = 0; b < 2; ++b)
#pragma unroll
      for (int m = 0; m < 4; ++m)
#pragma unroll
        for (int n = 0; n < 2; ++n) acc[a][b][m][n] = f32x4{0.f, 0.f, 0.f, 0.f};
}

#define EPI_COORDS                                                                                           \
  const int wid = tid >> 6, lane = tid & 63, wr = wid >> 2, wc = wid & 3, fr = lane & 15, fq = lane >> 4; \
  (void)wid;
#define EPI_LOOP                                                                                             \
  _Pragma("unroll") for (int ai = 0; ai < 2; ++ai) _Pragma("unroll") for (int bj = 0; bj < 2; ++bj)            \
  _Pragma("unroll") for (int m = 0; m < 4; ++m) _Pragma("unroll") for (int n = 0; n < 2; ++n)
#define EPI_ROW (brow + ai * 128 + wr * 64 + m * 16 + fr)
#define EPI_COL (bj * 128 + wc * 32 + n * 16 + fq * 4)

__device__ __forceinline__ void epi_store_bf16(const Acc& acc, bf16* dst, int ldd, int brow, const int tid) {
  EPI_COORDS
  EPI_LOOP {
    const f32x4 v = acc[ai][bj][m][n];
    u32x2 o; o.x = pk2(v[0], v[1]); o.y = pk2(v[2], v[3]);
    *reinterpret_cast<u32x2*>(dst + (size_t)EPI_ROW * ldd + EPI_COL) = o;
  }
}

__device__ __forceinline__ void epi_store_bf16_perm(const Acc& acc, bf16* dst, int ldd, int brow, const int tid) {
  EPI_COORDS
#pragma unroll
  for (int ai = 0; ai < 2; ++ai)
#pragma unroll
    for (int bj = 0; bj < 2; ++bj)
#pragma unroll
      for (int m = 0; m < 4; ++m) {
        const f32x4 v0 = acc[ai][bj][m][0], v1 = acc[ai][bj][m][1];
        u32x4 o; o.x = pk2(v0[0], v0[1]); o.y = pk2(v0[2], v0[3]); o.z = pk2(v1[0], v1[1]); o.w = pk2(v1[2], v1[3]);
        *reinterpret_cast<u32x4*>(dst + (size_t)(brow + ai * 128 + wr * 64 + m * 16 + fr) * ldd + bj * 128 + wc * 32 + 8 * fq) = o;
      }
}

__device__ __forceinline__ int srcmap_win(int d) {
  if (d < 2048) return d;
  if (d < 3584) return d + 8;
  if (d < 5632) return d + 24;
  if (d < 5640) return d - 5632 + 2048;
  if (d < 5656) return d - 5640 + 3592;
  return -1;
}
__device__ __forceinline__ int srcmap_ffi(int d) {
  const int tile = d >> 8, c = d & 255;
  const int bj = c >> 7, wc = (c >> 5) & 3, n = (c >> 4) & 1, i = c & 15;
  const int h = tile * 128 + wc * 32 + (i >> 2) * 8 + bj * 4 + (i & 3);
  return n ? (DFF + h) : h;
}
__device__ __forceinline__ void transpose_item(const float* __restrict__ W, int K, int Nsrc, bf16* __restrict__ WT, int mode,
                                               int item, float* scr, int lane) {
  const int nkb = K / 64, db = item / nkb, kb = item % nkb, k0 = kb * 64, d0 = db * 32;
  const int d = d0 + (lane & 7) * 4;
  const int s = (mode == 0) ? d : (mode == 1 ? srcmap_win(d) : srcmap_ffi(d));
#pragma unroll
  for (int i = 0; i < 8; ++i) {
    const int kk = 8 * i + (lane >> 3);
    f32x4 v = {0.f, 0.f, 0.f, 0.f};
    if (s >= 0) v = *reinterpret_cast<const f32x4*>(W + (size_t)(k0 + kk) * Nsrc + s);
    float* sp = scr + kk * 33 + (lane & 7) * 4;
    sp[0] = v[0]; sp[1] = v[1]; sp[2] = v[2]; sp[3] = v[3];
  }
  __builtin_amdgcn_wave_barrier();
  const int c = lane & 7;
#pragma unroll
  for (int j = 0; j < 4; ++j) {
    const int n = (lane >> 3) + 8 * j;
    const float* sp = scr + (8 * c) * 33 + n;
    u32x4 o;
    o.x = pk2(sp[0 * 33], sp[1 * 33]); o.y = pk2(sp[2 * 33], sp[3 * 33]);
    o.z = pk2(sp[4 * 33], sp[5 * 33]); o.w = pk2(sp[6 * 33], sp[7 * 33]);
    *reinterpret_cast<u32x4*>(WT + (size_t)(d0 + n) * K + k0 + 8 * c) = o;
  }
  __builtin_amdgcn_wave_barrier();
}

__device__ __forceinline__ void phase_convert(const Params& p, int l, int parts, int first_wg) {
  const int tid = opaque_tid();
  const int wid = tid >> 6, lane = tid & 63;
  if ((int)blockIdx.x < first_wg) return;
  float* scr = (float*)(smem_raw + wid * 8704);
  const int gw = ((int)blockIdx.x - first_wg) * NWAVES + wid, NGW = ((int)gridDim.x - first_wg) * NWAVES;
  constexpr int I_IN = (DIN_PAD / 32) * 16, I_FI = (2 * DFF / 32) * 16, I_FO = 32 * (DFF / 64), I_A = 32 * 8, I_O = 32 * 16;
  constexpr int NITEMS = I_IN + I_FI + I_FO + 2 * I_A + I_O;
  unsigned char* ws = p.ws;
  for (int it = gw; it < NITEMS; it += NGW) {
    int r = it;
    {
      const int grp = (r < I_IN) ? 0 : ((r < I_IN + I_FI + I_FO) ? 2 : 1);
      if (!((parts >> grp) & 1)) continue;
    }
    if (r < I_IN) { transpose_item(p.in[6] + (size_t)l * 1024 * DIN_SRC, 1024, DIN_SRC, (bf16*)(ws + OFF_WIN), 1, r, scr, lane); continue; }
    r -= I_IN;
    if (r < I_FI) { transpose_item(p.in[21] + (size_t)l * 1024 * 2 * DFF, 1024, 2 * DFF, (bf16*)(ws + OFF_WFI), 2, r, scr, lane); continue; }
    r -= I_FI;
    if (r < I_FO) { transpose_item(p.in[22] + (size_t)l * DFF * 1024, DFF, 1024, (bf16*)(ws + OFF_WFO), 0, r, scr, lane); continue; }
    r -= I_FO;
    if (r < I_A) { transpose_item(p.in[14] + (size_t)l * 512 * 1024, 512, 1024, (bf16*)(ws + OFF_WA), 0, r, scr, lane); continue; }
    r -= I_A;
    if (r < I_A) { transpose_item(p.in[15] + (size_t)l * 512 * 1024, 512, 1024, (bf16*)(ws + OFF_WB), 0, r, scr, lane); continue; }
    r -= I_A;
    transpose_item(p.in[16] + (size_t)l * 1024 * 1024, 1024, 1024, (bf16*)(ws + OFF_WO), 0, r, scr, lane);
  }
  if (parts & 8) {
    bf16* Xb = (bf16*)(ws + OFF_XB);
    const size_t nvec = (size_t)MT * 128;
    for (size_t v = (size_t)blockIdx.x * NTHREADS + tid; v < nvec; v += (size_t)gridDim.x * NTHREADS) {
      const int row = (int)(v >> 7), c0 = (int)(v & 127) * 8;
      const float* src;
      if (row < MP) {
        const int b = row / LP, t = row - b * LP;
        src = (t < 16) ? (p.in[5] + (size_t)t * D + c0) : (p.in[0] + ((size_t)b * 2048 + (t - 16)) * D + c0);
      } else {
        src = p.in[1] + (size_t)(row - MP) * D + c0;
      }
      const f32x4 a = *reinterpret_cast<const f32x4*>(src), b4 = *reinterpret_cast<const f32x4*>(src + 4);
      u32x4 o; o.x = pk2(a[0], a[1]); o.y = pk2(a[2], a[3]); o.z = pk2(b4[0], b4[1]); o.w = pk2(b4[2], b4[3]);
      *reinterpret_cast<u32x4*>(Xb + (size_t)row * D + c0) = o;
    }
  }
}

using f32x16 = __attribute__((ext_vector_type(16))) float;
constexpr int TAIL_ROW0 = 64 * 256;
template <int MODE>
__device__ __forceinline__ void tail_gemm(const Params& p, const bf16* __restrict__ A, int lda, const bf16* __restrict__ Bt, int ldb, int K, int N,
                                          int br, const int tid_in) {
  int tid = tid_in;
  asm volatile("" : "+v"(tid));
  unsigned char* ws = p.ws;
  LAS float* part = (LAS float*)smem_raw;
  const int wid = tid >> 6, lane = tid & 63, r32 = lane & 31, hh = lane >> 5;
  const int ncb = N / 32, kw = K / 8, k0 = wid * kw;
  for (int st = blockIdx.x; st < 8 * ncb; st += gridDim.x) {
    const int rb = st / ncb, cbk = st - rb * ncb;
    const int row0 = TAIL_ROW0 + rb * 32, col0 = cbk * 32;
    const bf16* ap = A + (size_t)(row0 + r32) * lda + k0 + hh * 8;
    const bf16* bp = Bt + (size_t)(col0 + r32) * ldb + k0 + hh * 8;
    f32x16 acc;
#pragma unroll
    for (int i = 0; i < 16; ++i) acc[i] = 0.f;
#pragma unroll 8
    for (int ks = 0; ks < kw; ks += 16) {
      const bf16x8 a = *reinterpret_cast<const bf16x8*>(ap + ks);
      const bf16x8 b = *reinterpret_cast<const bf16x8*>(bp + ks);
      acc = __builtin_amdgcn_mfma_f32_32x32x16_bf16(b, a, acc, 0, 0, 0);
    }
    const size_t m = (size_t)(row0 + r32);
    const int n = col0 + ((2 * wid) & 3) + 8 * ((2 * wid) >> 2) + 4 * hh;
    u32 gpair = 0u, ppair = 0u;
    if (MODE == 1) {
      gpair = *reinterpret_cast<const u32*>(reinterpret_cast<const u16*>(ws + OFF_R4) + m * 2048 + br * 1024 + n);
      if (br) ppair = *reinterpret_cast<const u32*>(reinterpret_cast<const u16*>(ws + OFF_R3) + m * 1024 + n);
    } else if (MODE == 2) {
      gpair = *reinterpret_cast<const u32*>(reinterpret_cast<const u16*>(ws + OFF_XB) + m * 1024 + n);
    }
#pragma unroll
    for (int i = 0; i < 16; ++i) part[(wid * 16 + i) * 64 + lane] = acc[i];
    __syncthreads();
    float v0 = 0.f, v1 = 0.f;
#pragma unroll
    for (int w = 0; w < 8; ++w) { v0 += part[(w * 16 + 2 * wid) * 64 + lane]; v1 += part[(w * 16 + 2 * wid + 1) * 64 + lane]; }
    if (MODE == 0) {
      *reinterpret_cast<u32*>(reinterpret_cast<u16*>(ws + OFF_R4) + m * 2048 + n) = pk2(v0, v1);
    } else if (MODE == 1) {
      float o0 = v0 * sigmoidf_(bflo(gpair)), o1 = v1 * sigmoidf_(bfhi(gpair));
      if (br) { o0 += bflo(ppair); o1 += bfhi(ppair); }
      *reinterpret_cast<u32*>(reinterpret_cast<u16*>(ws + OFF_R3) + m * 1024 + n) = pk2(o0, o1);
    } else {
      *reinterpret_cast<u32*>(reinterpret_cast<u16*>(ws + OFF_R4) + m * 1024 + n) = pk2(v0 + ALPHA * bflo(gpair), v1 + ALPHA * bfhi(gpair));
    }
    __syncthreads();
  }
}

__device__ __forceinline__ void tile_xcd(int u, int nn, int& pm, int& pi) {
  if (u < 64 * nn) {
    const int x = u & 7, jj = u >> 3, half = jj / (4 * nn), rem = jj - half * 4 * nn;
    pi = ((rem >> 2) + (x * nn) / 8) % nn;
    pm = 8 * x + 4 * half + (rem & 3);
  }
  else { pm = 64; pi = u - 64 * nn; }
}

__device__ __forceinline__ void phase_gemm_in(const Params& p, bool gates) {
  const int tid = opaque_tid();
  unsigned char* ws = p.ws;
  const bf16* Xb = (const bf16*)(ws + OFF_XB);
  const bf16* Wt = (const bf16*)(ws + OFF_WIN);
  const int nmt = gates ? 64 : NMT;
  const int ntile = (gates ? 8 : 15) * nmt;
  for (int t = blockIdx.x; t < ntile; t += gridDim.x) {
    int pi, pm;
    tile_xcd(t, gates ? 8 : 15, pm, pi);
    const int pn = gates ? (14 + pi) : (pi < 14 ? pi : 22);
    const int brow = pm * 256, bcol = pn * 256;
    Acc acc; acc_zero(acc);
    gemm_kloop(acc, Xb, 1024, Wt, 1024, 1024, brow, bcol, tid, true);
    if (pn < 6) epi_store_bf16_perm(acc, (bf16*)(ws + OFF_R2) + pn * 256, 1536, brow, tid);
    else if (pn < 14) epi_store_bf16_perm(acc, (bf16*)(ws + OFF_R3) + (pn - 6) * 256, 2048, brow, tid);
    else if (pn < 22) epi_store_bf16_perm(acc, (bf16*)(ws + OFF_R4) + (pn - 14) * 256, 2048, brow, tid);
    else {
      float* sm = (float*)(ws + OFF_R5);
      EPI_COORDS
      EPI_LOOP {
        if (bj == 0 && wc == 0) *reinterpret_cast<f32x4*>(sm + (size_t)EPI_ROW * 32 + 8 * fq + 4 * n) = acc[ai][bj][m][n];
      }
    }
  }
  if (gates) {
    __syncthreads();
    tail_gemm<0>(p, Xb, 1024, Wt + (size_t)14 * 256 * 1024, 1024, 1024, 2048, 0, tid);
  }
}

__device__ __forceinline__ void gdn_job(const Params& p, int l, int b, int h, int half, float* lds, const int tid) {
  unsigned char* ws = p.ws;
  const bf16* QS = (const bf16*)(ws + OFF_QS);
  const float* SM = (const float*)(ws + OFF_R5);
  bf16* O = (bf16*)(ws + OFF_R2);
  const int lane = tid & 63, cg = lane & 15, kq = lane >> 4;
  const int col = half * 64 + cg * 4;
  f32x4 S[32];
  const float* s0 = p.in[2] + (((size_t)l * NS + b) * 4 + h) * 128 * 128 + (size_t)(kq * 32) * 128 + col;
#pragma unroll
  for (int i = 0; i < 32; ++i) S[i] = *reinterpret_cast<const f32x4*>(s0 + (size_t)i * 128);
  const float eA = __expf(p.in[8][l * 4 + h]), dtb = p.in[9][l * 4 + h];
  float* lk = lds;
  float* lq = lds + 128;
  const size_t row = (size_t)MP + b;
  const u32 q2 = *reinterpret_cast<const u32*>(QS + (size_t)b * 1536 + h * 128 + lane * 2);
  const u32 k2 = *reinterpret_cast<const u32*>(QS + (size_t)b * 1536 + 512 + h * 128 + lane * 2);
  const u32x2 v2 = *reinterpret_cast<const u32x2*>(QS + (size_t)b * 1536 + 1024 + h * 128 + col);
  const f32x4 v = {bflo(v2.x), bfhi(v2.x), bflo(v2.y), bfhi(v2.y)};
  const float beta = sigmoidf_(SM[row * 32 + h]);
  const float g = -eA * softplusf_(SM[row * 32 + 4 + h] + dtb);
  const float eg = __expf(g);
  __builtin_amdgcn_wave_barrier();
  lq[lane * 2] = bflo(q2); lq[lane * 2 + 1] = bfhi(q2);
  lk[lane * 2] = bflo(k2); lk[lane * 2 + 1] = bfhi(k2);
  __builtin_amdgcn_wave_barrier();
  const float* lkq = lk + kq * 32;
  const float* lqq = lq + kq * 32;
  f32x4 ks = {0.f, 0.f, 0.f, 0.f};
#pragma unroll
  for (int i = 0; i < 32; i += 4) {
    const f32x4 kk = *reinterpret_cast<const f32x4*>(lkq + i);
    ks += S[i] * kk[0] + S[i + 1] * kk[1] + S[i + 2] * kk[2] + S[i + 3] * kk[3];
  }
#pragma unroll
  for (int c = 0; c < 4; ++c) { ks[c] += __shfl_xor(ks[c], 16); ks[c] += __shfl_xor(ks[c], 32); }
  const f32x4 u = (v - ks * eg) * beta;
  f32x4 o = {0.f, 0.f, 0.f, 0.f};
  float* so = p.out + OUT_GDNS + (((size_t)l * NS + b) * 4 + h) * 128 * 128 + (size_t)(kq * 32) * 128 + col;
#pragma unroll
  for (int i = 0; i < 32; i += 4) {
    const f32x4 kk = *reinterpret_cast<const f32x4*>(lkq + i);
    const f32x4 qq = *reinterpret_cast<const f32x4*>(lqq + i);
#pragma unroll
    for (int e = 0; e < 4; ++e) {
      const f32x4 sn = S[i + e] * eg + u * kk[e];
      o += sn * qq[e];
      *reinterpret_cast<f32x4*>(so + (size_t)(i + e) * 128) = sn;
    }
  }
#pragma unroll
  for (int c = 0; c < 4; ++c) { o[c] += __shfl_xor(o[c], 16); o[c] += __shfl_xor(o[c], 32); }
  if (kq == 0) {
    u32x2 ov; ov.x = pk2(o[0], o[1]); ov.y = pk2(o[2], o[3]);
    *reinterpret_cast<u32x2*>(O + row * 1024 + h * 128 + col) = ov;
  }
  __builtin_amdgcn_wave_barrier();
}

__device__ __forceinline__ void gla_job(const Params& p, int l, int b, int h, int half, bool smp, float* lds, const int tid) {
  unsigned char* ws = p.ws;
  const bf16* P2 = (const bf16*)(ws + OFF_R3);
  const float* SM = (const float*)(ws + OFF_R5);
  bf16* O = (bf16*)(ws + OFF_R2);
  const int lane = tid & 63, col = half * 64 + lane;
  float S[64];
  if (smp) {
    const float* s0 = p.in[3] + (((size_t)l * NS + b) * 4 + h) * 64 * 128 + col;
#pragma unroll
    for (int i = 0; i < 64; ++i) S[i] = s0[(size_t)i * 128];
  } else {
#pragma unroll
    for (int i = 0; i < 64; ++i) S[i] = 0.f;
  }
  float w2[16];
#pragma unroll
  for (int r = 0; r < 16; ++r) w2[r] = p.in[11][((size_t)l * 16 + r) * 256 + h * 64 + lane];
  const float gb = p.in[12][l * 256 + h * 64 + lane];
  const int T = smp ? 1 : LP, row0 = smp ? (MP + b) : b * LP;
  float* le = lds;
  float* lk = lds + 64;
  float* lq = lds + 128;
  for (int t = 0; t < T; ++t) {
    const size_t row = (size_t)(row0 + t);
    const float q = bf1(*reinterpret_cast<const u16*>(P2 + row * 2048 + 512 + h * 64 + lane)) * 0.125f;
    const float k = bf1(*reinterpret_cast<const u16*>(P2 + row * 2048 + 768 + h * 64 + lane));
    const float v = bf1(*reinterpret_cast<const u16*>(P2 + row * 2048 + 1024 + h * 128 + col));
    float x = gb;
#pragma unroll
    for (int r = 0; r < 16; ++r) x += SM[row * 32 + 8 + r] * w2[r];
    const float lg = -softplusf_(-x) * (1.f / 16.f);
    __builtin_amdgcn_wave_barrier();
    le[lane] = __expf(lg); lk[lane] = k; lq[lane] = q;
    __builtin_amdgcn_wave_barrier();
    float o = 0.f;
#pragma unroll
    for (int i = 0; i < 64; i += 4) {
      const f32x4 ee = *reinterpret_cast<const f32x4*>(le + i);
      const f32x4 kk = *reinterpret_cast<const f32x4*>(lk + i);
      const f32x4 qq = *reinterpret_cast<const f32x4*>(lq + i);
      S[i] = ee[0] * S[i] + kk[0] * v; S[i + 1] = ee[1] * S[i + 1] + kk[1] * v;
      S[i + 2] = ee[2] * S[i + 2] + kk[2] * v; S[i + 3] = ee[3] * S[i + 3] + kk[3] * v;
      o += S[i] * qq[0] + S[i + 1] * qq[1] + S[i + 2] * qq[2] + S[i + 3] * qq[3];
    }
    O[row * 1024 + 512 + h * 128 + col] = __float2bfloat16(o);
  }
  float* so = smp ? (p.out + OUT_GLAS + (((size_t)l * NS + b) * 4 + h) * 64 * 128 + col)
                  : (p.out + OUT_GLAP + (((size_t)l * NBATCH + b) * 4 + h) * 64 * 128 + col);
#pragma unroll
  for (int i = 0; i < 64; ++i) so[(size_t)i * 128] = S[i];
}

constexpr int NCH = 33;
constexpr int GDN_IMG = 73728, GLA_IMG = 25088;
constexpr size_t OFF_GDN_IMG = OFF_R4;
constexpr size_t OFF_GLA_IMG = OFF_R4 + (size_t)NBATCH * 4 * NCH * GDN_IMG;
constexpr size_t R4_IMG_END = OFF_GLA_IMG + (size_t)NBATCH * 4 * NCH * GLA_IMG;
static_assert(R4_IMG_END <= OFF_R5, "R4 too small for the images");

__device__ __forceinline__ bf16x8 lds_frag16(const LAS unsigned char* base) { return *reinterpret_cast<const LAS bf16x8*>(base); }
__device__ __forceinline__ bf16x8 mk_frag(u32 a, u32 b, u32 c, u32 d) {
  u32x4 v; v.x = a; v.y = b; v.z = c; v.w = d;
  return __builtin_bit_cast(bf16x8, v);
}
__device__ __forceinline__ bf16x8 frag_from_tiles(const f32x4 t0, const f32x4 t1) {
  return mk_frag(pk2(t0[0], t0[1]), pk2(t0[2], t0[3]), pk2(t1[0], t1[1]), pk2(t1[2], t1[3]));
}
#define MFMA16(a, b, c) __builtin_amdgcn_mfma_f32_16x16x32_bf16(a, b, c, 0, 0, 0)

__device__ __forceinline__ void conv8(const bf16* __restrict__ P1, const float* __restrict__ cw, size_t row, int t, int c0, bool valid,
                                      float* o, float* x3) {
#pragma unroll
  for (int e = 0; e < 8; ++e) o[e] = 0.f;
#pragma unroll
  for (int i = 0; i < 4; ++i) {
    float x[8];
    if (valid && (t - 3 + i >= 0)) unpack8(*reinterpret_cast<const u32x4*>(P1 + (row - 3 + i) * 1536 + c0), x);
    else {
#pragma unroll
      for (int e = 0; e < 8; ++e) x[e] = 0.f;
    }
    const f32x4 wa = *reinterpret_cast<const f32x4*>(cw + i * 1536 + c0), wb = *reinterpret_cast<const f32x4*>(cw + i * 1536 + c0 + 4);
    o[0] += wa[0] * x[0]; o[1] += wa[1] * x[1]; o[2] += wa[2] * x[2]; o[3] += wa[3] * x[3];
    o[4] += wb[0] * x[4]; o[5] += wb[1] * x[5]; o[6] += wb[2] * x[6]; o[7] += wb[3] * x[7];
    if (i == 3) {
#pragma unroll
      for (int e = 0; e < 8; ++e) x3[e] = x[e];
    }
  }
#pragma unroll
  for (int e = 0; e < 8; ++e) o[e] = o[e] * sigmoidf_(o[e]);
}

constexpr int LQ = 0, LK = 17408, LKT = 34816, LVT = 53248, LAM = 71680, LTW = 89088, LTU = 98304, LGM = 107520, LBT = 107776, LCW = 108032;
constexpr int QSTR = 272, TSTR = 144, ASTR = 68;

__device__ __forceinline__ void gdn_pre_item(const Params& p, int l, int b, int h, int c, const int tid_in) {
  int tid = tid_in;
  asm volatile("" : "+v"(tid));
  unsigned char* ws = p.ws;
  LAS unsigned char* lds = (LAS unsigned char*)smem_raw;
  asm volatile("" : "+v"(lds));
  const bf16* P1 = (const bf16*)(ws + OFF_R2);
  const float* SM = (const float*)(ws + OFF_R5);
  const float* cw = p.in[7] + (size_t)l * 4 * 1536;
  unsigned char* img = ws + OFF_GDN_IMG + (size_t)((b * 4 + h) * NCH + c) * GDN_IMG;
  const int wid = tid >> 6, lane = tid & 63, r = lane & 15, q = lane >> 4;
  const int tb = (c == 0) ? 0 : 16 + 64 * (c - 1), nvalid = (c == 0) ? 16 : 64;
  const size_t row0 = (size_t)b * LP + tb;
  float sm_a = 0.f, sm_b = 0.f;
  {
    const int j = tid >> 3, sub = tid & 7;
    const bool valid = j < nvalid;
    const int t = tb + j;
    const size_t row = row0 + j;
    LAS float* lcw = reinterpret_cast<LAS float*>(lds + LCW);
    float cwv[3];
#pragma unroll
    for (int u = 0; u < 3; ++u) {
      const int i = tid + u * NTHREADS, tap = i / 384, cc = i - tap * 384;
      cwv[u] = cw[tap * 1536 + (cc >> 7) * 512 + h * 128 + (cc & 127)];
    }
    if (wid == 0 && lane < nvalid) {
      sm_a = SM[(row0 + lane) * 32 + 4 + h];
      sm_b = SM[(row0 + lane) * 32 + h];
    }
    u32x4 raw[3][4][2];
#pragma unroll
    for (int mat = 0; mat < 3; ++mat)
#pragma unroll
      for (int i = 0; i < 4; ++i)
#pragma unroll
        for (int hf = 0; hf < 2; ++hf) {
          if (valid && (t - 3 + i >= 0)) raw[mat][i][hf] = *reinterpret_cast<const u32x4*>(P1 + (row - 3 + i) * 1536 + mat * 512 + h * 128 + sub * 16 + hf * 8);
          else raw[mat][i][hf] = u32x4{0u, 0u, 0u, 0u};
        }
#pragma unroll
    for (int u = 0; u < 3; ++u) lcw[tid + u * NTHREADS] = cwv[u];
    __syncthreads();
#pragma unroll
    for (int mat = 0; mat < 3; ++mat) {
      float o[16];
#pragma unroll
      for (int e = 0; e < 16; ++e) o[e] = 0.f;
#pragma unroll
      for (int i = 0; i < 4; ++i)
#pragma unroll
        for (int hf = 0; hf < 2; ++hf) {
          float x[8];
          unpack8(raw[mat][i][hf], x);
          const f32x4 wa = *reinterpret_cast<const LAS f32x4*>(lcw + i * 384 + mat * 128 + sub * 16 + hf * 8);
          const f32x4 wb = *reinterpret_cast<const LAS f32x4*>(lcw + i * 384 + mat * 128 + sub * 16 + hf * 8 + 4);
          float* oo = o + hf * 8;
          oo[0] += wa[0] * x[0]; oo[1] += wa[1] * x[1]; oo[2] += wa[2] * x[2]; oo[3] += wa[3] * x[3];
          oo[4] += wb[0] * x[4]; oo[5] += wb[1] * x[5]; oo[6] += wb[2] * x[6]; oo[7] += wb[3] * x[7];
        }
#pragma unroll
      for (int e = 0; e < 16; ++e) o[e] = o[e] * sigmoidf_(o[e]);
      if (mat < 2) {
        float ss = 0.f;
#pragma unroll
        for (int e = 0; e < 16; ++e) ss += o[e] * o[e];
        ss = sum8(ss);
        const float sc = rsqrtf(ss + 1e-6f) * (mat == 0 ? 0.08838834764831845f : 1.f);
#pragma unroll
        for (int e = 0; e < 16; ++e) o[e] *= sc;
      }
      if (mat < 2) {
        LAS unsigned char* ldst = lds + (mat == 0 ? LQ : LK) + j * QSTR + sub * 32;
        *reinterpret_cast<LAS u32x4*>(ldst) = pack8(o);
        *reinterpret_cast<LAS u32x4*>(ldst + 16) = pack8(o + 8);
      }
      if (mat >= 1) {
        LAS unsigned char* ldst = lds + (mat == 1 ? LKT : LVT) + (sub * 16) * TSTR + (j ^ (sub << 3)) * 2;
#pragma unroll
        for (int e = 0; e < 16; ++e) *reinterpret_cast<LAS u16*>(ldst + e * TSTR) = f2bf(o[e]);
      }
      if (c == NCH - 1 && j >= 61) {
        float* dst = p.out + OUT_CONVP + (((size_t)l * NBATCH + b) * 3 + (j - 61)) * 1536 + mat * 512 + h * 128 + sub * 16;
#pragma unroll
        for (int hf = 0; hf < 2; ++hf) {
          float x3[8];
          unpack8(raw[mat][3][hf], x3);
          *reinterpret_cast<f32x4*>(dst + hf * 8) = f32x4{x3[0], x3[1], x3[2], x3[3]};
          *reinterpret_cast<f32x4*>(dst + hf * 8 + 4) = f32x4{x3[4], x3[5], x3[6], x3[7]};
        }
      }
    }
  }
  if (wid == 0) {
    const bool valid = lane < nvalid;
    float g = 0.f, be = 0.f;
    if (valid) {
      const float eA = __expf(p.in[8][l * 4 + h]), dtb = p.in[9][l * 4 + h];
      g = -eA * softplusf_(sm_a + dtb);
      be = sigmoidf_(sm_b);
    }
#pragma unroll
    for (int o = 1; o < 64; o <<= 1) {
      const float y = __shfl_up(g, o);
      if (lane >= o) g += y;
    }
    reinterpret_cast<LAS float*>(lds + LGM)[lane] = g;
    reinterpret_cast<LAS float*>(lds + LBT)[lane] = be;
  }
  __syncthreads();
  const LAS float* gam = reinterpret_cast<const LAS float*>(lds + LGM);
  const LAS float* bet = reinterpret_cast<const LAS float*>(lds + LBT);
  {
#pragma unroll
    for (int u = 0; u < 2; ++u) {
      const int id = wid * 2 + u, it = id >> 2, jt = id & 3;
      f32x4 d = {0.f, 0.f, 0.f, 0.f};
#pragma unroll
      for (int ks = 0; ks < 4; ++ks) {
        const bf16x8 a = lds_frag16(lds + LK + (16 * it + r) * QSTR + (32 * ks + 8 * q) * 2);
        const bf16x8 bb = lds_frag16(lds + LK + (16 * jt + r) * QSTR + (32 * ks + 8 * q) * 2);
        d = MFMA16(a, bb, d);
      }
      const int jj = 16 * jt + r;
      const float gj = gam[jj];
#pragma unroll
      for (int e = 0; e < 4; ++e) {
        const int ii = 16 * it + 4 * q + e;
        const float v = (jj < ii) ? bet[ii] * __expf(fminf(gam[ii] - gj, 0.f)) * d[e] : 0.f;
        reinterpret_cast<LAS float*>(lds + LAM)[ii * ASTR + jj] = v;
      }
    }
    const int it = wid & 3, s = wid >> 2;
    f32x4 d2[2];
#pragma unroll
    for (int u = 0; u < 2; ++u) {
      const int jt = 2 * s + u;
      f32x4 d = {0.f, 0.f, 0.f, 0.f};
#pragma unroll
      for (int ks = 0; ks < 4; ++ks) {
        const bf16x8 a = lds_frag16(lds + LK + (16 * jt + r) * QSTR + (32 * ks + 8 * q) * 2);
        const bf16x8 bb = lds_frag16(lds + LQ + (16 * it + r) * QSTR + (32 * ks + 8 * q) * 2);
        d = MFMA16(a, bb, d);
      }
      const int ii = 16 * it + r;
      const float gi = gam[ii];
#pragma unroll
      for (int e = 0; e < 4; ++e) {
        const int jj = 16 * jt + 4 * q + e;
        d[e] = (jj <= ii) ? __expf(fminf(gi - gam[jj], 0.f)) * d[e] : 0.f;
      }
      d2[u] = d;
    }
    *reinterpret_cast<bf16x8*>(img + 32768 + (it * 2 + s) * 1024 + lane * 16) = frag_from_tiles(d2[0], d2[1]);
  }
  __syncthreads();
  if (wid == 0) {
    const LAS float* A = reinterpret_cast<const LAS float*>(lds + LAM);
    LAS unsigned char* PT = lds + LCW;
    LAS unsigned char* QR = lds + LCW + 2560;
    const int blk = lane >> 5, cc = lane & 31;
    float T[32];
    {
      const LAS float* Ab = A + (32 * blk) * ASTR + 32 * blk;
#pragma unroll
      for (int i = 0; i < 32; ++i) {
        float a0 = (i == cc) ? 1.f : 0.f, a1 = 0.f, a2 = 0.f, a3 = 0.f;
#pragma unroll
        for (int j4 = 0; j4 + 4 <= i; j4 += 4) {
          const f32x4 av = *reinterpret_cast<const LAS f32x4*>(Ab + i * ASTR + j4);
          a0 -= av[0] * T[j4]; a1 -= av[1] * T[j4 + 1]; a2 -= av[2] * T[j4 + 2]; a3 -= av[3] * T[j4 + 3];
        }
#pragma unroll
        for (int j = (i & ~3); j < i; ++j) a0 -= Ab[i * ASTR + j] * T[j];
        T[i] = (a0 + a1) + (a2 + a3);
        if ((i & 3) == 3) __builtin_amdgcn_sched_barrier(0);
      }
    }
    const float bj = bet[lane], bw = bj * __expf(gam[lane]);
    if (blk == 0) {
#pragma unroll
      for (int i8 = 0; i8 < 4; ++i8) *reinterpret_cast<LAS u32x4*>(PT + cc * 80 + i8 * 16) = pack8(T + 8 * i8);
    } else {
#pragma unroll
      for (int i = 0; i < 32; ++i) *reinterpret_cast<LAS u16*>(QR + i * 80 + cc * 2) = f2bf(T[i]);
    }
#pragma unroll
    for (int i = 0; i < 32; ++i) {
      *reinterpret_cast<LAS u16*>(lds + LTW + (32 * blk + i) * TSTR + lane * 2) = f2bf(T[i] * bw);
      *reinterpret_cast<LAS u16*>(lds + LTU + (32 * blk + i) * TSTR + lane * 2) = f2bf(T[i] * bj);
      if (blk == 1) {
        *reinterpret_cast<LAS u16*>(lds + LTW + i * TSTR + lane * 2) = (u16)0;
        *reinterpret_cast<LAS u16*>(lds + LTU + i * TSTR + lane * 2) = (u16)0;
      }
      if ((i & 7) == 7) __builtin_amdgcn_sched_barrier(0);
    }
    f32x4 M1[2][2];
#pragma unroll
    for (int it = 0; it < 2; ++it) {
      const LAS float* ar = A + (32 + 16 * it + r) * ASTR + 8 * q;
      const f32x4 x0 = *reinterpret_cast<const LAS f32x4*>(ar), x1 = *reinterpret_cast<const LAS f32x4*>(ar + 4);
      const bf16x8 af = mk_frag(pk2(x0[0], x0[1]), pk2(x0[2], x0[3]), pk2(x1[0], x1[1]), pk2(x1[2], x1[3]));
#pragma unroll
      for (int nt = 0; nt < 2; ++nt) {
        const bf16x8 bfq = lds_frag16(PT + (16 * nt + r) * 80 + q * 16);
        M1[it][nt] = MFMA16(af, bfq, (f32x4{0.f, 0.f, 0.f, 0.f}));
      }
    }
#pragma unroll
    for (int nt = 0; nt < 2; ++nt) {
      const bf16x8 mf = frag_from_tiles(M1[0][nt], M1[1][nt]);
      const int n = 16 * nt + r;
      const float bn = bet[n], bwn = bn * __expf(gam[n]);
#pragma unroll
      for (int it = 0; it < 2; ++it) {
        const u32x2 lo = *reinterpret_cast<const LAS u32x2*>(QR + (16 * it + r) * 80 + (4 * q) * 2);
        const u32x2 hi = *reinterpret_cast<const LAS u32x2*>(QR + (16 * it + r) * 80 + (16 + 4 * q) * 2);
        const f32x4 rr = MFMA16(mk_frag(lo.x, lo.y, hi.x, hi.y), mf, (f32x4{0.f, 0.f, 0.f, 0.f}));
#pragma unroll
        for (int e = 0; e < 4; ++e) {
          const int i = 32 + 16 * it + 4 * q + e;
          *reinterpret_cast<LAS u16*>(lds + LTW + i * TSTR + n * 2) = f2bf(-rr[e] * bwn);
          *reinterpret_cast<LAS u16*>(lds + LTU + i * TSTR + n * 2) = f2bf(-rr[e] * bn);
        }
      }
    }
    if (lane == 0) reinterpret_cast<float*>(ws + OFF_GT)[(b * 4 + h) * NCH + c] = __expf(gam[63]);
  } else {
    for (int f = wid - 1; f < 32; f += 7) {
      if (f < 16) {
        const int it = f >> 2, ks = f & 3, ii = 16 * it + r;
        const float sc = __expf(gam[ii]);
        const u32x2 lo = *reinterpret_cast<const LAS u32x2*>(lds + LQ + ii * QSTR + (32 * ks + 4 * q) * 2);
        const u32x2 hi = *reinterpret_cast<const LAS u32x2*>(lds + LQ + ii * QSTR + (32 * ks + 16 + 4 * q) * 2);
        const bf16x8 o = mk_frag(pk2(bflo(lo.x) * sc, bfhi(lo.x) * sc), pk2(bflo(lo.y) * sc, bfhi(lo.y) * sc),
                                 pk2(bflo(hi.x) * sc, bfhi(hi.x) * sc), pk2(bflo(hi.y) * sc, bfhi(hi.y) * sc));
        *reinterpret_cast<bf16x8*>(img + 16384 + f * 1024 + lane * 16) = o;
      } else {
        const int g2 = f - 16, kt = g2 >> 1, s = g2 & 1, kk = 16 * kt + r;
        const float gl = gam[63];
        const u32x2 lo = *reinterpret_cast<const LAS u32x2*>(lds + LKT + kk * TSTR + ((32 * s + 4 * q) ^ ((kt & 7) << 3)) * 2);
        const u32x2 hi = *reinterpret_cast<const LAS u32x2*>(lds + LKT + kk * TSTR + ((32 * s + 16 + 4 * q) ^ ((kt & 7) << 3)) * 2);
        const f32x4 g0 = *reinterpret_cast<const LAS f32x4*>(gam + 32 * s + 4 * q);
        const f32x4 g1 = *reinterpret_cast<const LAS f32x4*>(gam + 32 * s + 16 + 4 * q);
        const bf16x8 o = mk_frag(pk2(bflo(lo.x) * __expf(gl - g0[0]), bfhi(lo.x) * __expf(gl - g0[1])),
                                 pk2(bflo(lo.y) * __expf(gl - g0[2]), bfhi(lo.y) * __expf(gl - g0[3])),
                                 pk2(bflo(hi.x) * __expf(gl - g1[0]), bfhi(hi.x) * __expf(gl - g1[1])),
                                 pk2(bflo(hi.y) * __expf(gl - g1[2]), bfhi(hi.y) * __expf(gl - g1[3])));
        *reinterpret_cast<bf16x8*>(img + 40960 + g2 * 1024 + lane * 16) = o;
      }
    }
  }
  __syncthreads();
  {
    const int it = wid & 3;
#pragma unroll
    for (int u = 0; u < 2; ++u) {
      const int ks = (wid >> 2) + 2 * u;
      f32x4 d2[2];
#pragma unroll
      for (int v = 0; v < 2; ++v) {
        const int kt = 2 * ks + v;
        f32x4 d = {0.f, 0.f, 0.f, 0.f};
#pragma unroll
        for (int s = 0; s < 2; ++s) {
          const bf16x8 a = lds_frag16(lds + LKT + (16 * kt + r) * TSTR + ((32 * s + 8 * q) ^ ((kt & 7) << 3)) * 2);
          const bf16x8 bb = lds_frag16(lds + LTW + (16 * it + r) * TSTR + (32 * s + 8 * q) * 2);
          d = MFMA16(a, bb, d);
        }
        d2[v] = -d;
      }
      *reinterpret_cast<bf16x8*>(img + (it * 4 + ks) * 1024 + lane * 16) = frag_from_tiles(d2[0], d2[1]);
    }
    const int nt = wid;
#pragma unroll
    for (int it2 = 0; it2 < 4; ++it2) {
      f32x4 d = {0.f, 0.f, 0.f, 0.f};
#pragma unroll
      for (int s = 0; s < 2; ++s) {
        const bf16x8 a = lds_frag16(lds + LTU + (16 * it2 + r) * TSTR + (32 * s + 8 * q) * 2);
        const bf16x8 bb = lds_frag16(lds + LVT + (16 * nt + r) * TSTR + ((32 * s + 8 * q) ^ ((nt & 7) << 3)) * 2);
        d = MFMA16(a, bb, d);
      }
      u32x2 o; o.x = pk2(d[0], d[1]); o.y = pk2(d[2], d[3]);
      *reinterpret_cast<u32x2*>(img + 57344 + ((nt * 4 + it2) * 64 + lane) * 8) = o;
    }
  }
  __syncthreads();
}

constexpr int GQ = 0, GK = 9216, GKR = 18432, GCB = 27648, GW2 = 45056;
__device__ __forceinline__ void gla_pre_item(const Params& p, int l, int b, int h, int c, const int tid_in) {
  int tid = tid_in;
  asm volatile("" : "+v"(tid));
  unsigned char* ws = p.ws;
  LAS unsigned char* lds = (LAS unsigned char*)smem_raw;
  asm volatile("" : "+v"(lds));
  const bf16* P2 = (const bf16*)(ws + OFF_R3);
  const float* SM = (const float*)(ws + OFF_R5);
  unsigned char* img = ws + OFF_GLA_IMG + (size_t)((b * 4 + h) * NCH + c) * GLA_IMG;
  const int wid = tid >> 6, lane = tid & 63, r = lane & 15, q = lane >> 4;
  const int tb = (c == 0) ? 0 : 16 + 64 * (c - 1), nvalid = (c == 0) ? 16 : 64;
  const size_t row0 = (size_t)b * LP + tb;
  LAS float* cb = reinterpret_cast<LAS float*>(lds + GCB);
  LAS float* w2s = reinterpret_cast<LAS float*>(lds + GW2);
  LAS float* wtot = w2s + 1024;
  const int j = tid >> 3, sub = tid & 7;
  const bool valid = j < nvalid;
  f32x4 glr[4];
  {
    const float w2a = p.in[11][((size_t)l * 16 + (tid >> 6)) * 256 + h * 64 + (tid & 63)];
    const float w2b = p.in[11][((size_t)l * 16 + ((tid + NTHREADS) >> 6)) * 256 + h * 64 + (tid & 63)];
    const float* smr = SM + (row0 + (valid ? j : 0)) * 32 + 8;
#pragma unroll
    for (int u = 0; u < 4; ++u) glr[u] = *reinterpret_cast<const f32x4*>(smr + 4 * u);
    w2s[tid] = w2a; w2s[tid + NTHREADS] = w2b;
  }
  __syncthreads();
  float qv[8], kv[8], cbv[8];
  {
    float x[8];
#pragma unroll
    for (int e = 0; e < 8; ++e) x[e] = p.in[12][l * 256 + h * 64 + sub * 8 + e];
    if (valid) {
#pragma unroll
      for (int rr = 0; rr < 16; ++rr) {
        const float gl = glr[rr >> 2][rr & 3];
        const f32x4 wa = *reinterpret_cast<const LAS f32x4*>(w2s + rr * 64 + sub * 8), wb = *reinterpret_cast<const LAS f32x4*>(w2s + rr * 64 + sub * 8 + 4);
        x[0] += gl * wa[0]; x[1] += gl * wa[1]; x[2] += gl * wa[2]; x[3] += gl * wa[3];
        x[4] += gl * wb[0]; x[5] += gl * wb[1]; x[6] += gl * wb[2]; x[7] += gl * wb[3];
      }
    }
#pragma unroll
    for (int e = 0; e < 8; ++e) cbv[e] = valid ? -softplusf_(-x[e]) * (1.f / 16.f) : 0.f;
    if (valid) {
      unpack8(*reinterpret_cast<const u32x4*>(P2 + (row0 + j) * 2048 + 512 + h * 64 + sub * 8), qv);
      unpack8(*reinterpret_cast<const u32x4*>(P2 + (row0 + j) * 2048 + 768 + h * 64 + sub * 8), kv);
    } else {
#pragma unroll
      for (int e = 0; e < 8; ++e) { qv[e] = 0.f; kv[e] = 0.f; }
    }
    *reinterpret_cast<LAS u32x4*>(lds + GKR + j * TSTR + sub * 16) = pack8(kv);
#pragma unroll
    for (int o = 8; o < 64; o <<= 1) {
#pragma unroll
      for (int e = 0; e < 8; ++e) {
        const float y = __shfl_up(cbv[e], o);
        if (lane >= o) cbv[e] += y;
      }
    }
    if (lane >= 56) {
#pragma unroll
      for (int e = 0; e < 8; ++e) wtot[wid * 64 + sub * 8 + e] = cbv[e];
    }
  }
  __syncthreads();
  {
    float tot[8];
#pragma unroll
    for (int e = 0; e < 8; ++e) tot[e] = 0.f;
#pragma unroll
    for (int w = 0; w < 8; ++w) {
      const f32x4 ta = *reinterpret_cast<const LAS f32x4*>(wtot + w * 64 + sub * 8), tb4 = *reinterpret_cast<const LAS f32x4*>(wtot + w * 64 + sub * 8 + 4);
      if (w < wid) {
        cbv[0] += ta[0]; cbv[1] += ta[1]; cbv[2] += ta[2]; cbv[3] += ta[3];
        cbv[4] += tb4[0]; cbv[5] += tb4[1]; cbv[6] += tb4[2]; cbv[7] += tb4[3];
      }
      tot[0] += ta[0]; tot[1] += ta[1]; tot[2] += ta[2]; tot[3] += ta[3];
      tot[4] += tb4[0]; tot[5] += tb4[1]; tot[6] += tb4[2]; tot[7] += tb4[3];
    }
#pragma unroll
    for (int e = 0; e < 8; ++e) cb[j * ASTR + sub * 8 + e] = cbv[e];
    if (j == 63) {
#pragma unroll
      for (int e = 0; e < 8; ++e) reinterpret_cast<float*>(img + 24576)[sub * 8 + e] = __expf(tot[e]);
    }
    float qo[8], ko[8];
#pragma unroll
    for (int e = 0; e < 8; ++e) {
      const float cv = cbv[e];
      qo[e] = qv[e] * 0.125f * __expf(cv);
      ko[e] = kv[e] * __expf(-cv);
    }
    *reinterpret_cast<LAS u32x4*>(lds + GQ + j * TSTR + sub * 16) = pack8(qo);
    *reinterpret_cast<LAS u32x4*>(lds + GK + j * TSTR + sub * 16) = pack8(ko);
  }
  __syncthreads();
  {
    {
      const int it = wid >> 1, ks = wid & 1, ii = 16 * it + r;
      const u32x2 lo = *reinterpret_cast<const LAS u32x2*>(lds + GQ + ii * TSTR + (32 * ks + 4 * q) * 2);
      const u32x2 hi = *reinterpret_cast<const LAS u32x2*>(lds + GQ + ii * TSTR + (32 * ks + 16 + 4 * q) * 2);
      *reinterpret_cast<bf16x8*>(img + wid * 1024 + lane * 16) = mk_frag(lo.x, lo.y, hi.x, hi.y);
    }
    {
      const int kt = wid >> 1, s = wid & 1, dk = 16 * kt + r;
      const float cl = cb[63 * ASTR + dk];
      float o[8];
#pragma unroll
      for (int e = 0; e < 8; ++e) {
        const int jj = 32 * s + (e < 4 ? 4 * q + e : 16 + 4 * q + (e - 4));
        const float kr = bf1(*reinterpret_cast<const LAS u16*>(lds + GKR + jj * TSTR + dk * 2));
        o[e] = kr * __expf(cl - cb[jj * ASTR + dk]);
      }
      *reinterpret_cast<bf16x8*>(img + 16384 + wid * 1024 + lane * 16) = mk_frag(pk2(o[0], o[1]), pk2(o[2], o[3]), pk2(o[4], o[5]), pk2(o[6], o[7]));
    }
    {
      const int it = wid & 3, s = wid >> 2;
      f32x4 d2[2];
#pragma unroll
      for (int u = 0; u < 2; ++u) {
        const int jt = 2 * s + u;
        f32x4 d = {0.f, 0.f, 0.f, 0.f};
#pragma unroll
        for (int ks = 0; ks < 2; ++ks) {
          const bf16x8 a = lds_frag16(lds + GK + (16 * jt + r) * TSTR + (32 * ks + 8 * q) * 2);
          const bf16x8 bb = lds_frag16(lds + GQ + (16 * it + r) * TSTR + (32 * ks + 8 * q) * 2);
          d = MFMA16(a, bb, d);
        }
        const int ii = 16 * it + r;
#pragma unroll
        for (int e = 0; e < 4; ++e) {
          const int jj = 16 * jt + 4 * q + e;
          d[e] = (jj <= ii) ? d[e] : 0.f;
        }
        d2[u] = d;
      }
      *reinterpret_cast<bf16x8*>(img + 8192 + (it * 2 + s) * 1024 + lane * 16) = frag_from_tiles(d2[0], d2[1]);
    }
  }
  __syncthreads();
}

__device__ __forceinline__ void sample_conv(const Params& p, int l, const int tid) {
  unsigned char* ws = p.ws;
  const bf16* P1 = (const bf16*)(ws + OFF_R2);
  bf16* QS = (bf16*)(ws + OFF_QS);
  const float* cw = p.in[7] + (size_t)l * 4 * 1536;
  const int wid = tid >> 6, lane = tid & 63;
  const int wg0 = (gridDim.x == 256) ? 128 : 0;
  if ((int)blockIdx.x < wg0) return;
  const int gw = ((int)blockIdx.x - wg0) * NWAVES + wid, NGW = ((int)gridDim.x - wg0) * NWAVES;
  for (int b = gw; b < NS; b += NGW) {
    const size_t row = (size_t)MP + b;
#pragma unroll
    for (int j = 0; j < 3; ++j) {
      const int c0 = j * 512 + lane * 8;
      float x[4][8];
      unpack8(*reinterpret_cast<const u32x4*>(P1 + row * 1536 + c0), x[3]);
#pragma unroll
      for (int i = 0; i < 3; ++i) {
        const float* sp = p.in[4] + (((size_t)l * NS + b) * 3 + i) * 1536 + c0;
        const f32x4 a = *reinterpret_cast<const f32x4*>(sp), cc = *reinterpret_cast<const f32x4*>(sp + 4);
        x[i][0] = a[0]; x[i][1] = a[1]; x[i][2] = a[2]; x[i][3] = a[3];
        x[i][4] = cc[0]; x[i][5] = cc[1]; x[i][6] = cc[2]; x[i][7] = cc[3];
      }
      float o[8];
#pragma unroll
      for (int e = 0; e < 8; ++e) o[e] = 0.f;
#pragma unroll
      for (int i = 0; i < 4; ++i) {
        const f32x4 wa = *reinterpret_cast<const f32x4*>(cw + i * 1536 + c0), wb = *reinterpret_cast<const f32x4*>(cw + i * 1536 + c0 + 4);
        o[0] += wa[0] * x[i][0]; o[1] += wa[1] * x[i][1]; o[2] += wa[2] * x[i][2]; o[3] += wa[3] * x[i][3];
        o[4] += wb[0] * x[i][4]; o[5] += wb[1] * x[i][5]; o[6] += wb[2] * x[i][6]; o[7] += wb[3] * x[i][7];
      }
      float ss = 0.f;
#pragma unroll
      for (int e = 0; e < 8; ++e) { o[e] = o[e] * sigmoidf_(o[e]); ss += o[e] * o[e]; }
      if (j < 2) {
        ss = sum16(ss);
        const float sc = rsqrtf(ss + 1e-6f) * (j == 0 ? 0.08838834764831845f : 1.f);
#pragma unroll
        for (int e = 0; e < 8; ++e) o[e] *= sc;
      }
      *reinterpret_cast<u32x4*>(QS + (size_t)b * 1536 + c0) = pack8(o);
#pragma unroll
      for (int i = 0; i < 3; ++i) {
        float* dst = p.out + OUT_CONVS + (((size_t)l * NS + b) * 3 + i) * 1536 + c0;
        *reinterpret_cast<f32x4*>(dst) = f32x4{x[i + 1][0], x[i + 1][1], x[i + 1][2], x[i + 1][3]};
        *reinterpret_cast<f32x4*>(dst + 4) = f32x4{x[i + 1][4], x[i + 1][5], x[i + 1][6], x[i + 1][7]};
      }
    }
  }
}

__device__ __forceinline__ void phase_pre(const Params& p, int l) {
  const int tid = opaque_tid();
  sample_conv(p, l, tid);
  constexpr int NCHH = NBATCH * 4 * NCH;
  for (int it = blockIdx.x; it < NCHH; it += gridDim.x) {
    const int c = it % NCH, bh = it / NCH;
    gdn_pre_item(p, l, bh >> 2, bh & 3, c, tid);
  }
  if (gridDim.x == 256) {
    const int w = blockIdx.x;
    int first, count, stride;
    if (w < 32) { first = 896 + w; count = 3; stride = 32; }
    else { first = w - 32; count = 4; stride = 224; }
    for (int k = 0; k < count; ++k) {
      const int x = first + k * stride;
      gla_pre_item(p, l, (x / NCH) >> 2, (x / NCH) & 3, x % NCH, tid);
    }
    if (w >= 32 && w < 96) {
      const int x = 992 + (w - 32);
      gla_pre_item(p, l, (x / NCH) >> 2, (x / NCH) & 3, x % NCH, tid);
    }
  } else {
    for (int x = blockIdx.x; x < NCHH; x += gridDim.x) gla_pre_item(p, l, (x / NCH) >> 2, (x / NCH) & 3, x % NCH, tid);
  }
}

__device__ __forceinline__ void img_load(const unsigned char* img, int bytes, int ldsoff, const int tid) {
  LAS unsigned char* lds = (LAS unsigned char*)smem_raw;
  const int wid = __builtin_amdgcn_readfirstlane(tid >> 6), lane = tid & 63;
  for (int k = 0; k * 8192 < bytes; ++k)
    __builtin_amdgcn_global_load_lds((const unsigned*)(img + k * 8192 + wid * 1024 + lane * 16),
                                     (LAS unsigned*)(lds + ldsoff + k * 8192 + wid * 1024), 16, 0, 0);
}

__device__ __forceinline__ void gdn_scan(const Params& p, int l, int b, int h, const int tid) {
  unsigned char* ws = p.ws;
  const LAS unsigned char* lds = (const LAS unsigned char*)smem_raw;
  asm volatile("" : "+v"(lds));
  bf16* O = (bf16*)(ws + OFF_R2);
  const int wid = tid >> 6, lane = tid & 63, r = lane & 15, q = lane >> 4;
  const int n = 16 * wid + r;
  const unsigned char* img0 = ws + OFF_GDN_IMG + (size_t)((b * 4 + h) * NCH) * GDN_IMG;
  const float* GT = reinterpret_cast<const float*>(ws + OFF_GT) + (b * 4 + h) * NCH;
  f32x4 S[8];
#pragma unroll
  for (int k = 0; k < 8; ++k) S[k] = f32x4{0.f, 0.f, 0.f, 0.f};
  constexpr int BUF = 57344;
  img_load(img0, BUF, 0, tid);
  u32x2 u0n[4];
#pragma unroll
  for (int it = 0; it < 4; ++it) u0n[it] = *reinterpret_cast<const u32x2*>(img0 + 57344 + ((wid * 4 + it) * 64 + lane) * 8);
  const float* gtp = GT + (lane & 0);
  asm volatile("" : "+v"(gtp));
  asm volatile("s_waitcnt vmcnt(0)" ::: "memory");
  __syncthreads();
#pragma unroll 1
  for (int c = 0; c < NCH; ++c) {
    const unsigned char* img = img0 + (size_t)c * GDN_IMG;
    const float gt = gtp[c];
    f32x4 U[4], Oc[4];
#pragma unroll
    for (int it = 0; it < 4; ++it) {
      U[it] = f32x4{bflo(u0n[it].x), bfhi(u0n[it].x), bflo(u0n[it].y), bfhi(u0n[it].y)};
      Oc[it] = f32x4{0.f, 0.f, 0.f, 0.f};
    }
    if (c + 1 < NCH) {
      img_load(img + GDN_IMG, BUF, ((c + 1) & 1) * BUF, tid);
#pragma unroll
      for (int it = 0; it < 4; ++it) u0n[it] = *reinterpret_cast<const u32x2*>(img + GDN_IMG + 57344 + ((wid * 4 + it) * 64 + lane) * 8);
    }
    const LAS unsigned char* buf = lds + (c & 1) * BUF;
    bf16x8 Sf[4];
    Sf[0] = frag_from_tiles(S[0], S[1]);
    Sf[1] = frag_from_tiles(S[2], S[3]);
#define SB __builtin_amdgcn_sched_barrier(0)
#define LW(F, ks) _Pragma("unroll") for (int it = 0; it < 4; ++it) F[it] = lds_frag16(buf + (it * 4 + (ks)) * 1024 + lane * 16);
#define LQ(F, ks) _Pragma("unroll") for (int it = 0; it < 4; ++it) F[it] = lds_frag16(buf + 16384 + (it * 4 + (ks)) * 1024 + lane * 16);
#define LK(F, g) _Pragma("unroll") for (int i = 0; i < 4; ++i) F[i] = lds_frag16(buf + 32768 + ((g) * 4 + i) * 1024 + lane * 16);
#define LD(F, g) _Pragma("unroll") for (int i = 0; i < 4; ++i) F[i] = lds_frag16(buf + 40960 + ((g) * 4 + i) * 1024 + lane * 16);
#define MW(F, ks) _Pragma("unroll") for (int it = 0; it < 4; ++it) U[it] = MFMA16(F[it], Sf[ks], U[it]);
#define MQ(F, ks) _Pragma("unroll") for (int it = 0; it < 4; ++it) Oc[it] = MFMA16(F[it], Sf[ks], Oc[it]);
#define MK(F, g) _Pragma("unroll") for (int i = 0; i < 4; ++i) Oc[(g) * 2 + (i >> 1)] = MFMA16(F[i], Uf[i & 1], Oc[(g) * 2 + (i >> 1)]);
#define MD(F, g) _Pragma("unroll") for (int i = 0; i < 4; ++i) {                                   \
      if ((i & 1) == 0) S[(g) * 2 + (i >> 1)] = S[(g) * 2 + (i >> 1)] * gt;                        \
      S[(g) * 2 + (i >> 1)] = MFMA16(F[i], Uf[i & 1], S[(g) * 2 + (i >> 1)]); }
    bf16x8 f0[4], f1[4];
    LW(f0, 0) LQ(f1, 0) SB;
    MW(f0, 0) LW(f0, 1) SB;
    Sf[2] = frag_from_tiles(S[4], S[5]);
    Sf[3] = frag_from_tiles(S[6], S[7]);
    MQ(f1, 0) LQ(f1, 1) SB;
    MW(f0, 1) LW(f0, 2) SB;
    MQ(f1, 1) LQ(f1, 2) SB;
    MW(f0, 2) LW(f0, 3) SB;
    MQ(f1, 2) LQ(f1, 3) SB;
    MW(f0, 3) LK(f0, 0) SB;
    MQ(f1, 3) LK(f1, 1) SB;
    bf16x8 Uf[2];
    Uf[0] = frag_from_tiles(U[0], U[1]);
    Uf[1] = frag_from_tiles(U[2], U[3]);
    MK(f0, 0) LD(f0, 0) SB;
    MK(f1, 1) LD(f1, 1) SB;
    MD(f0, 0) LD(f0, 2) SB;
    MD(f1, 1) LD(f1, 3) SB;
    MD(f0, 2) MD(f1, 3)
#undef LW
#undef LQ
#undef LK
#undef LD
#undef MW
#undef MQ
#undef MK
#undef MD
    {
      const int tbc = (c == 0) ? 0 : 16 + 64 * (c - 1), nvc = (c == 0) ? 16 : 64;
      bf16* ob = O + ((size_t)b * LP + tbc + 4 * q) * 1024 + h * 128 + n;
      asm volatile("" : "+v"(ob));
#pragma unroll
      for (int it = 0; it < 4; ++it)
#pragma unroll
        for (int e = 0; e < 4; ++e) {
          const int i = 16 * it + 4 * q + e;
          if (i < nvc) *reinterpret_cast<u16*>(ob + (16 * it + e) * 1024) = f2bf(Oc[it][e]);
        }
    }
    asm volatile("s_waitcnt vmcnt(0)" ::: "memory");
    __syncthreads();
  }
  float* so = p.out + OUT_GDNP + (((size_t)l * NBATCH + b) * 4 + h) * 128 * 128 + n;
#pragma unroll
  for (int kt = 0; kt < 8; ++kt)
#pragma unroll
    for (int e = 0; e < 4; ++e) so[(size_t)(16 * kt + 4 * q + e) * 128] = S[kt][e];
}

__device__ __forceinline__ void gla_vload(const bf16* __restrict__ P2, size_t row0, int nvalid, int h, int n, int q, bf16x8* Vf) {
#pragma unroll
  for (int s = 0; s < 2; ++s) {
    u16 v[8];
#pragma unroll
    for (int e = 0; e < 8; ++e) {
      const int jj = 32 * s + (e < 4 ? 4 * q + e : 16 + 4 * q + (e - 4));
      v[e] = (jj < nvalid) ? *reinterpret_cast<const u16*>(P2 + (row0 + jj) * 2048 + 1024 + h * 128 + n) : (u16)0;
    }
    Vf[s] = mk_frag((u32)v[0] | ((u32)v[1] << 16), (u32)v[2] | ((u32)v[3] << 16), (u32)v[4] | ((u32)v[5] << 16), (u32)v[6] | ((u32)v[7] << 16));
  }
}
__device__ __forceinline__ void gla_scan(const Params& p, int l, int b, int h, const int tid) {
  unsigned char* ws = p.ws;
  const LAS unsigned char* lds = (const LAS unsigned char*)smem_raw;
  asm volatile("" : "+v"(lds));
  const bf16* P2 = (const bf16*)(ws + OFF_R3);
  bf16* O = (bf16*)(ws + OFF_R2);
  const int wid = tid >> 6, lane = tid & 63, r = lane & 15, q = lane >> 4;
  const int n = 16 * wid + r;
  const unsigned char* img0 = ws + OFF_GLA_IMG + (size_t)((b * 4 + h) * NCH) * GLA_IMG;
  f32x4 S[4];
#pragma unroll
  for (int k = 0; k < 4; ++k) S[k] = f32x4{0.f, 0.f, 0.f, 0.f};
  constexpr int BUF = 24576;
  img_load(img0, BUF, 0, tid);
  bf16x8 Vn[2];
  f32x4 atn[4];
  gla_vload(P2, (size_t)b * LP, 16, h, n, q, Vn);
#pragma unroll
  for (int kt = 0; kt < 4; ++kt) atn[kt] = *reinterpret_cast<const f32x4*>(img0 + 24576 + (16 * kt + 4 * q) * 4);
  u32x2 opk[4];
#pragma unroll
  for (int it = 0; it < 4; ++it) opk[it] = u32x2{0u, 0u};
  asm volatile("s_waitcnt vmcnt(0)" ::: "memory");
  __syncthreads();
#pragma unroll 1
  for (int c = 0; c < NCH; ++c) {
    const unsigned char* img = img0 + (size_t)c * GLA_IMG;
    bf16x8 Vf[2];
    f32x4 at[4];
    Vf[0] = Vn[0]; Vf[1] = Vn[1];
#pragma unroll
    for (int kt = 0; kt < 4; ++kt) at[kt] = atn[kt];
    if (c + 1 < NCH) {
      img_load(img + GLA_IMG, BUF, ((c + 1) & 1) * BUF, tid);
      gla_vload(P2, (size_t)b * LP + 16 + 64 * c, 64, h, n, q, Vn);
#pragma unroll
      for (int kt = 0; kt < 4; ++kt) atn[kt] = *reinterpret_cast<const f32x4*>(img + GLA_IMG + 24576 + (16 * kt + 4 * q) * 4);
    }
    if (c > 0) {
      const int tbp = (c == 1) ? 0 : 16 + 64 * (c - 2), nvp = (c == 1) ? 16 : 64;
      const size_t rowp = (size_t)b * LP + tbp;
#pragma unroll
      for (int it = 0; it < 4; ++it)
#pragma unroll
        for (int e = 0; e < 4; ++e) {
          const int i = 16 * it + 4 * q + e;
          const u32 w = (e < 2) ? opk[it].x : opk[it].y;
          if (i < nvp) *reinterpret_cast<u16*>(O + (rowp + i) * 1024 + 512 + h * 128 + n) = (u16)((e & 1) ? (w >> 16) : (w & 0xffffu));
        }
    }
    const LAS unsigned char* buf = lds + (c & 1) * BUF;
    bf16x8 Sf[2];
    Sf[0] = frag_from_tiles(S[0], S[1]);
    Sf[1] = frag_from_tiles(S[2], S[3]);
#pragma unroll
    for (int it = 0; it < 4; ++it) {
      f32x4 o = {0.f, 0.f, 0.f, 0.f};
#pragma unroll
      for (int ks = 0; ks < 2; ++ks) o = MFMA16(lds_frag16(buf + (it * 2 + ks) * 1024 + lane * 16), Sf[ks], o);
#pragma unroll
      for (int s = 0; s < 2; ++s) o = MFMA16(lds_frag16(buf + 8192 + (it * 2 + s) * 1024 + lane * 16), Vf[s], o);
      opk[it].x = pk2(o[0], o[1]); opk[it].y = pk2(o[2], o[3]);
    }
    __builtin_amdgcn_sched_barrier(0);
#pragma unroll
    for (int kt = 0; kt < 4; ++kt) {
      f32x4 sv = S[kt] * at[kt];
#pragma unroll
      for (int s = 0; s < 2; ++s) sv = MFMA16(lds_frag16(buf + 16384 + (kt * 2 + s) * 1024 + lane * 16), Vf[s], sv);
      S[kt] = sv;
    }
    asm volatile("s_waitcnt vmcnt(0)" ::: "memory");
    __syncthreads();
  }
  {
    const int tbp = 16 + 64 * (NCH - 2);
    const size_t rowp = (size_t)b * LP + tbp;
#pragma unroll
    for (int it = 0; it < 4; ++it)
#pragma unroll
      for (int e = 0; e < 4; ++e) {
        const int i = 16 * it + 4 * q + e;
        const u32 w = (e < 2) ? opk[it].x : opk[it].y;
        *reinterpret_cast<u16*>(O + (rowp + i) * 1024 + 512 + h * 128 + n) = (u16)((e & 1) ? (w >> 16) : (w & 0xffffu));
      }
  }
  float* so = p.out + OUT_GLAP + (((size_t)l * NBATCH + b) * 4 + h) * 64 * 128 + n;
#pragma unroll
  for (int kt = 0; kt < 4; ++kt)
#pragma unroll
    for (int e = 0; e < 4; ++e) so[(size_t)(16 * kt + 4 * q + e) * 128] = S[kt][e];
}

__device__ __forceinline__ void phase_scan(const Params& p, int l) {
  const int tid = opaque_tid();
  const int wid = tid >> 6;
  for (int j = blockIdx.x; j < 64; j += gridDim.x) {
    if (j < 32) gdn_scan(p, l, j >> 2, j & 3, tid);
    else gla_scan(p, l, (j - 32) >> 2, j & 3, tid);
  }
  const int nsw = gridDim.x > 64 ? (int)gridDim.x - 64 : (int)gridDim.x;
  const int myw = gridDim.x > 64 ? (int)blockIdx.x - 64 : (int)blockIdx.x;
  if (myw >= 0) {
    float* lds = (float*)(smem_raw + wid * 2048);
    for (int s = myw * NWAVES + wid; s < 2048; s += nsw * NWAVES) {
      const int j = s & 1023;
      if (s < 1024) gdn_job(p, l, j >> 3, (j >> 1) & 3, j & 1, lds, tid);
      else gla_job(p, l, j >> 3, (j >> 1) & 3, j & 1, true, lds, tid);
    }
  }
}

__device__ __forceinline__ void phase_gnorm(const Params& p, int l) {
  const int tid = opaque_tid();
  unsigned char* ws = p.ws;
  const bf16* P2 = (const bf16*)(ws + OFF_R3);
  bf16* O = (bf16*)(ws + OFF_R2);
  const int wid = tid >> 6, lane = tid & 63;
  const int gw = blockIdx.x * NWAVES + wid, NGW = gridDim.x * NWAVES;
  const int cw = (lane & 15) * 8;
  float wA[8], wB[8];
#pragma unroll
  for (int e = 0; e < 8; ++e) { wA[e] = p.in[10][l * 128 + cw + e]; wB[e] = p.in[13][l * 128 + cw + e]; }
  for (int row = gw; row < MT; row += NGW) {
#pragma unroll
    for (int j = 0; j < 2; ++j) {
      const int c0 = j * 512 + lane * 8;
      float o[8], z[8];
      unpack8(*reinterpret_cast<const u32x4*>(O + (size_t)row * 1024 + c0), o);
      unpack8(*reinterpret_cast<const u32x4*>(P2 + (size_t)row * 2048 + (j == 0 ? 0 : 1536) + lane * 8), z);
      float ss = 0.f;
#pragma unroll
      for (int e = 0; e < 8; ++e) ss += o[e] * o[e];
      ss = sum16(ss);
      const float sc = rsqrtf(ss * (1.f / 128.f) + 1e-6f);
#pragma unroll
      for (int e = 0; e < 8; ++e) o[e] = o[e] * sc * (j == 0 ? wA[e] : wB[e]) * (z[e] * sigmoidf_(z[e]));
      *reinterpret_cast<u32x4*>(O + (size_t)row * 1024 + c0) = pack8(o);
    }
  }
}

__device__ __forceinline__ void phase_merge(const Params& p) {
  const int tid = opaque_tid();
  unsigned char* ws = p.ws;
  const bf16* O = (const bf16*)(ws + OFF_R2);
  const bf16* P3 = (const bf16*)(ws + OFF_R4);
  bf16* MG = (bf16*)(ws + OFF_R3);
  for (int u = 0;; ++u) {
    const int t = blockIdx.x + (u >> 1) * gridDim.x, br = u & 1;
    if (t >= 4 * 64) break;
    const int pn = t / 64, pm = t % 64, brow = pm * 256, bcol = pn * 256;
    {
      Acc acc; acc_zero(acc);
      gemm_kloop(acc, O + br * 512, 1024, (const bf16*)(ws + (br ? OFF_WB : OFF_WA)), 512, 512, brow, bcol, tid, true);
      int brow_e = brow;
      asm volatile("" : "+s"(brow_e));
      EPI_COORDS
#pragma unroll
      for (int ai = 0; ai < 2; ++ai)
#pragma unroll
        for (int bj = 0; bj < 2; ++bj)
#pragma unroll
          for (int m = 0; m < 4; ++m) {
            const int erow = brow_e + ai * 128 + wr * 64 + m * 16 + fr;
            const int ecol = bcol + bj * 128 + wc * 32 + 8 * fq;
            float g[8], r[8];
            unpack8(*reinterpret_cast<const u32x4*>(P3 + (size_t)erow * 2048 + br * 1024 + ecol), g);
            bf16* mp = MG + (size_t)erow * 1024 + ecol;
            const f32x4 v0 = acc[ai][bj][m][0], v1 = acc[ai][bj][m][1];
#pragma unroll
            for (int j = 0; j < 4; ++j) { r[j] = v0[j] * sigmoidf_(g[j]); r[4 + j] = v1[j] * sigmoidf_(g[4 + j]); }
            if (br) {
              float pv[8];
              unpack8(*reinterpret_cast<const u32x4*>(mp), pv);
#pragma unroll
              for (int j = 0; j < 8; ++j) r[j] += pv[j];
            }
            *reinterpret_cast<u32x4*>(mp) = pack8(r);
            __builtin_amdgcn_sched_barrier(0);
          }
    }
  }
  __syncthreads();
  tail_gemm<1>(p, O, 1024, (const bf16*)(ws + OFF_WA), 512, 512, 1024, 0, tid);
  tail_gemm<1>(p, O + 512, 1024, (const bf16*)(ws + OFF_WB), 512, 512, 1024, 1, tid);
}

__device__ __forceinline__ void phase_gemm_resid(const Params& p, const bf16* A, int lda, const bf16* Wt, int K) {
  const int tid = opaque_tid();
  unsigned char* ws = p.ws;
  const bf16* Xb = (const bf16*)(ws + OFF_XB);
  bf16* PL = (bf16*)(ws + OFF_R4);
  for (int t = blockIdx.x; t < 4 * 64; t += gridDim.x) {
    const int pn = t / 64, pm = t % 64, brow = pm * 256, bcol = pn * 256;
    Acc acc; acc_zero(acc);
    gemm_kloop(acc, A, lda, Wt, K, K, brow, bcol, tid, true);
    EPI_COORDS
#pragma unroll
    for (int ai = 0; ai < 2; ++ai)
#pragma unroll
      for (int bj = 0; bj < 2; ++bj)
#pragma unroll
        for (int m = 0; m < 4; ++m) {
          const size_t off = (size_t)(brow + ai * 128 + wr * 64 + m * 16 + fr) * 1024 + bcol + bj * 128 + wc * 32 + 8 * fq;
          float x[8], r[8];
          unpack8(*reinterpret_cast<const u32x4*>(Xb + off), x);
          const f32x4 v0 = acc[ai][bj][m][0], v1 = acc[ai][bj][m][1];
#pragma unroll
          for (int j = 0; j < 4; ++j) { r[j] = v0[j] + ALPHA * x[j]; r[4 + j] = v1[j] + ALPHA * x[4 + j]; }
          *reinterpret_cast<u32x4*>(PL + off) = pack8(r);
        }
  }
  __syncthreads();
  tail_gemm<2>(p, A, lda, Wt, K, K, 1024, 0, tid);
}

__device__ __forceinline__ void phase_ffn_in(const Params& p) {
  const int tid = opaque_tid();
  unsigned char* ws = p.ws;
  const bf16* Xb = (const bf16*)(ws + OFF_XB);
  bf16* H = (bf16*)(ws + OFF_R2);
  for (int t = blockIdx.x; t < 22 * NMT; t += gridDim.x) {
    int pn, pm;
    tile_xcd(t, 22, pm, pn);
    const int brow = pm * 256, bcol = pn * 256;
    Acc acc; acc_zero(acc);
    gemm_kloop(acc, Xb, 1024, (const bf16*)(ws + OFF_WFI), 1024, 1024, brow, bcol, tid);
    EPI_COORDS
#pragma unroll
    for (int ai = 0; ai < 2; ++ai)
#pragma unroll
      for (int m = 0; m < 4; ++m) {
        float r[8];
#pragma unroll
        for (int bj = 0; bj < 2; ++bj) {
          const f32x4 a = acc[ai][bj][m][0], u = acc[ai][bj][m][1];
#pragma unroll
          for (int j = 0; j < 4; ++j) r[bj * 4 + j] = a[j] * sigmoidf_(a[j]) * u[j];
        }
        const int hc = (bcol >> 1) + wc * 32 + fq * 8;
        *reinterpret_cast<u32x4*>(H + (size_t)(brow + ai * 128 + wr * 64 + m * 16 + fr) * DFF + hc) = pack8(r);
      }
  }
}

__device__ __forceinline__ void phase_ln(const Params& p, const float* g, const float* bta, bool final_out) {
  const int tid = opaque_tid();
  unsigned char* ws = p.ws;
  const bf16* PL = (const bf16*)(ws + OFF_R4);
  bf16* Xb = (bf16*)(ws + OFF_XB);
  const int wid = tid >> 6, lane = tid & 63;
  const int gw = blockIdx.x * NWAVES + wid, NGW = gridDim.x * NWAVES;
  float gg[2][8], bb[2][8];
#pragma unroll
  for (int j = 0; j < 2; ++j)
#pragma unroll
    for (int e = 0; e < 8; e += 4) {
      const f32x4 gv = *reinterpret_cast<const f32x4*>(g + j * 512 + lane * 8 + e), bv = *reinterpret_cast<const f32x4*>(bta + j * 512 + lane * 8 + e);
      gg[j][e] = gv[0]; gg[j][e + 1] = gv[1]; gg[j][e + 2] = gv[2]; gg[j][e + 3] = gv[3];
      bb[j][e] = bv[0]; bb[j][e + 1] = bv[1]; bb[j][e + 2] = bv[2]; bb[j][e + 3] = bv[3];
    }
  for (int row = gw; row < MT; row += NGW) {
    float v[2][8];
    float s = 0.f;
#pragma unroll
    for (int j = 0; j < 2; ++j) {
      unpack8(*reinterpret_cast<const u32x4*>(PL + (size_t)row * 1024 + j * 512 + lane * 8), v[j]);
#pragma unroll
      for (int e = 0; e < 8; ++e) s += v[j][e];
    }
    const float mean = sum64(s) * (1.f / 1024.f);
    float s2 = 0.f;
#pragma unroll
    for (int j = 0; j < 2; ++j)
#pragma unroll
      for (int e = 0; e < 8; ++e) { v[j][e] -= mean; s2 += v[j][e] * v[j][e]; }
    const float rstd = rsqrtf(sum64(s2) * (1.f / 1024.f) + 1e-5f);
    float* dst = nullptr;
    if (final_out) {
      if (row < MP) {
        const int b = row / LP, t = row - b * LP;
        if (t >= 16) dst = p.out + OUT_YP + ((size_t)b * 2048 + (t - 16)) * 1024;
      } else {
        dst = p.out + OUT_YS + (size_t)(row - MP) * 1024;
      }
    }
#pragma unroll
    for (int j = 0; j < 2; ++j) {
      float y[8];
#pragma unroll
      for (int e = 0; e < 8; ++e) y[e] = v[j][e] * rstd * gg[j][e] + bb[j][e];
      if (final_out) {
        if (dst) {
          *reinterpret_cast<f32x4*>(dst + j * 512 + lane * 8) = f32x4{y[0], y[1], y[2], y[3]};
          *reinterpret_cast<f32x4*>(dst + j * 512 + lane * 8 + 4) = f32x4{y[4], y[5], y[6], y[7]};
        }
      } else {
        *reinterpret_cast<u32x4*>(Xb + (size_t)row * 1024 + j * 512 + lane * 8) = pack8(y);
      }
    }
  }
}

#define XB_TMO      128
#define XB_XCNT(j)  (256  + 64 * (j))
#define XB_XSUB(j)  (1280 + 64 * (j))
#define XB_XGEN(j)  (2304 + 64 * (j))
#define XB_TOP      3328
#define XB_TOPGEN   3392
#define XCD_BAR_WORDS 3456
#define XB_SPIN_CAP (1u << 18)

__device__ __forceinline__ unsigned xb_ld(unsigned* p)              { return __hip_atomic_load(p, __ATOMIC_RELAXED, __HIP_MEMORY_SCOPE_AGENT); }
__device__ __forceinline__ unsigned xb_add(unsigned* p, unsigned v) { return __hip_atomic_fetch_add(p, v, __ATOMIC_RELAXED, __HIP_MEMORY_SCOPE_AGENT); }
__device__ __forceinline__ unsigned xb_xcc_id() { return (unsigned)__builtin_amdgcn_s_getreg((3 << 11) | 20) & 0xFu; }
#define XB_SPIN(cond, bar) do { unsigned _sp = 0; while (cond) { __builtin_amdgcn_s_sleep(1); \
    if ((++_sp & 255u) == 0u) { if (xb_ld(&(bar)[XB_TMO])) break; if (_sp > XB_SPIN_CAP) { atomicAdd(&(bar)[XB_TMO], 1u); break; } } } } while (0)

struct XcdBarrier {
    unsigned* bar; unsigned x;
    volatile LAS unsigned* st;
};

__device__ __forceinline__ XcdBarrier xcd_barrier_post(unsigned* bar, volatile LAS unsigned* st) {
    XcdBarrier b; b.bar = bar; b.x = xb_xcc_id(); b.st = st;
    if (threadIdx.x == 0) (void)xb_add(&bar[XB_XCNT(b.x)], 1u);
    return b;
}
__device__ __forceinline__ void xcd_barrier_complete(unsigned* bar, unsigned x, unsigned& nloc, unsigned& nx) {
    const unsigned G = gridDim.x * gridDim.y * gridDim.z;
    unsigned sum, cnt, mine, sp = 0u;
    for (;;) {
        sum = 0u; cnt = 0u; mine = 0u;
#pragma unroll
        for (unsigned j = 0; j < 16; ++j) { const unsigned c = xb_ld(&bar[XB_XCNT(j)]); sum += c; cnt += (c > 0u) ? 1u : 0u; mine = (j == x) ? c : mine; }
        if (sum == G) break;
        __builtin_amdgcn_s_sleep(1);
        if ((++sp & 255u) == 0u) { if (xb_ld(&bar[XB_TMO])) break; if (sp > XB_SPIN_CAP) { atomicAdd(&bar[XB_TMO], 1u); break; } }
    }
    nloc = mine > 0u ? mine : 1u; nx = cnt > 0u ? cnt : 1u;
}

__device__ __forceinline__ void xcd_barrier(const XcdBarrier& b) {
    asm volatile("s_waitcnt vmcnt(0)" ::: "memory");
    __syncthreads();
    if (threadIdx.x == 0) {
        unsigned* bar = b.bar;
        __builtin_amdgcn_s_waitcnt(0);
        unsigned nloc = b.st[0], nx = b.st[1];
        if (nloc == 0u) { xcd_barrier_complete(bar, b.x, nloc, nx); b.st[0] = nloc; b.st[1] = nx; }
        const unsigned old = xb_add(&bar[XB_XSUB(b.x)], 1u);
        const unsigned gen = old / nloc;
        if (old + 1u == (gen + 1u) * nloc) {
            __builtin_amdgcn_fence(__ATOMIC_RELEASE, "agent");
            asm volatile("s_waitcnt vmcnt(0)" ::: "memory");
            const unsigned og = xb_add(&bar[XB_TOP], 1u);
            const unsigned tg = og / nx;
            if (og + 1u == (tg + 1u) * nx) xb_add(&bar[XB_TOPGEN], 1u);
            else XB_SPIN(xb_ld(&bar[XB_TOPGEN]) == tg, bar);
            __builtin_amdgcn_fence(__ATOMIC_ACQUIRE, "agent");
            xb_add(&bar[XB_XGEN(b.x)], 1u);
            asm volatile("s_waitcnt vmcnt(0)" ::: "memory");
        } else {
            XB_SPIN(xb_ld(&bar[XB_XGEN(b.x)]) == gen, bar);
            __builtin_amdgcn_fence(__ATOMIC_ACQUIRE, "agent");
            asm volatile("s_waitcnt vmcnt(0)" ::: "memory");
        }
    }
    __syncthreads();
}


__global__ void __launch_bounds__(NTHREADS, 2) fwd_kernel(Params p_in) {
  volatile LAS unsigned* xb_st = (volatile LAS unsigned*)((LAS unsigned char*)smem_raw + 131072);
  if (threadIdx.x == 0) { xb_st[0] = 0u; xb_st[1] = 0u; xb_st[2] = 0u; xb_st[3] = 0u; }
  __syncthreads();
  const XcdBarrier xb = xcd_barrier_post((unsigned*)(p_in.ws + OFF_BAR), xb_st);
  for (int ph = p_in.ph_lo; ph < p_in.ph_hi; ++ph) {
    const int l = ph / PH_PER_LAYER, k = ph % PH_PER_LAYER;
    Params p = p_in;
    {
      unsigned long long wsi = (unsigned long long)p_in.ws, outi = (unsigned long long)p_in.out;
      asm volatile("" : "+s"(wsi), "+s"(outi));
      p.ws = (unsigned char*)(__attribute__((address_space(1))) unsigned char*)wsi;
      p.out = (float*)(__attribute__((address_space(1))) float*)outi;
    }
    unsigned char* ws = p.ws;
    const int nrep = 1 + ((REPEAT_MASK >> k) & 1);
    for (int rep = 0; rep < nrep; ++rep) {
    if (rep) xcd_barrier(xb);
    switch (k) {
      case 0: if (l == 0) phase_convert(p, 0, 1 | 8, 0); break;
      case 1: phase_gemm_in(p, false); break;
      case 2: phase_pre(p, l); break;
      case 3: phase_scan(p, l);
              __syncthreads();
              phase_convert(p, l, 2 | 4, gridDim.x > 64 ? 64 : 0);
              break;
      case 4: phase_gnorm(p, l); phase_gemm_in(p, true); break;
      case 5: break;
      case 6: phase_merge(p); break;
      case 7: phase_gemm_resid(p, (const bf16*)(ws + OFF_R3), 1024, (const bf16*)(ws + OFF_WO), 1024); break;
      case 8: phase_ln(p, p.in[17] + l * 1024, p.in[18] + l * 1024, false);
              if (l == 0) phase_convert(p, 1, 1, 0);
              break;
      case 9: phase_ffn_in(p); break;
      case 10: phase_gemm_resid(p, (const bf16*)(ws + OFF_R2), DFF, (const bf16*)(ws + OFF_WFO), DFF); break;
      case 11: phase_ln(p, p.in[19] + l * 1024, p.in[20] + l * 1024, l == 1);
               break;
    }
    }
#if EXTRA_SYNCS
    for (int xs = 0; xs < EXTRA_SYNCS; ++xs) xcd_barrier(xb);
#endif
    const bool empty_phase = (k == 5) || (k == 0 && l > 0);
    if (ph + 1 < p_in.ph_hi && !empty_phase) {
      if (p_in.ph_hi > NPHASES) { __syncthreads(); cg::this_grid().sync(); }
      xcd_barrier(xb);
    }
  }
}

extern "C" void kernel_launch(void* const* d_in, const int* in_sizes, int n_in, void* d_out, int out_size, void* d_ws,
                              size_t ws_size, hipStream_t stream) {
  constexpr int LDS_BYTES = 131072 + 16;
  static int grid = 0;
  if (grid == 0) {
    int dev = 0, cus = 0;
    hipGetDevice(&dev);
    hipDeviceGetAttribute(&cus, hipDeviceAttributeMultiprocessorCount, dev);
    hipFuncSetAttribute((const void*)fwd_kernel, hipFuncAttributeMaxDynamicSharedMemorySize, LDS_BYTES);
    int per_cu = 0;
    hipOccupancyMaxActiveBlocksPerMultiprocessor(&per_cu, (const void*)fwd_kernel, NTHREADS, LDS_BYTES);
    (void)hipGetLastError();
    grid = cus > 0 ? cus : 256;
    if (ws_size < WS_END) fprintf(stderr, "kernel_launch: workspace too small: %zu < %zu\n", ws_size, (size_t)WS_END);
    if (per_cu < 1) fprintf(stderr, "kernel_launch: occupancy query says %d blocks per CU\n", per_cu);
  }
  Params p{};
  for (int i = 0; i < 23; ++i) p.in[i] = (const float*)d_in[i];
  p.out = (float*)d_out;
  p.ws = (unsigned char*)d_ws;
  (void)hipMemsetAsync((unsigned char*)d_ws + OFF_BAR, 0, BAR_BYTES, stream);
#if SINGLE_LAUNCH
  p.ph_lo = 0; p.ph_hi = NPHASES;
  void* args[] = {&p};
  hipError_t e = hipLaunchCooperativeKernel((const void*)fwd_kernel, dim3(grid), dim3(NTHREADS), args, LDS_BYTES, stream);
  if (e != hipSuccess) fprintf(stderr, "cooperative launch failed: %s (grid %d)\n", hipGetErrorString(e), grid);
#else
  for (int ph = 0; ph < NPHASES; ++ph) {
    p.ph_lo = ph; p.ph_hi = ph + 1;
    hipLaunchKernelGGL(fwd_kernel, dim3(grid), dim3(NTHREADS), LDS_BYTES, stream, p);
  }
#endif
}
```

```cpp
#include <hip/hip_runtime.h>
#include <hip/hip_bf16.h>
#include <hip/hip_cooperative_groups.h>
#include <cstdio>
namespace cg = cooperative_groups;

#ifndef SINGLE_LAUNCH
#define SINGLE_LAUNCH 1
#endif
#ifndef REPEAT_MASK
#define REPEAT_MASK 0
#endif
#ifndef EXTRA_SYNCS
#define EXTRA_SYNCS 0
#endif

typedef __hip_bfloat16 bf16;
typedef unsigned short u16;
typedef unsigned int u32;
using bf16x8 = __attribute__((ext_vector_type(8))) short;
using f32x4 = __attribute__((ext_vector_type(4))) float;
using u32x4 = __attribute__((ext_vector_type(4))) unsigned int;
using u32x2 = __attribute__((ext_vector_type(2))) unsigned int;

constexpr int D = 1024;
constexpr int NBATCH = 8, LP = 2064, MP = NBATCH * LP;
constexpr int NS = 128;
constexpr int MT = MP + NS;
constexpr int NMT = MT / 256;
constexpr int DIN_SRC = 5656, DIN_PAD = 5888;
constexpr int DFF = 2816;
constexpr int NTHREADS = 512, NWAVES = 8;
constexpr int PH_PER_LAYER = 12, NPHASES = 2 * PH_PER_LAYER;
constexpr float ALPHA = 1.4142135623730951f;

constexpr size_t SZ_WIN = (size_t)DIN_PAD * 1024 * 2;
constexpr size_t SZ_WFI = (size_t)2 * DFF * 1024 * 2;
constexpr size_t SZ_WFO = (size_t)1024 * DFF * 2;
constexpr size_t SZ_WA = (size_t)1024 * 512 * 2;
constexpr size_t SZ_WO = (size_t)1024 * 1024 * 2;
constexpr size_t OFF_WIN = 0;
constexpr size_t OFF_WFI = OFF_WIN + SZ_WIN;
constexpr size_t OFF_WFO = OFF_WFI + SZ_WFI;
constexpr size_t OFF_WA = OFF_WFO + SZ_WFO;
constexpr size_t OFF_WB = OFF_WA + SZ_WA;
constexpr size_t OFF_WO = OFF_WB + SZ_WA;
constexpr size_t OFF_XB = OFF_WO + SZ_WO;
constexpr size_t OFF_R2 = OFF_XB + (size_t)MT * 1024 * 2;
constexpr size_t OFF_R3 = OFF_R2 + (size_t)MT * 1536 * 2;
constexpr size_t OFF_R4 = OFF_R3 + (size_t)MT * 2048 * 2;
constexpr size_t R4_BYTES = (size_t)1056 * (73728 + 25088);
constexpr size_t OFF_R5 = OFF_R4 + R4_BYTES;
constexpr size_t OFF_GT = OFF_R5 + (size_t)MT * 32 * 4;
constexpr size_t OFF_QS = OFF_GT + 8192;
constexpr size_t OFF_BAR = OFF_QS + (size_t)NS * 1536 * 2;
constexpr size_t BAR_BYTES = 16384;
constexpr size_t WS_END = OFF_BAR + BAR_BYTES;
static_assert(WS_END <= (size_t)305000000, "workspace budget");
static_assert(R4_BYTES >= (size_t)MT * 1024 * 4, "R4 must hold preLN");

constexpr size_t OUT_YP = 0;
constexpr size_t OUT_YS = OUT_YP + (size_t)8 * 2048 * 1024;
constexpr size_t OUT_GDNP = OUT_YS + (size_t)128 * 1024;
constexpr size_t OUT_GLAP = OUT_GDNP + (size_t)2 * 8 * 4 * 128 * 128;
constexpr size_t OUT_CONVP = OUT_GLAP + (size_t)2 * 8 * 4 * 64 * 128;
constexpr size_t OUT_GDNS = OUT_CONVP + (size_t)2 * 8 * 3 * 1536;
constexpr size_t OUT_GLAS = OUT_GDNS + (size_t)2 * 128 * 4 * 128 * 128;
constexpr size_t OUT_CONVS = OUT_GLAS + (size_t)2 * 128 * 4 * 64 * 128;

struct Params {
  const float* in[23];
  float* out;
  unsigned char* ws;
  int ph_lo, ph_hi;
};

typedef float f32x2_t __attribute__((ext_vector_type(2)));
typedef __bf16 bf16x2_t __attribute__((ext_vector_type(2)));
__device__ __forceinline__ u32 pk2(float lo, float hi) {
  f32x2_t v = {lo, hi};
  bf16x2_t b = __builtin_convertvector(v, bf16x2_t);
  return __builtin_bit_cast(u32, b);
}
__device__ __forceinline__ u16 f2bf(float x) { return (u16)(pk2(x, 0.f) & 0xffffu); }
__device__ __forceinline__ float bflo(u32 w) { return __uint_as_float(w << 16); }
__device__ __forceinline__ float bfhi(u32 w) { return __uint_as_float(w & 0xffff0000u); }
__device__ __forceinline__ float bf1(u16 h) { return __uint_as_float(((u32)h) << 16); }
__device__ __forceinline__ void unpack8(const u32x4 v, float* f) {
  f[0] = bflo(v.x); f[1] = bfhi(v.x); f[2] = bflo(v.y); f[3] = bfhi(v.y);
  f[4] = bflo(v.z); f[5] = bfhi(v.z); f[6] = bflo(v.w); f[7] = bfhi(v.w);
}
__device__ __forceinline__ u32x4 pack8(const float* f) {
  u32x4 v; v.x = pk2(f[0], f[1]); v.y = pk2(f[2], f[3]); v.z = pk2(f[4], f[5]); v.w = pk2(f[6], f[7]);
  return v;
}
template <int X> __device__ __forceinline__ float swz_xor(float v) {
  return __int_as_float(__builtin_amdgcn_ds_swizzle(__float_as_int(v), (X << 10) | 0x1f));
}
__device__ __forceinline__ float sum8(float v) {
  v += swz_xor<1>(v); v += swz_xor<2>(v); v += swz_xor<4>(v);
  return v;
}
__device__ __forceinline__ float sum16(float v) {
  v += swz_xor<1>(v); v += swz_xor<2>(v); v += swz_xor<4>(v); v += swz_xor<8>(v);
  return v;
}
__device__ __forceinline__ float sum64(float v) {
  v += swz_xor<1>(v); v += swz_xor<2>(v); v += swz_xor<4>(v); v += swz_xor<8>(v); v += swz_xor<16>(v);
  return __int_as_float(__builtin_amdgcn_readlane(__float_as_int(v), 0)) + __int_as_float(__builtin_amdgcn_readlane(__float_as_int(v), 32));
}
__device__ __forceinline__ float sigmoidf_(float x) { return __builtin_amdgcn_rcpf(1.f + __expf(-x)); }
__device__ __forceinline__ float softplusf_(float x) { return x > 20.f ? x : __logf(1.f + __expf(x)); }

extern __shared__ __attribute__((aligned(16))) unsigned char smem_raw[];
__device__ __forceinline__ int opaque_tid() { int t = threadIdx.x; asm volatile("" : "+v"(t)); return t; }

constexpr int HT = 128 * 64;
__device__ __forceinline__ int lds_byte(int r, int c) {
  int st = (r >> 4) * 2 + (c >> 5), rr = r & 15, cc = c & 31, ob = rr * 64 + cc * 2;
  return st * 1024 + (ob ^ (((ob >> 9) & 1) << 5));
}
__device__ __forceinline__ void stage_rc(int b, int& R, int& C) {
  int st = b / 1024, sb = b % 1024, swz = sb ^ (((sb >> 9) & 1) << 5);
  R = (st >> 1) * 16 + swz / 64;
  C = (st & 1) * 32 + (swz % 64) / 2;
}

typedef f32x4 Acc[2][2][4][2];

#define LAS __attribute__((address_space(3)))
__device__ __forceinline__ void gemm_kloop(Acc& acc, const bf16* __restrict__ A, int lda, const bf16* __restrict__ Bt, int ldb,
                                           int K, int brow, int bcol, const int tid, const bool perm = false) {
  LAS unsigned char* lds = (LAS unsigned char*)smem_raw;
  const int wid = __builtin_amdgcn_readfirstlane(tid >> 6), lane = tid & 63, wr = wid >> 2, wc = wid & 3,
            fr = lane & 15, fq = lane >> 4;
  unsigned voffA[2], voffB[2];
#pragma unroll
  for (int i = 0; i < 2; ++i) {
    int R, C;
    stage_rc(tid * 16 + i * 8192, R, C);
    voffA[i] = (unsigned)(R * lda + C) * 2u;
    const int p32 = R & 31, Rb = perm ? ((R & ~31) + 8 * ((p32 & 15) >> 2) + 4 * (p32 >> 4) + (p32 & 3)) : R;
    voffB[i] = (unsigned)(Rb * ldb + C) * 2u;
  }
  const size_t kstep = 128, hA = (size_t)128 * lda * 2, hB = (size_t)128 * ldb * 2;
  const unsigned ldsw = (unsigned)wid * 1024u;
  const int aoff = lds_byte(wr * 64 + fr, fq * 8), boff = lds_byte(wc * 32 + fr, fq * 8);
  const char* cA = (const char*)A + (size_t)brow * lda * 2;
  const char* cB = (const char*)Bt + (size_t)bcol * ldb * 2;
#define SA(b, h) (((b) * 2 + (h)) * 16384)
#define SB(b, h) ((4 + (b) * 2 + (h)) * 16384)
#define STAGE(bufoff, gbase, voff)                                                                             \
  do {                                                                                                         \
    _Pragma("unroll") for (int _i = 0; _i < 2; ++_i)                                                           \
        __builtin_amdgcn_global_load_lds((const unsigned*)((const char*)(gbase) + (voff)[_i]),                 \
                                         (LAS unsigned*)(lds + (bufoff) + ldsw + _i * 8192), 16, 0, 0);        \
  } while (0)
#define LDA(dst, b, h)                                                                                         \
  do {                                                                                                         \
    _Pragma("unroll") for (int m = 0; m < 4; ++m) _Pragma("unroll") for (int k = 0; k < 2; ++k)                \
        dst[m][k] = *(const LAS bf16x8*)(lds + SA(b, h) + aoff + m * 2048 + k * 1024);                         \
  } while (0)
#define LDB(dst, b, h)                                                                                         \
  do {                                                                                                         \
    _Pragma("unroll") for (int n = 0; n < 2; ++n) _Pragma("unroll") for (int k = 0; k < 2; ++k)                \
        dst[n][k] = *(const LAS bf16x8*)(lds + SB(b, h) + boff + n * 2048 + k * 1024);                         \
  } while (0)
#define MMA(ai, bj, At_, Bt_)                                                                                  \
  do {                                                                                                         \
    __builtin_amdgcn_s_setprio(1);                                                                             \
    _Pragma("unroll") for (int m = 0; m < 4; ++m) _Pragma("unroll") for (int n = 0; n < 2; ++n)                \
    _Pragma("unroll") for (int k = 0; k < 2; ++k)                                                              \
        acc[ai][bj][m][n] = __builtin_amdgcn_mfma_f32_16x16x32_bf16(Bt_[n][k], At_[m][k], acc[ai][bj][m][n], 0, 0, 0); \
    __builtin_amdgcn_s_setprio(0);                                                                             \
  } while (0)
#define WAIT_V(n) asm volatile("s_waitcnt vmcnt(" #n ")" ::: "memory")
#define WAIT_L(n) asm volatile("s_waitcnt lgkmcnt(" #n ")" ::: "memory")
#define BAR __builtin_amdgcn_s_barrier()
#define SCHED __builtin_amdgcn_sched_barrier(0)
  bf16x8 At[4][2], B0[2][2], B1[2][2];
  const int nt = K / 64;
  STAGE(SB(0, 0), cB, voffB); STAGE(SA(0, 0), cA, voffA); STAGE(SB(0, 1), cB + hB, voffB); STAGE(SA(0, 1), cA + hA, voffA);
  if (wr == 1) BAR;
  WAIT_V(4); BAR;
  STAGE(SB(1, 0), cB + kstep, voffB); STAGE(SA(1, 0), cA + kstep, voffA); STAGE(SB(1, 1), cB + hB + kstep, voffB);
  WAIT_V(6); BAR;
#pragma unroll 1
  for (int t = 0; t < nt - 2; t += 2) {
    const char* a1 = cA + (size_t)(t + 1) * kstep;
    const char* a2 = cA + (size_t)(t + 2) * kstep;
    const char* b2 = cB + (size_t)(t + 2) * kstep;
    const char* a3 = a2 + kstep;
    const char* b3 = b2 + kstep;
    LDB(B0, 0, 0); SCHED; LDA(At, 0, 0); STAGE(SA(1, 1), a1 + hA, voffA);
    WAIT_L(8); BAR; WAIT_L(0); MMA(0, 0, At, B0); BAR; SCHED;
    LDB(B1, 0, 1); STAGE(SB(0, 0), b2, voffB);
    BAR; WAIT_L(0); MMA(0, 1, At, B1); BAR;
    LDA(At, 0, 1); STAGE(SA(0, 0), a2, voffA);
    BAR; WAIT_L(0); MMA(1, 0, At, B0); BAR; SCHED;
    STAGE(SB(0, 1), b2 + hB, voffB);
    WAIT_V(6); BAR; MMA(1, 1, At, B1); BAR;
    LDB(B0, 1, 0); SCHED; LDA(At, 1, 0); STAGE(SA(0, 1), a2 + hA, voffA);
    WAIT_L(8); BAR; WAIT_L(0); MMA(0, 0, At, B0); BAR; SCHED;
    LDB(B1, 1, 1); STAGE(SB(1, 0), b3, voffB);
    BAR; WAIT_L(0); MMA(0, 1, At, B1); BAR;
    LDA(At, 1, 1); STAGE(SA(1, 0), a3, voffA);
    BAR; WAIT_L(0); MMA(1, 0, At, B0); BAR; SCHED;
    STAGE(SB(1, 1), b3 + hB, voffB);
    WAIT_V(6); BAR; MMA(1, 1, At, B1); BAR;
  }
  {
    const char* a1 = cA + (size_t)(nt - 1) * kstep;
    LDB(B0, 0, 0); LDA(At, 0, 0); STAGE(SA(1, 1), a1 + hA, voffA);
    BAR; WAIT_L(0); MMA(0, 0, At, B0); BAR;
    LDB(B1, 0, 1); BAR; WAIT_L(0); MMA(0, 1, At, B1); BAR;
    LDA(At, 0, 1); WAIT_V(4); BAR; WAIT_L(0); MMA(1, 0, At, B0); MMA(1, 1, At, B1); BAR;
  }
  {
    LDB(B0, 1, 0); LDA(At, 1, 0); WAIT_V(2); BAR; WAIT_L(0); MMA(0, 0, At, B0); BAR;
    LDB(B1, 1, 1); WAIT_V(0); BAR; WAIT_L(0); MMA(0, 1, At, B1); BAR;
    LDA(At, 1, 1); BAR; WAIT_L(0); MMA(1, 0, At, B0); MMA(1, 1, At, B1); BAR;
  }
  if (wr == 0) BAR;
#undef SA
#undef SB
#undef STAGE
#undef LDA
#undef LDB
#undef MMA
}

__device__ __forceinline__ void acc_zero(Acc& acc) {
#pragma unroll
  for (int a = 0; a < 2; ++a)
#pragma unroll
    for (int b = 0; b < 2; ++b)
#pragma unroll
      for (int m = 0; m < 4; ++m)
#pragma unroll
        for (int n = 0; n < 2; ++n) acc[a][b][m][n] = f32x4{0.f, 0.f, 0.f, 0.f};
}

#define EPI_COORDS                                                                                           \
  const int wid = tid >> 6, lane = tid & 63, wr = wid >> 2, wc = wid & 3, fr = lane & 15, fq = lane >> 4; \
  (void)wid;
#define EPI_LOOP                                                                                             \
  _Pragma("unroll") for (int ai = 0; ai < 2; ++ai) _Pragma("unroll") for (int bj = 0; bj < 2; ++bj)            \
  _Pragma("unroll") for (int m = 0; m < 4; ++m) _Pragma("unroll") for (int n = 0; n < 2; ++n)
#define EPI_ROW (brow + ai * 128 + wr * 64 + m * 16 + fr)
#define EPI_COL (bj * 128 + wc * 32 + n * 16 + fq * 4)

__device__ __forceinline__ void epi_store_bf16(const Acc& acc, bf16* dst, int ldd, int brow, const int tid) {
  EPI_COORDS
  EPI_LOOP {
    const f32x4 v = acc[ai][bj][m][n];
    u32x2 o; o.x = pk2(v[0], v[1]); o.y = pk2(v[2], v[3]);
    *reinterpret_cast<u32x2*>(dst + (size_t)EPI_ROW * ldd + EPI_COL) = o;
  }
}

__device__ __forceinline__ void epi_store_bf16_perm(const Acc& acc, bf16* dst, int ldd, int brow, const int tid) {
  EPI_COORDS
#pragma unroll
  for (int ai = 0; ai < 2; ++ai)
#pragma unroll
    for (int bj = 0; bj < 2; ++bj)
#pragma unroll
      for (int m = 0; m < 4; ++m) {
        const f32x4 v0 = acc[ai][bj][m][0], v1 = acc[ai][bj][m][1];
        u32x4 o; o.x = pk2(v0[0], v0[1]); o.y = pk2(v0[2], v0[3]); o.z = pk2(v1[0], v1[1]); o.w = pk2(v1[2], v1[3]);
        *reinterpret_cast<u32x4*>(dst + (size_t)(brow + ai * 128 + wr * 64 + m * 16 + fr) * ldd + bj * 128 + wc * 32 + 8 * fq) = o;
      }
}

__device__ __forceinline__ int srcmap_win(int d) {
  if (d < 2048) return d;
  if (d < 3584) return d + 8;
  if (d < 5632) return d + 24;
  if (d < 5640) return d - 5632 + 2048;
  if (d < 5656) return d - 5640 + 3592;
  return -1;
}
__device__ __forceinline__ int srcmap_ffi(int d) {
  const int tile = d >> 8, c = d & 255;
  const int bj = c >> 7, wc = (c >> 5) & 3, n = (c >> 4) & 1, i = c & 15;
  const int h = tile * 128 + wc * 32 + (i >> 2) * 8 + bj * 4 + (i & 3);
  return n ? (DFF + h) : h;
}
__device__ __forceinline__ void transpose_item(const float* __restrict__ W, int K, int Nsrc, bf16* __restrict__ WT, int mode,
                                               int item, float* scr, int lane) {
  const int nkb = K / 64, db = item / nkb, kb = item % nkb, k0 = kb * 64, d0 = db * 32;
  const int d = d0 + (lane & 7) * 4;
  const int s = (mode == 0) ? d : (mode == 1 ? srcmap_win(d) : srcmap_ffi(d));
#pragma unroll
  for (int i = 0; i < 8; ++i) {
    const int kk = 8 * i + (lane >> 3);
    f32x4 v = {0.f, 0.f, 0.f, 0.f};
    if (s >= 0) v = *reinterpret_cast<const f32x4*>(W + (size_t)(k0 + kk) * Nsrc + s);
    float* sp = scr + kk * 33 + (lane & 7) * 4;
    sp[0] = v[0]; sp[1] = v[1]; sp[2] = v[2]; sp[3] = v[3];
  }
  __builtin_amdgcn_wave_barrier();
  const int c = lane & 7;
#pragma unroll
  for (int j = 0; j < 4; ++j) {
    const int n = (lane >> 3) + 8 * j;
    const float* sp = scr + (8 * c) * 33 + n;
    u32x4 o;
    o.x = pk2(sp[0 * 33], sp[1 * 33]); o.y = pk2(sp[2 * 33], sp[3 * 33]);
    o.z = pk2(sp[4 * 33], sp[5 * 33]); o.w = pk2(sp[6 * 33], sp[7 * 33]);
    *reinterpret_cast<u32x4*>(WT + (size_t)(d0 + n) * K + k0 + 8 * c) = o;
  }
  __builtin_amdgcn_wave_barrier();
}

__device__ __forceinline__ void phase_convert(const Params& p, int l, int parts, int first_wg) {
  const int tid = opaque_tid();
  const int wid = tid >> 6, lane = tid & 63;
  if ((int)blockIdx.x < first_wg) return;
  float* scr = (float*)(smem_raw + wid * 8704);
  const int gw = ((int)blockIdx.x - first_wg) * NWAVES + wid, NGW = ((int)gridDim.x - first_wg) * NWAVES;
  constexpr int I_IN = (DIN_PAD / 32) * 16, I_FI = (2 * DFF / 32) * 16, I_FO = 32 * (DFF / 64), I_A = 32 * 8, I_O = 32 * 16;
  constexpr int NITEMS = I_IN + I_FI + I_FO + 2 * I_A + I_O;
  unsigned char* ws = p.ws;
  for (int it = gw; it < NITEMS; it += NGW) {
    int r = it;
    {
      const int grp = (r < I_IN) ? 0 : ((r < I_IN + I_FI + I_FO) ? 2 : 1);
      if (!((parts >> grp) & 1)) continue;
    }
    if (r < I_IN) { transpose_item(p.in[6] + (size_t)l * 1024 * DIN_SRC, 1024, DIN_SRC, (bf16*)(ws + OFF_WIN), 1, r, scr, lane); continue; }
    r -= I_IN;
    if (r < I_FI) { transpose_item(p.in[21] + (size_t)l * 1024 * 2 * DFF, 1024, 2 * DFF, (bf16*)(ws + OFF_WFI), 2, r, scr, lane); continue; }
    r -= I_FI;
    if (r < I_FO) { transpose_item(p.in[22] + (size_t)l * DFF * 1024, DFF, 1024, (bf16*)(ws + OFF_WFO), 0, r, scr, lane); continue; }
    r -= I_FO;
    if (r < I_A) { transpose_item(p.in[14] + (size_t)l * 512 * 1024, 512, 1024, (bf16*)(ws + OFF_WA), 0, r, scr, lane); continue; }
    r -= I_A;
    if (r < I_A) { transpose_item(p.in[15] + (size_t)l * 512 * 1024, 512, 1024, (bf16*)(ws + OFF_WB), 0, r, scr, lane); continue; }
    r -= I_A;
    transpose_item(p.in[16] + (size_t)l * 1024 * 1024, 1024, 1024, (bf16*)(ws + OFF_WO), 0, r, scr, lane);
  }
  if (parts & 8) {
    bf16* Xb = (bf16*)(ws + OFF_XB);
    const size_t nvec = (size_t)MT * 128;
    for (size_t v = (size_t)blockIdx.x * NTHREADS + tid; v < nvec; v += (size_t)gridDim.x * NTHREADS) {
      const int row = (int)(v >> 7), c0 = (int)(v & 127) * 8;
      const float* src;
      if (row < MP) {
        const int b = row / LP, t = row - b * LP;
        src = (t < 16) ? (p.in[5] + (size_t)t * D + c0) : (p.in[0] + ((size_t)b * 2048 + (t - 16)) * D + c0);
      } else {
        src = p.in[1] + (size_t)(row - MP) * D + c0;
      }
      const f32x4 a = *reinterpret_cast<const f32x4*>(src), b4 = *reinterpret_cast<const f32x4*>(src + 4);
      u32x4 o; o.x = pk2(a[0], a[1]); o.y = pk2(a[2], a[3]); o.z = pk2(b4[0], b4[1]); o.w = pk2(b4[2], b4[3]);
      *reinterpret_cast<u32x4*>(Xb + (size_t)row * D + c0) = o;
    }
  }
}

using f32x16 = __attribute__((ext_vector_type(16))) float;
constexpr int TAIL_ROW0 = 64 * 256;
template <int MODE>
__device__ __forceinline__ void tail_gemm(const Params& p, const bf16* __restrict__ A, int lda, const bf16* __restrict__ Bt, int ldb, int K, int N,
                                          int br, const int tid_in) {
  int tid = tid_in;
  asm volatile("" : "+v"(tid));
  unsigned char* ws = p.ws;
  LAS float* part = (LAS float*)smem_raw;
  const int wid = tid >> 6, lane = tid & 63, r32 = lane & 31, hh = lane >> 5;
  const int ncb = N / 32, kw = K / 8, k0 = wid * kw;
  for (int st = blockIdx.x; st < 8 * ncb; st += gridDim.x) {
    const int rb = st / ncb, cbk = st - rb * ncb;
    const int row0 = TAIL_ROW0 + rb * 32, col0 = cbk * 32;
    const bf16* ap = A + (size_t)(row0 + r32) * lda + k0 + hh * 8;
    const bf16* bp = Bt + (size_t)(col0 + r32) * ldb + k0 + hh * 8;
    f32x16 acc;
#pragma unroll
    for (int i = 0; i < 16; ++i) acc[i] = 0.f;
#pragma unroll 8
    for (int ks = 0; ks < kw; ks += 16) {
      const bf16x8 a = *reinterpret_cast<const bf16x8*>(ap + ks);
      const bf16x8 b = *reinterpret_cast<const bf16x8*>(bp + ks);
      acc = __builtin_amdgcn_mfma_f32_32x32x16_bf16(b, a, acc, 0, 0, 0);
    }
    const size_t m = (size_t)(row0 + r32);
    const int n = col0 + ((2 * wid) & 3) + 8 * ((2 * wid) >> 2) + 4 * hh;
    u32 gpair = 0u, ppair = 0u;
    if (MODE == 1) {
      gpair = *reinterpret_cast<const u32*>(reinterpret_cast<const u16*>(ws + OFF_R4) + m * 2048 + br * 1024 + n);
      if (br) ppair = *reinterpret_cast<const u32*>(reinterpret_cast<const u16*>(ws + OFF_R3) + m * 1024 + n);
    } else if (MODE == 2) {
      gpair = *reinterpret_cast<const u32*>(reinterpret_cast<const u16*>(ws + OFF_XB) + m * 1024 + n);
    }
#pragma unroll
    for (int i = 0; i < 16; ++i) part[(wid * 16 + i) * 64 + lane] = acc[i];
    __syncthreads();
    float v0 = 0.f, v1 = 0.f;
#pragma unroll
    for (int w = 0; w < 8; ++w) { v0 += part[(w * 16 + 2 * wid) * 64 + lane]; v1 += part[(w * 16 + 2 * wid + 1) * 64 + lane]; }
    if (MODE == 0) {
      *reinterpret_cast<u32*>(reinterpret_cast<u16*>(ws + OFF_R4) + m * 2048 + n) = pk2(v0, v1);
    } else if (MODE == 1) {
      float o0 = v0 * sigmoidf_(bflo(gpair)), o1 = v1 * sigmoidf_(bfhi(gpair));
      if (br) { o0 += bflo(ppair); o1 += bfhi(ppair); }
      *reinterpret_cast<u32*>(reinterpret_cast<u16*>(ws + OFF_R3) + m * 1024 + n) = pk2(o0, o1);
    } else {
      *reinterpret_cast<u32*>(reinterpret_cast<u16*>(ws + OFF_R4) + m * 1024 + n) = pk2(v0 + ALPHA * bflo(gpair), v1 + ALPHA * bfhi(gpair));
    }
    __syncthreads();
  }
}

__device__ __forceinline__ void tile_xcd(int u, int nn, int& pm, int& pi) {
  if (u < 64 * nn) {
    const int x = u & 7, jj = u >> 3, half = jj / (4 * nn), rem = jj - half * 4 * nn;
    pi = ((rem >> 2) + (x * nn) / 8) % nn;
    pm = 8 * x + 4 * half + (rem & 3);
  }
  else { pm = 64; pi = u - 64 * nn; }
}

__device__ __forceinline__ void phase_gemm_in(const Params& p, bool gates) {
  const int tid = opaque_tid();
  unsigned char* ws = p.ws;
  const bf16* Xb = (const bf16*)(ws + OFF_XB);
  const bf16* Wt = (const bf16*)(ws + OFF_WIN);
  const int nmt = gates ? 64 : NMT;
  const int ntile = (gates ? 8 : 15) * nmt;
  for (int t = blockIdx.x; t < ntile; t += gridDim.x) {
    int pi, pm;
    tile_xcd(t, gates ? 8 : 15, pm, pi);
    const int pn = gates ? (14 + pi) : (pi < 14 ? pi : 22);
    const int brow = pm * 256, bcol = pn * 256;
    Acc acc; acc_zero(acc);
    gemm_kloop(acc, Xb, 1024, Wt, 1024, 1024, brow, bcol, tid, true);
    if (pn < 6) epi_store_bf16_perm(acc, (bf16*)(ws + OFF_R2) + pn * 256, 1536, brow, tid);
    else if (pn < 14) epi_store_bf16_perm(acc, (bf16*)(ws + OFF_R3) + (pn - 6) * 256, 2048, brow, tid);
    else if (pn < 22) epi_store_bf16_perm(acc, (bf16*)(ws + OFF_R4) + (pn - 14) * 256, 2048, brow, tid);
    else {
      float* sm = (float*)(ws + OFF_R5);
      EPI_COORDS
      EPI_LOOP {
        if (bj == 0 && wc == 0) *reinterpret_cast<f32x4*>(sm + (size_t)EPI_ROW * 32 + 8 * fq + 4 * n) = acc[ai][bj][m][n];
      }
    }
  }
  if (gates) {
    __syncthreads();
    tail_gemm<0>(p, Xb, 1024, Wt + (size_t)14 * 256 * 1024, 1024, 1024, 2048, 0, tid);
  }
}

__device__ __forceinline__ void gdn_job(const Params& p, int l, int b, int h, int half, float* lds, const int tid) {
  unsigned char* ws = p.ws;
  const bf16* QS = (const bf16*)(ws + OFF_QS);
  const float* SM = (const float*)(ws + OFF_R5);
  bf16* O = (bf16*)(ws + OFF_R2);
  const int lane = tid & 63, cg = lane & 15, kq = lane >> 4;
  const int col = half * 64 + cg * 4;
  f32x4 S[32];
  const float* s0 = p.in[2] + (((size_t)l * NS + b) * 4 + h) * 128 * 128 + (size_t)(kq * 32) * 128 + col;
#pragma unroll
  for (int i = 0; i < 32; ++i) S[i] = *reinterpret_cast<const f32x4*>(s0 + (size_t)i * 128);
  const float eA = __expf(p.in[8][l * 4 + h]), dtb = p.in[9][l * 4 + h];
  float* lk = lds;
  float* lq = lds + 128;
  const size_t row = (size_t)MP + b;
  const u32 q2 = *reinterpret_cast<const u32*>(QS + (size_t)b * 1536 + h * 128 + lane * 2);
  const u32 k2 = *reinterpret_cast<const u32*>(QS + (size_t)b * 1536 + 512 + h * 128 + lane * 2);
  const u32x2 v2 = *reinterpret_cast<const u32x2*>(QS + (size_t)b * 1536 + 1024 + h * 128 + col);
  const f32x4 v = {bflo(v2.x), bfhi(v2.x), bflo(v2.y), bfhi(v2.y)};
  const float beta = sigmoidf_(SM[row * 32 + h]);
  const float g = -eA * softplusf_(SM[row * 32 + 4 + h] + dtb);
  const float eg = __expf(g);
  __builtin_amdgcn_wave_barrier();
  lq[lane * 2] = bflo(q2); lq[lane * 2 + 1] = bfhi(q2);
  lk[lane * 2] = bflo(k2); lk[lane * 2 + 1] = bfhi(k2);
  __builtin_amdgcn_wave_barrier();
  const float* lkq = lk + kq * 32;
  const float* lqq = lq + kq * 32;
  f32x4 ks = {0.f, 0.f, 0.f, 0.f};
#pragma unroll
  for (int i = 0; i < 32; i += 4) {
    const f32x4 kk = *reinterpret_cast<const f32x4*>(lkq + i);
    ks += S[i] * kk[0] + S[i + 1] * kk[1] + S[i + 2] * kk[2] + S[i + 3] * kk[3];
  }
#pragma unroll
  for (int c = 0; c < 4; ++c) { ks[c] += __shfl_xor(ks[c], 16); ks[c] += __shfl_xor(ks[c], 32); }
  const f32x4 u = (v - ks * eg) * beta;
  f32x4 o = {0.f, 0.f, 0.f, 0.f};
  float* so = p.out + OUT_GDNS + (((size_t)l * NS + b) * 4 + h) * 128 * 128 + (size_t)(kq * 32) * 128 + col;
#pragma unroll
  for (int i = 0; i < 32; i += 4) {
    const f32x4 kk = *reinterpret_cast<const f32x4*>(lkq + i);
    const f32x4 qq = *reinterpret_cast<const f32x4*>(lqq + i);
#pragma unroll
    for (int e = 0; e < 4; ++e) {
      const f32x4 sn = S[i + e] * eg + u * kk[e];
      o += sn * qq[e];
      *reinterpret_cast<f32x4*>(so + (size_t)(i + e) * 128) = sn;
    }
  }
#pragma unroll
  for (int c = 0; c < 4; ++c) { o[c] += __shfl_xor(o[c], 16); o[c] += __shfl_xor(o[c], 32); }
  if (kq == 0) {
    u32x2 ov; ov.x = pk2(o[0], o[1]); ov.y = pk2(o[2], o[3]);
    *reinterpret_cast<u32x2*>(O + row * 1024 + h * 128 + col) = ov;
  }
  __builtin_amdgcn_wave_barrier();
}

__device__ __forceinline__ void gla_job(const Params& p, int l, int b, int h, int half, bool smp, float* lds, const int tid) {
  unsigned char* ws = p.ws;
  const bf16* P2 = (const bf16*)(ws + OFF_R3);
  const float* SM = (const float*)(ws + OFF_R5);
  bf16* O = (bf16*)(ws + OFF_R2);
  const int lane = tid & 63, col = half * 64 + lane;
  float S[64];
  if (smp) {
    const float* s0 = p.in[3] + (((size_t)l * NS + b) * 4 + h) * 64 * 128 + col;
#pragma unroll
    for (int i = 0; i < 64; ++i) S[i] = s0[(size_t)i * 128];
  } else {
#pragma unroll
    for (int i = 0; i < 64; ++i) S[i] = 0.f;
  }
  float w2[16];
#pragma unroll
  for (int r = 0; r < 16; ++r) w2[r] = p.in[11][((size_t)l * 16 + r) * 256 + h * 64 + lane];
  const float gb = p.in[12][l * 256 + h * 64 + lane];
  const int T = smp ? 1 : LP, row0 = smp ? (MP + b) : b * LP;
  float* le = lds;
  float* lk = lds + 64;
  float* lq = lds + 128;
  for (int t = 0; t < T; ++t) {
    const size_t row = (size_t)(row0 + t);
    const float q = bf1(*reinterpret_cast<const u16*>(P2 + row * 2048 + 512 + h * 64 + lane)) * 0.125f;
    const float k = bf1(*reinterpret_cast<const u16*>(P2 + row * 2048 + 768 + h * 64 + lane));
    const float v = bf1(*reinterpret_cast<const u16*>(P2 + row * 2048 + 1024 + h * 128 + col));
    float x = gb;
#pragma unroll
    for (int r = 0; r < 16; ++r) x += SM[row * 32 + 8 + r] * w2[r];
    const float lg = -softplusf_(-x) * (1.f / 16.f);
    __builtin_amdgcn_wave_barrier();
    le[lane] = __expf(lg); lk[lane] = k; lq[lane] = q;
    __builtin_amdgcn_wave_barrier();
    float o = 0.f;
#pragma unroll
    for (int i = 0; i < 64; i += 4) {
      const f32x4 ee = *reinterpret_cast<const f32x4*>(le + i);
      const f32x4 kk = *reinterpret_cast<const f32x4*>(lk + i);
      const f32x4 qq = *reinterpret_cast<const f32x4*>(lq + i);
      S[i] = ee[0] * S[i] + kk[0] * v; S[i + 1] = ee[1] * S[i + 1] + kk[1] * v;
      S[i + 2] = ee[2] * S[i + 2] + kk[2] * v; S[i + 3] = ee[3] * S[i + 3] + kk[3] * v;
      o += S[i] * qq[0] + S[i + 1] * qq[1] + S[i + 2] * qq[2] + S[i + 3] * qq[3];
    }
    O[row * 1024 + 512 + h * 128 + col] = __float2bfloat16(o);
  }
  float* so = smp ? (p.out + OUT_GLAS + (((size_t)l * NS + b) * 4 + h) * 64 * 128 + col)
                  : (p.out + OUT_GLAP + (((size_t)l * NBATCH + b) * 4 + h) * 64 * 128 + col);
#pragma unroll
  for (int i = 0; i < 64; ++i) so[(size_t)i * 128] = S[i];
}

constexpr int NCH = 33;
constexpr int GDN_IMG = 73728, GLA_IMG = 25088;
constexpr size_t OFF_GDN_IMG = OFF_R4;
constexpr size_t OFF_GLA_IMG = OFF_R4 + (size_t)NBATCH * 4 * NCH * GDN_IMG;
constexpr size_t R4_IMG_END = OFF_GLA_IMG + (size_t)NBATCH * 4 * NCH * GLA_IMG;
static_assert(R4_IMG_END <= OFF_R5, "R4 too small for the images");

__device__ __forceinline__ bf16x8 lds_frag16(const LAS unsigned char* base) { return *reinterpret_cast<const LAS bf16x8*>(base); }
__device__ __forceinline__ bf16x8 mk_frag(u32 a, u32 b, u32 c, u32 d) {
  u32x4 v; v.x = a; v.y = b; v.z = c; v.w = d;
  return __builtin_bit_cast(bf16x8, v);
}
__device__ __forceinline__ bf16x8 frag_from_tiles(const f32x4 t0, const f32x4 t1) {
  return mk_frag(pk2(t0[0], t0[1]), pk2(t0[2], t0[3]), pk2(t1[0], t1[1]), pk2(t1[2], t1[3]));
}
#define MFMA16(a, b, c) __builtin_amdgcn_mfma_f32_16x16x32_bf16(a, b, c, 0, 0, 0)

__device__ __forceinline__ void conv8(const bf16* __restrict__ P1, const float* __restrict__ cw, size_t row, int t, int c0, bool valid,
                                      float* o, float* x3) {
#pragma unroll
  for (int e = 0; e < 8; ++e) o[e] = 0.f;
#pragma unroll
  for (int i = 0; i < 4; ++i) {
    float x[8];
    if (valid && (t - 3 + i >= 0)) unpack8(*reinterpret_cast<const u32x4*>(P1 + (row - 3 + i) * 1536 + c0), x);
    else {
#pragma unroll
      for (int e = 0; e < 8; ++e) x[e] = 0.f;
    }
    const f32x4 wa = *reinterpret_cast<const f32x4*>(cw + i * 1536 + c0), wb = *reinterpret_cast<const f32x4*>(cw + i * 1536 + c0 + 4);
    o[0] += wa[0] * x[0]; o[1] += wa[1] * x[1]; o[2] += wa[2] * x[2]; o[3] += wa[3] * x[3];
    o[4] += wb[0] * x[4]; o[5] += wb[1] * x[5]; o[6] += wb[2] * x[6]; o[7] += wb[3] * x[7];
    if (i == 3) {
#pragma unroll
      for (int e = 0; e < 8; ++e) x3[e] = x[e];
    }
  }
#pragma unroll
  for (int e = 0; e < 8; ++e) o[e] = o[e] * sigmoidf_(o[e]);
}

constexpr int LQ = 0, LK = 17408, LKT = 34816, LVT = 53248, LAM = 71680, LTW = 89088, LTU = 98304, LGM = 107520, LBT = 107776, LCW = 108032;
constexpr int QSTR = 272, TSTR = 144, ASTR = 68;

__device__ __forceinline__ void gdn_pre_item(const Params& p, int l, int b, int h, int c, const int tid_in) {
  int tid = tid_in;
  asm volatile("" : "+v"(tid));
  unsigned char* ws = p.ws;
  LAS unsigned char* lds = (LAS unsigned char*)smem_raw;
  asm volatile("" : "+v"(lds));
  const bf16* P1 = (const bf16*)(ws + OFF_R2);
  const float* SM = (const float*)(ws + OFF_R5);
  const float* cw = p.in[7] + (size_t)l * 4 * 1536;
  unsigned char* img = ws + OFF_GDN_IMG + (size_t)((b * 4 + h) * NCH + c) * GDN_IMG;
  const int wid = tid >> 6, lane = tid & 63, r = lane & 15, q = lane >> 4;
  const int tb = (c == 0) ? 0 : 16 + 64 * (c - 1), nvalid = (c == 0) ? 16 : 64;
  const size_t row0 = (size_t)b * LP + tb;
  float sm_a = 0.f, sm_b = 0.f;
  {
    const int j = tid >> 3, sub = tid & 7;
    const bool valid = j < nvalid;
    const int t = tb + j;
    const size_t row = row0 + j;
    LAS float* lcw = reinterpret_cast<LAS float*>(lds + LCW);
    float cwv[3];
#pragma unroll
    for (int u = 0; u < 3; ++u) {
      const int i = tid + u * NTHREADS, tap = i / 384, cc = i - tap * 384;
      cwv[u] = cw[tap * 1536 + (cc >> 7) * 512 + h * 128 + (cc & 127)];
    }
    if (wid == 0 && lane < nvalid) {
      sm_a = SM[(row0 + lane) * 32 + 4 + h];
      sm_b = SM[(row0 + lane) * 32 + h];
    }
    u32x4 raw[3][4][2];
#pragma unroll
    for (int mat = 0; mat < 3; ++mat)
#pragma unroll
      for (int i = 0; i < 4; ++i)
#pragma unroll
        for (int hf = 0; hf < 2; ++hf) {
          if (valid && (t - 3 + i >= 0)) raw[mat][i][hf] = *reinterpret_cast<const u32x4*>(P1 + (row - 3 + i) * 1536 + mat * 512 + h * 128 + sub * 16 + hf * 8);
          else raw[mat][i][hf] = u32x4{0u, 0u, 0u, 0u};
        }
#pragma unroll
    for (int u = 0; u < 3; ++u) lcw[tid + u * NTHREADS] = cwv[u];
    __syncthreads();
#pragma unroll
    for (int mat = 0; mat < 3; ++mat) {
      float o[16];
#pragma unroll
      for (int e = 0; e < 16; ++e) o[e] = 0.f;
#pragma unroll
      for (int i = 0; i < 4; ++i)
#pragma unroll
        for (int hf = 0; hf < 2; ++hf) {
          float x[8];
          unpack8(raw[mat][i][hf], x);
          const f32x4 wa = *reinterpret_cast<const LAS f32x4*>(lcw + i * 384 + mat * 128 + sub * 16 + hf * 8);
          const f32x4 wb = *reinterpret_cast<const LAS f32x4*>(lcw + i * 384 + mat * 128 + sub * 16 + hf * 8 + 4);
          float* oo = o + hf * 8;
          oo[0] += wa[0] * x[0]; oo[1] += wa[1] * x[1]; oo[2] += wa[2] * x[2]; oo[3] += wa[3] * x[3];
          oo[4] += wb[0] * x[4]; oo[5] += wb[1] * x[5]; oo[6] += wb[2] * x[6]; oo[7] += wb[3] * x[7];
        }
#pragma unroll
      for (int e = 0; e < 16; ++e) o[e] = o[e] * sigmoidf_(o[e]);
      if (mat < 2) {
        float ss = 0.f;
#pragma unroll
        for (int e = 0; e < 16; ++e) ss += o[e] * o[e];
        ss = sum8(ss);
        const float sc = rsqrtf(ss + 1e-6f) * (mat == 0 ? 0.08838834764831845f : 1.f);
#pragma unroll
        for (int e = 0; e < 16; ++e) o[e] *= sc;
      }
      if (mat < 2) {
        LAS unsigned char* ldst = lds + (mat == 0 ? LQ : LK) + j * QSTR + sub * 32;
        *reinterpret_cast<LAS u32x4*>(ldst) = pack8(o);
        *reinterpret_cast<LAS u32x4*>(ldst + 16) = pack8(o + 8);
      }
      if (mat >= 1) {
        LAS unsigned char* ldst = lds + (mat == 1 ? LKT : LVT) + (sub * 16) * TSTR + (j ^ (sub << 3)) * 2;
#pragma unroll
        for (int e = 0; e < 16; ++e) *reinterpret_cast<LAS u16*>(ldst + e * TSTR) = f2bf(o[e]);
      }
      if (c == NCH - 1 && j >= 61) {
        float* dst = p.out + OUT_CONVP + (((size_t)l * NBATCH + b) * 3 + (j - 61)) * 1536 + mat * 512 + h * 128 + sub * 16;
#pragma unroll
        for (int hf = 0; hf < 2; ++hf) {
          float x3[8];
          unpack8(raw[mat][3][hf], x3);
          *reinterpret_cast<f32x4*>(dst + hf * 8) = f32x4{x3[0], x3[1], x3[2], x3[3]};
          *reinterpret_cast<f32x4*>(dst + hf * 8 + 4) = f32x4{x3[4], x3[5], x3[6], x3[7]};
        }
      }
    }
  }
  if (wid == 0) {
    const bool valid = lane < nvalid;
    float g = 0.f, be = 0.f;
    if (valid) {
      const float eA = __expf(p.in[8][l * 4 + h]), dtb = p.in[9][l * 4 + h];
      g = -eA * softplusf_(sm_a + dtb);
      be = sigmoidf_(sm_b);
    }
#pragma unroll
    for (int o = 1; o < 64; o <<= 1) {
      const float y = __shfl_up(g, o);
      if (lane >= o) g += y;
    }
    reinterpret_cast<LAS float*>(lds + LGM)[lane] = g;
    reinterpret_cast<LAS float*>(lds + LBT)[lane] = be;
  }
  __syncthreads();
  const LAS float* gam = reinterpret_cast<const LAS float*>(lds + LGM);
  const LAS float* bet = reinterpret_cast<const LAS float*>(lds + LBT);
  {
#pragma unroll
    for (int u = 0; u < 2; ++u) {
      const int id = wid * 2 + u, it = id >> 2, jt = id & 3;
      f32x4 d = {0.f, 0.f, 0.f, 0.f};
#pragma unroll
      for (int ks = 0; ks < 4; ++ks) {
        const bf16x8 a = lds_frag16(lds + LK + (16 * it + r) * QSTR + (32 * ks + 8 * q) * 2);
        const bf16x8 bb = lds_frag16(lds + LK + (16 * jt + r) * QSTR + (32 * ks + 8 * q) * 2);
        d = MFMA16(a, bb, d);
      }
      const int jj = 16 * jt + r;
      const float gj = gam[jj];
#pragma unroll
      for (int e = 0; e < 4; ++e) {
        const int ii = 16 * it + 4 * q + e;
        const float v = (jj < ii) ? bet[ii] * __expf(fminf(gam[ii] - gj, 0.f)) * d[e] : 0.f;
        reinterpret_cast<LAS float*>(lds + LAM)[ii * ASTR + jj] = v;
      }
    }
    const int it = wid & 3, s = wid >> 2;
    f32x4 d2[2];
#pragma unroll
    for (int u = 0; u < 2; ++u) {
      const int jt = 2 * s + u;
      f32x4 d = {0.f, 0.f, 0.f, 0.f};
#pragma unroll
      for (int ks = 0; ks < 4; ++ks) {
        const bf16x8 a = lds_frag16(lds + LK + (16 * jt + r) * QSTR + (32 * ks + 8 * q) * 2);
        const bf16x8 bb = lds_frag16(lds + LQ + (16 * it + r) * QSTR + (32 * ks + 8 * q) * 2);
        d = MFMA16(a, bb, d);
      }
      const int ii = 16 * it + r;
      const float gi = gam[ii];
#pragma unroll
      for (int e = 0; e < 4; ++e) {
        const int jj = 16 * jt + 4 * q + e;
        d[e] = (jj <= ii) ? __expf(fminf(gi - gam[jj], 0.f)) * d[e] : 0.f;
      }
      d2[u] = d;
    }
    *reinterpret_cast<bf16x8*>(img + 32768 + (it * 2 + s) * 1024 + lane * 16) = frag_from_tiles(d2[0], d2[1]);
  }
  __syncthreads();
  if (wid == 0) {
    const LAS float* A = reinterpret_cast<const LAS float*>(lds + LAM);
    LAS unsigned char* PT = lds + LCW;
    LAS unsigned char* QR = lds + LCW + 2560;
    const int blk = lane >> 5, cc = lane & 31;
    float T[32];
    {
      const LAS float* Ab = A + (32 * blk) * ASTR + 32 * blk;
#pragma unroll
      for (int i = 0; i < 32; ++i) {
        float a0 = (i == cc) ? 1.f : 0.f, a1 = 0.f, a2 = 0.f, a3 = 0.f;
#pragma unroll
        for (int j4 = 0; j4 + 4 <= i; j4 += 4) {
          const f32x4 av = *reinterpret_cast<const LAS f32x4*>(Ab + i * ASTR + j4);
          a0 -= av[0] * T[j4]; a1 -= av[1] * T[j4 + 1]; a2 -= av[2] * T[j4 + 2]; a3 -= av[3] * T[j4 + 3];
        }
#pragma unroll
        for (int j = (i & ~3); j < i; ++j) a0 -= Ab[i * ASTR + j] * T[j];
        T[i] = (a0 + a1) + (a2 + a3);
        if ((i & 3) == 3) __builtin_amdgcn_sched_barrier(0);
      }
    }
    const float bj = bet[lane], bw = bj * __expf(gam[lane]);
    if (blk == 0) {
#pragma unroll
      for (int i8 = 0; i8 < 4; ++i8) *reinterpret_cast<LAS u32x4*>(PT + cc * 80 + i8 * 16) = pack8(T + 8 * i8);
    } else {
#pragma unroll
      for (int i = 0; i < 32; ++i) *reinterpret_cast<LAS u16*>(QR + i * 80 + cc * 2) = f2bf(T[i]);
    }
#pragma unroll
    for (int i = 0; i < 32; ++i) {
      *reinterpret_cast<LAS u16*>(lds + LTW + (32 * blk + i) * TSTR + lane * 2) = f2bf(T[i] * bw);
      *reinterpret_cast<LAS u16*>(lds + LTU + (32 * blk + i) * TSTR + lane * 2) = f2bf(T[i] * bj);
      if (blk == 1) {
        *reinterpret_cast<LAS u16*>(lds + LTW + i * TSTR + lane * 2) = (u16)0;
        *reinterpret_cast<LAS u16*>(lds + LTU + i * TSTR + lane * 2) = (u16)0;
      }
      if ((i & 7) == 7) __builtin_amdgcn_sched_barrier(0);
    }
    f32x4 M1[2][2];
#pragma unroll
    for (int it = 0; it < 2; ++it) {
      const LAS float* ar = A + (32 + 16 * it + r) * ASTR + 8 * q;
      const f32x4 x0 = *reinterpret_cast<const LAS f32x4*>(ar), x1 = *reinterpret_cast<const LAS f32x4*>(ar + 4);
      const bf16x8 af = mk_frag(pk2(x0[0], x0[1]), pk2(x0[2], x0[3]), pk2(x1[0], x1[1]), pk2(x1[2], x1[3]));
#pragma unroll
      for (int nt = 0; nt < 2; ++nt) {
        const bf16x8 bfq = lds_frag16(PT + (16 * nt + r) * 80 + q * 16);
        M1[it][nt] = MFMA16(af, bfq, (f32x4{0.f, 0.f, 0.f, 0.f}));
      }
    }
#pragma unroll
    for (int nt = 0; nt < 2; ++nt) {
      const bf16x8 mf = frag_from_tiles(M1[0][nt], M1[1][nt]);
      const int n = 16 * nt + r;
      const float bn = bet[n], bwn = bn * __expf(gam[n]);
#pragma unroll
      for (int it = 0; it < 2; ++it) {
        const u32x2 lo = *reinterpret_cast<const LAS u32x2*>(QR + (16 * it + r) * 80 + (4 * q) * 2);
        const u32x2 hi = *reinterpret_cast<const LAS u32x2*>(QR + (16 * it + r) * 80 + (16 + 4 * q) * 2);
        const f32x4 rr = MFMA16(mk_frag(lo.x, lo.y, hi.x, hi.y), mf, (f32x4{0.f, 0.f, 0.f, 0.f}));
#pragma unroll
        for (int e = 0; e < 4; ++e) {
          const int i = 32 + 16 * it + 4 * q + e;
          *reinterpret_cast<LAS u16*>(lds + LTW + i * TSTR + n * 2) = f2bf(-rr[e] * bwn);
          *reinterpret_cast<LAS u16*>(lds + LTU + i * TSTR + n * 2) = f2bf(-rr[e] * bn);
        }
      }
    }
    if (lane == 0) reinterpret_cast<float*>(ws + OFF_GT)[(b * 4 + h) * NCH + c] = __expf(gam[63]);
  } else {
    for (int f = wid - 1; f < 32; f += 7) {
      if (f < 16) {
        const int it = f >> 2, ks = f & 3, ii = 16 * it + r;
        const float sc = __expf(gam[ii]);
        const u32x2 lo = *reinterpret_cast<const LAS u32x2*>(lds + LQ + ii * QSTR + (32 * ks + 4 * q) * 2);
        const u32x2 hi = *reinterpret_cast<const LAS u32x2*>(lds + LQ + ii * QSTR + (32 * ks + 16 + 4 * q) * 2);
        const bf16x8 o = mk_frag(pk2(bflo(lo.x) * sc, bfhi(lo.x) * sc), pk2(bflo(lo.y) * sc, bfhi(lo.y) * sc),
                                 pk2(bflo(hi.x) * sc, bfhi(hi.x) * sc), pk2(bflo(hi.y) * sc, bfhi(hi.y) * sc));
        *reinterpret_cast<bf16x8*>(img + 16384 + f * 1024 + lane * 16) = o;
      } else {
        const int g2 = f - 16, kt = g2 >> 1, s = g2 & 1, kk = 16 * kt + r;
        const float gl = gam[63];
        const u32x2 lo = *reinterpret_cast<const LAS u32x2*>(lds + LKT + kk * TSTR + ((32 * s + 4 * q) ^ ((kt & 7) << 3)) * 2);
        const u32x2 hi = *reinterpret_cast<const LAS u32x2*>(lds + LKT + kk * TSTR + ((32 * s + 16 + 4 * q) ^ ((kt & 7) << 3)) * 2);
        const f32x4 g0 = *reinterpret_cast<const LAS f32x4*>(gam + 32 * s + 4 * q);
        const f32x4 g1 = *reinterpret_cast<const LAS f32x4*>(gam + 32 * s + 16 + 4 * q);
        const bf16x8 o = mk_frag(pk2(bflo(lo.x) * __expf(gl - g0[0]), bfhi(lo.x) * __expf(gl - g0[1])),
                                 pk2(bflo(lo.y) * __expf(gl - g0[2]), bfhi(lo.y) * __expf(gl - g0[3])),
                                 pk2(bflo(hi.x) * __expf(gl - g1[0]), bfhi(hi.x) * __expf(gl - g1[1])),
                                 pk2(bflo(hi.y) * __expf(gl - g1[2]), bfhi(hi.y) * __expf(gl - g1[3])));
        *reinterpret_cast<bf16x8*>(img + 40960 + g2 * 1024 + lane * 16) = o;
      }
    }
  }
  __syncthreads();
  {
    const int it = wid & 3;
#pragma unroll
    for (int u = 0; u < 2; ++u) {
      const int ks = (wid >> 2) + 2 * u;
      f32x4 d2[2];
#pragma unroll
      for (int v = 0; v < 2; ++v) {
        const int kt = 2 * ks + v;
        f32x4 d = {0.f, 0.f, 0.f, 0.f};
#pragma unroll
        for (int s = 0; s < 2; ++s) {
          const bf16x8 a = lds_frag16(lds + LKT + (16 * kt + r) * TSTR + ((32 * s + 8 * q) ^ ((kt & 7) << 3)) * 2);
          const bf16x8 bb = lds_frag16(lds + LTW + (16 * it + r) * TSTR + (32 * s + 8 * q) * 2);
          d = MFMA16(a, bb, d);
        }
        d2[v] = -d;
      }
      *reinterpret_cast<bf16x8*>(img + (it * 4 + ks) * 1024 + lane * 16) = frag_from_tiles(d2[0], d2[1]);
    }
    const int nt = wid;
#pragma unroll
    for (int it2 = 0; it2 < 4; ++it2) {
      f32x4 d = {0.f, 0.f, 0.f, 0.f};
#pragma unroll
      for (int s = 0; s < 2; ++s) {
        const bf16x8 a = lds_frag16(lds + LTU + (16 * it2 + r) * TSTR + (32 * s + 8 * q) * 2);
        const bf16x8 bb = lds_frag16(lds + LVT + (16 * nt + r) * TSTR + ((32 * s + 8 * q) ^ ((nt & 7) << 3)) * 2);
        d = MFMA16(a, bb, d);
      }
      u32x2 o; o.x = pk2(d[0], d[1]); o.y = pk2(d[2], d[3]);
      *reinterpret_cast<u32x2*>(img + 57344 + ((nt * 4 + it2) * 64 + lane) * 8) = o;
    }
  }
  __syncthreads();
}

constexpr int GQ = 0, GK = 9216, GKR = 18432, GCB = 27648, GW2 = 45056;
__device__ __forceinline__ void gla_pre_item(const Params& p, int l, int b, int h, int c, const int tid_in) {
  int tid = tid_in;
  asm volatile("" : "+v"(tid));
  unsigned char* ws = p.ws;
  LAS unsigned char* lds = (LAS unsigned char*)smem_raw;
  asm volatile("" : "+v"(lds));
  const bf16* P2 = (const bf16*)(ws + OFF_R3);
  const float* SM = (const float*)(ws + OFF_R5);
  unsigned char* img = ws + OFF_GLA_IMG + (size_t)((b * 4 + h) * NCH + c) * GLA_IMG;
  const int wid = tid >> 6, lane = tid & 63, r = lane & 15, q = lane >> 4;
  const int tb = (c == 0) ? 0 : 16 + 64 * (c - 1), nvalid = (c == 0) ? 16 : 64;
  const size_t row0 = (size_t)b * LP + tb;
  LAS float* cb = reinterpret_cast<LAS float*>(lds + GCB);
  LAS float* w2s = reinterpret_cast<LAS float*>(lds + GW2);
  LAS float* wtot = w2s + 1024;
  const int j = tid >> 3, sub = tid & 7;
  const bool valid = j < nvalid;
  f32x4 glr[4];
  {
    const float w2a = p.in[11][((size_t)l * 16 + (tid >> 6)) * 256 + h * 64 + (tid & 63)];
    const float w2b = p.in[11][((size_t)l * 16 + ((tid + NTHREADS) >> 6)) * 256 + h * 64 + (tid & 63)];
    const float* smr = SM + (row0 + (valid ? j : 0)) * 32 + 8;
#pragma unroll
    for (int u = 0; u < 4; ++u) glr[u] = *reinterpret_cast<const f32x4*>(smr + 4 * u);
    w2s[tid] = w2a; w2s[tid + NTHREADS] = w2b;
  }
  __syncthreads();
  float qv[8], kv[8], cbv[8];
  {
    float x[8];
#pragma unroll
    for (int e = 0; e < 8; ++e) x[e] = p.in[12][l * 256 + h * 64 + sub * 8 + e];
    if (valid) {
#pragma unroll
      for (int rr = 0; rr < 16; ++rr) {
        const float gl = glr[rr >> 2][rr & 3];
        const f32x4 wa = *reinterpret_cast<const LAS f32x4*>(w2s + rr * 64 + sub * 8), wb = *reinterpret_cast<const LAS f32x4*>(w2s + rr * 64 + sub * 8 + 4);
        x[0] += gl * wa[0]; x[1] += gl * wa[1]; x[2] += gl * wa[2]; x[3] += gl * wa[3];
        x[4] += gl * wb[0]; x[5] += gl * wb[1]; x[6] += gl * wb[2]; x[7] += gl * wb[3];
      }
    }
#pragma unroll
    for (int e = 0; e < 8; ++e) cbv[e] = valid ? -softplusf_(-x[e]) * (1.f / 16.f) : 0.f;
    if (valid) {
      unpack8(*reinterpret_cast<const u32x4*>(P2 + (row0 + j) * 2048 + 512 + h * 64 + sub * 8), qv);
      unpack8(*reinterpret_cast<const u32x4*>(P2 + (row0 + j) * 2048 + 768 + h * 64 + sub * 8), kv);
    } else {
#pragma unroll
      for (int e = 0; e < 8; ++e) { qv[e] = 0.f; kv[e] = 0.f; }
    }
    *reinterpret_cast<LAS u32x4*>(lds + GKR + j * TSTR + sub * 16) = pack8(kv);
#pragma unroll
    for (int o = 8; o < 64; o <<= 1) {
#pragma unroll
      for (int e = 0; e < 8; ++e) {
        const float y = __shfl_up(cbv[e], o);
        if (lane >= o) cbv[e] += y;
      }
    }
    if (lane >= 56) {
#pragma unroll
      for (int e = 0; e < 8; ++e) wtot[wid * 64 + sub * 8 + e] = cbv[e];
    }
  }
  __syncthreads();
  {
    float tot[8];
#pragma unroll
    for (int e = 0; e < 8; ++e) tot[e] = 0.f;
#pragma unroll
    for (int w = 0; w < 8; ++w) {
      const f32x4 ta = *reinterpret_cast<const LAS f32x4*>(wtot + w * 64 + sub * 8), tb4 = *reinterpret_cast<const LAS f32x4*>(wtot + w * 64 + sub * 8 + 4);
      if (w < wid) {
        cbv[0] += ta[0]; cbv[1] += ta[1]; cbv[2] += ta[2]; cbv[3] += ta[3];
        cbv[4] += tb4[0]; cbv[5] += tb4[1]; cbv[6] += tb4[2]; cbv[7] += tb4[3];
      }
      tot[0] += ta[0]; tot[1] += ta[1]; tot[2] += ta[2]; tot[3] += ta[3];
      tot[4] += tb4[0]; tot[5] += tb4[1]; tot[6] += tb4[2]; tot[7] += tb4[3];
    }
#pragma unroll
    for (int e = 0; e < 8; ++e) cb[j * ASTR + sub * 8 + e] = cbv[e];
    if (j == 63) {
#pragma unroll
      for (int e = 0; e < 8; ++e) reinterpret_cast<float*>(img + 24576)[sub * 8 + e] = __expf(tot[e]);
    }
    float qo[8], ko[8];
#pragma unroll
    for (int e = 0; e < 8; ++e) {
      const float cv = cbv[e];
      qo[e] = qv[e] * 0.125f * __expf(cv);
      ko[e] = kv[e] * __expf(-cv);
    }
    *reinterpret_cast<LAS u32x4*>(lds + GQ + j * TSTR + sub * 16) = pack8(qo);
    *reinterpret_cast<LAS u32x4*>(lds + GK + j * TSTR + sub * 16) = pack8(ko);
  }
  __syncthreads();
  {
    {
      const int it = wid >> 1, ks = wid & 1, ii = 16 * it + r;
      const u32x2 lo = *reinterpret_cast<const LAS u32x2*>(lds + GQ + ii * TSTR + (32 * ks + 4 * q) * 2);
      const u32x2 hi = *reinterpret_cast<const LAS u32x2*>(lds + GQ + ii * TSTR + (32 * ks + 16 + 4 * q) * 2);
      *reinterpret_cast<bf16x8*>(img + wid * 1024 + lane * 16) = mk_frag(lo.x, lo.y, hi.x, hi.y);
    }
    {
      const int kt = wid >> 1, s = wid & 1, dk = 16 * kt + r;
      const float cl = cb[63 * ASTR + dk];
      float o[8];
#pragma unroll
      for (int e = 0; e < 8; ++e) {
        const int jj = 32 * s + (e < 4 ? 4 * q + e : 16 + 4 * q + (e - 4));
        const float kr = bf1(*reinterpret_cast<const LAS u16*>(lds + GKR + jj * TSTR + dk * 2));
        o[e] = kr * __expf(cl - cb[jj * ASTR + dk]);
      }
      *reinterpret_cast<bf16x8*>(img + 16384 + wid * 1024 + lane * 16) = mk_frag(pk2(o[0], o[1]), pk2(o[2], o[3]), pk2(o[4], o[5]), pk2(o[6], o[7]));
    }
    {
      const int it = wid & 3, s = wid >> 2;
      f32x4 d2[2];
#pragma unroll
      for (int u = 0; u < 2; ++u) {
        const int jt = 2 * s + u;
        f32x4 d = {0.f, 0.f, 0.f, 0.f};
#pragma unroll
        for (int ks = 0; ks < 2; ++ks) {
          const bf16x8 a = lds_frag16(lds + GK + (16 * jt + r) * TSTR + (32 * ks + 8 * q) * 2);
          const bf16x8 bb = lds_frag16(lds + GQ + (16 * it + r) * TSTR + (32 * ks + 8 * q) * 2);
          d = MFMA16(a, bb, d);
        }
        const int ii = 16 * it + r;
#pragma unroll
        for (int e = 0; e < 4; ++e) {
          const int jj = 16 * jt + 4 * q + e;
          d[e] = (jj <= ii) ? d[e] : 0.f;
        }
        d2[u] = d;
      }
      *reinterpret_cast<bf16x8*>(img + 8192 + (it * 2 + s) * 1024 + lane * 16) = frag_from_tiles(d2[0], d2[1]);
    }
  }
  __syncthreads();
}

__device__ __forceinline__ void sample_conv(const Params& p, int l, const int tid) {
  unsigned char* ws = p.ws;
  const bf16* P1 = (const bf16*)(ws + OFF_R2);
  bf16* QS = (bf16*)(ws + OFF_QS);
  const float* cw = p.in[7] + (size_t)l * 4 * 1536;
  const int wid = tid >> 6, lane = tid & 63;
  const int wg0 = (gridDim.x == 256) ? 128 : 0;
  if ((int)blockIdx.x < wg0) return;
  const int gw = ((int)blockIdx.x - wg0) * NWAVES + wid, NGW = ((int)gridDim.x - wg0) * NWAVES;
  for (int b = gw; b < NS; b += NGW) {
    const size_t row = (size_t)MP + b;
#pragma unroll
    for (int j = 0; j < 3; ++j) {
      const int c0 = j * 512 + lane * 8;
      float x[4][8];
      unpack8(*reinterpret_cast<const u32x4*>(P1 + row * 1536 + c0), x[3]);
#pragma unroll
      for (int i = 0; i < 3; ++i) {
        const float* sp = p.in[4] + (((size_t)l * NS + b) * 3 + i) * 1536 + c0;
        const f32x4 a = *reinterpret_cast<const f32x4*>(sp), cc = *reinterpret_cast<const f32x4*>(sp + 4);
        x[i][0] = a[0]; x[i][1] = a[1]; x[i][2] = a[2]; x[i][3] = a[3];
        x[i][4] = cc[0]; x[i][5] = cc[1]; x[i][6] = cc[2]; x[i][7] = cc[3];
      }
      float o[8];
#pragma unroll
      for (int e = 0; e < 8; ++e) o[e] = 0.f;
#pragma unroll
      for (int i = 0; i < 4; ++i) {
        const f32x4 wa = *reinterpret_cast<const f32x4*>(cw + i * 1536 + c0), wb = *reinterpret_cast<const f32x4*>(cw + i * 1536 + c0 + 4);
        o[0] += wa[0] * x[i][0]; o[1] += wa[1] * x[i][1]; o[2] += wa[2] * x[i][2]; o[3] += wa[3] * x[i][3];
        o[4] += wb[0] * x[i][4]; o[5] += wb[1] * x[i][5]; o[6] += wb[2] * x[i][6]; o[7] += wb[3] * x[i][7];
      }
      float ss = 0.f;
#pragma unroll
      for (int e = 0; e < 8; ++e) { o[e] = o[e] * sigmoidf_(o[e]); ss += o[e] * o[e]; }
      if (j < 2) {
        ss = sum16(ss);
        const float sc = rsqrtf(ss + 1e-6f) * (j == 0 ? 0.08838834764831845f : 1.f);
#pragma unroll
        for (int e = 0; e < 8; ++e) o[e] *= sc;
      }
      *reinterpret_cast<u32x4*>(QS + (size_t)b * 1536 + c0) = pack8(o);
#pragma unroll
      for (int i = 0; i < 3; ++i) {
        float* dst = p.out + OUT_CONVS + (((size_t)l * NS + b) * 3 + i) * 1536 + c0;
        *reinterpret_cast<f32x4*>(dst) = f32x4{x[i + 1][0], x[i + 1][1], x[i + 1][2], x[i + 1][3]};
        *reinterpret_cast<f32x4*>(dst + 4) = f32x4{x[i + 1][4], x[i + 1][5], x[i + 1][6], x[i + 1][7]};
      }
    }
  }
}

__device__ __forceinline__ void phase_pre(const Params& p, int l) {
  const int tid = opaque_tid();
  sample_conv(p, l, tid);
  constexpr int NCHH = NBATCH * 4 * NCH;
  for (int it = blockIdx.x; it < NCHH; it += gridDim.x) {
    const int c = it % NCH, bh = it / NCH;
    gdn_pre_item(p, l, bh >> 2, bh & 3, c, tid);
  }
  if (gridDim.x == 256) {
    const int w = blockIdx.x;
    int first, count, stride;
    if (w < 32) { first = 896 + w; count = 3; stride = 32; }
    else { first = w - 32; count = 4; stride = 224; }
    for (int k = 0; k < count; ++k) {
      const int x = first + k * stride;
      gla_pre_item(p, l, (x / NCH) >> 2, (x / NCH) & 3, x % NCH, tid);
    }
    if (w >= 32 && w < 96) {
      const int x = 992 + (w - 32);
      gla_pre_item(p, l, (x / NCH) >> 2, (x / NCH) & 3, x % NCH, tid);
    }
  } else {
    for (int x = blockIdx.x; x < NCHH; x += gridDim.x) gla_pre_item(p, l, (x / NCH) >> 2, (x / NCH) & 3, x % NCH, tid);
  }
}

__device__ __forceinline__ void img_load(const unsigned char* img, int bytes, int ldsoff, const int tid) {
  LAS unsigned char* lds = (LAS unsigned char*)smem_raw;
  const int wid = __builtin_amdgcn_readfirstlane(tid >> 6), lane = tid & 63;
  for (int k = 0; k * 8192 < bytes; ++k)
    __builtin_amdgcn_global_load_lds((const unsigned*)(img + k * 8192 + wid * 1024 + lane * 16),
                                     (LAS unsigned*)(lds + ldsoff + k * 8192 + wid * 1024), 16, 0, 0);
}

__device__ __forceinline__ void gdn_scan(const Params& p, int l, int b, int h, const int tid) {
  unsigned char* ws = p.ws;
  const LAS unsigned char* lds = (const LAS unsigned char*)smem_raw;
  asm volatile("" : "+v"(lds));
  bf16* O = (bf16*)(ws + OFF_R2);
  const int wid = tid >> 6, lane = tid & 63, r = lane & 15, q = lane >> 4;
  const int n = 16 * wid + r;
  const unsigned char* img0 = ws + OFF_GDN_IMG + (size_t)((b * 4 + h) * NCH) * GDN_IMG;
  const float* GT = reinterpret_cast<const float*>(ws + OFF_GT) + (b * 4 + h) * NCH;
  f32x4 S[8];
#pragma unroll
  for (int k = 0; k < 8; ++k) S[k] = f32x4{0.f, 0.f, 0.f, 0.f};
  constexpr int BUF = 57344;
  img_load(img0, BUF, 0, tid);
  u32x2 u0n[4];
#pragma unroll
  for (int it = 0; it < 4; ++it) u0n[it] = *reinterpret_cast<const u32x2*>(img0 + 57344 + ((wid * 4 + it) * 64 + lane) * 8);
  const float* gtp = GT + (lane & 0);
  asm volatile("" : "+v"(gtp));
  asm volatile("s_waitcnt vmcnt(0)" ::: "memory");
  __syncthreads();
#pragma unroll 1
  for (int c = 0; c < NCH; ++c) {
    const unsigned char* img = img0 + (size_t)c * GDN_IMG;
    const float gt = gtp[c];
    f32x4 U[4], Oc[4];
#pragma unroll
    for (int it = 0; it < 4; ++it) {
      U[it] = f32x4{bflo(u0n[it].x), bfhi(u0n[it].x), bflo(u0n[it].y), bfhi(u0n[it].y)};
      Oc[it] = f32x4{0.f, 0.f, 0.f, 0.f};
    }
    if (c + 1 < NCH) {
      img_load(img + GDN_IMG, BUF, ((c + 1) & 1) * BUF, tid);
#pragma unroll
      for (int it = 0; it < 4; ++it) u0n[it] = *reinterpret_cast<const u32x2*>(img + GDN_IMG + 57344 + ((wid * 4 + it) * 64 + lane) * 8);
    }
    const LAS unsigned char* buf = lds + (c & 1) * BUF;
    bf16x8 Sf[4];
    Sf[0] = frag_from_tiles(S[0], S[1]);
    Sf[1] = frag_from_tiles(S[2], S[3]);
#define SB __builtin_amdgcn_sched_barrier(0)
#define LW(F, ks) _Pragma("unroll") for (int it = 0; it < 4; ++it) F[it] = lds_frag16(buf + (it * 4 + (ks)) * 1024 + lane * 16);
#define LQ(F, ks) _Pragma("unroll") for (int it = 0; it < 4; ++it) F[it] = lds_frag16(buf + 16384 + (it * 4 + (ks)) * 1024 + lane * 16);
#define LK(F, g) _Pragma("unroll") for (int i = 0; i < 4; ++i) F[i] = lds_frag16(buf + 32768 + ((g) * 4 + i) * 1024 + lane * 16);
#define LD(F, g) _Pragma("unroll") for (int i = 0; i < 4; ++i) F[i] = lds_frag16(buf + 40960 + ((g) * 4 + i) * 1024 + lane * 16);
#define MW(F, ks) _Pragma("unroll") for (int it = 0; it < 4; ++it) U[it] = MFMA16(F[it], Sf[ks], U[it]);
#define MQ(F, ks) _Pragma("unroll") for (int it = 0; it < 4; ++it) Oc[it] = MFMA16(F[it], Sf[ks], Oc[it]);
#define MK(F, g) _Pragma("unroll") for (int i = 0; i < 4; ++i) Oc[(g) * 2 + (i >> 1)] = MFMA16(F[i], Uf[i & 1], Oc[(g) * 2 + (i >> 1)]);
#define MD(F, g) _Pragma("unroll") for (int i = 0; i < 4; ++i) {                                   \
      if ((i & 1) == 0) S[(g) * 2 + (i >> 1)] = S[(g) * 2 + (i >> 1)] * gt;                        \
      S[(g) * 2 + (i >> 1)] = MFMA16(F[i], Uf[i & 1], S[(g) * 2 + (i >> 1)]); }
    bf16x8 f0[4], f1[4];
    LW(f0, 0) LQ(f1, 0) SB;
    MW(f0, 0) LW(f0, 1) SB;
    Sf[2] = frag_from_tiles(S[4], S[5]);
    Sf[3] = frag_from_tiles(S[6], S[7]);
    MQ(f1, 0) LQ(f1, 1) SB;
    MW(f0, 1) LW(f0, 2) SB;
    MQ(f1, 1) LQ(f1, 2) SB;
    MW(f0, 2) LW(f0, 3) SB;
    MQ(f1, 2) LQ(f1, 3) SB;
    MW(f0, 3) LK(f0, 0) SB;
    MQ(f1, 3) LK(f1, 1) SB;
    bf16x8 Uf[2];
    Uf[0] = frag_from_tiles(U[0], U[1]);
    Uf[1] = frag_from_tiles(U[2], U[3]);
    MK(f0, 0) LD(f0, 0) SB;
    MK(f1, 1) LD(f1, 1) SB;
    MD(f0, 0) LD(f0, 2) SB;
    MD(f1, 1) LD(f1, 3) SB;
    MD(f0, 2) MD(f1, 3)
#undef LW
#undef LQ
#undef LK
#undef LD
#undef MW
#undef MQ
#undef MK
#undef MD
    {
      const int tbc = (c == 0) ? 0 : 16 + 64 * (c - 1), nvc = (c == 0) ? 16 : 64;
      bf16* ob = O + ((size_t)b * LP + tbc + 4 * q) * 1024 + h * 128 + n;
      asm volatile("" : "+v"(ob));
#pragma unroll
      for (int it = 0; it < 4; ++it)
#pragma unroll
        for (int e = 0; e < 4; ++e) {
          const int i = 16 * it + 4 * q + e;
          if (i < nvc) *reinterpret_cast<u16*>(ob + (16 * it + e) * 1024) = f2bf(Oc[it][e]);
        }
    }
    asm volatile("s_waitcnt vmcnt(0)" ::: "memory");
    __syncthreads();
  }
  float* so = p.out + OUT_GDNP + (((size_t)l * NBATCH + b) * 4 + h) * 128 * 128 + n;
#pragma unroll
  for (int kt = 0; kt < 8; ++kt)
#pragma unroll
    for (int e = 0; e < 4; ++e) so[(size_t)(16 * kt + 4 * q + e) * 128] = S[kt][e];
}

__device__ __forceinline__ void gla_vload(const bf16* __restrict__ P2, size_t row0, int nvalid, int h, int n, int q, bf16x8* Vf) {
#pragma unroll
  for (int s = 0; s < 2; ++s) {
    u16 v[8];
#pragma unroll
    for (int e = 0; e < 8; ++e) {
      const int jj = 32 * s + (e < 4 ? 4 * q + e : 16 + 4 * q + (e - 4));
      v[e] = (jj < nvalid) ? *reinterpret_cast<const u16*>(P2 + (row0 + jj) * 2048 + 1024 + h * 128 + n) : (u16)0;
    }
    Vf[s] = mk_frag((u32)v[0] | ((u32)v[1] << 16), (u32)v[2] | ((u32)v[3] << 16), (u32)v[4] | ((u32)v[5] << 16), (u32)v[6] | ((u32)v[7] << 16));
  }
}
__device__ __forceinline__ void gla_scan(const Params& p, int l, int b, int h, const int tid) {
  unsigned char* ws = p.ws;
  const LAS unsigned char* lds = (const LAS unsigned char*)smem_raw;
  asm volatile("" : "+v"(lds));
  const bf16* P2 = (const bf16*)(ws + OFF_R3);
  bf16* O = (bf16*)(ws + OFF_R2);
  const int wid = tid >> 6, lane = tid & 63, r = lane & 15, q = lane >> 4;
  const int n = 16 * wid + r;
  const unsigned char* img0 = ws + OFF_GLA_IMG + (size_t)((b * 4 + h) * NCH) * GLA_IMG;
  f32x4 S[4];
#pragma unroll
  for (int k = 0; k < 4; ++k) S[k] = f32x4{0.f, 0.f, 0.f, 0.f};
  constexpr int BUF = 24576;
  img_load(img0, BUF, 0, tid);
  bf16x8 Vn[2];
  f32x4 atn[4];
  gla_vload(P2, (size_t)b * LP, 16, h, n, q, Vn);
#pragma unroll
  for (int kt = 0; kt < 4; ++kt) atn[kt] = *reinterpret_cast<const f32x4*>(img0 + 24576 + (16 * kt + 4 * q) * 4);
  u32x2 opk[4];
#pragma unroll
  for (int it = 0; it < 4; ++it) opk[it] = u32x2{0u, 0u};
  asm volatile("s_waitcnt vmcnt(0)" ::: "memory");
  __syncthreads();
#pragma unroll 1
  for (int c = 0; c < NCH; ++c) {
    const unsigned char* img = img0 + (size_t)c * GLA_IMG;
    bf16x8 Vf[2];
    f32x4 at[4];
    Vf[0] = Vn[0]; Vf[1] = Vn[1];
#pragma unroll
    for (int kt = 0; kt < 4; ++kt) at[kt] = atn[kt];
    if (c + 1 < NCH) {
      img_load(img + GLA_IMG, BUF, ((c + 1) & 1) * BUF, tid);
      gla_vload(P2, (size_t)b * LP + 16 + 64 * c, 64, h, n, q, Vn);
#pragma unroll
      for (int kt = 0; kt < 4; ++kt) atn[kt] = *reinterpret_cast<const f32x4*>(img + GLA_IMG + 24576 + (16 * kt + 4 * q) * 4);
    }
    if (c > 0) {
      const int tbp = (c == 1) ? 0 : 16 + 64 * (c - 2), nvp = (c == 1) ? 16 : 64;
      const size_t rowp = (size_t)b * LP + tbp;
#pragma unroll
      for (int it = 0; it < 4; ++it)
#pragma unroll
        for (int e = 0; e < 4; ++e) {
          const int i = 16 * it + 4 * q + e;
          const u32 w = (e < 2) ? opk[it].x : opk[it].y;
          if (i < nvp) *reinterpret_cast<u16*>(O + (rowp + i) * 1024 + 512 + h * 128 + n) = (u16)((e & 1) ? (w >> 16) : (w & 0xffffu));
        }
    }
    const LAS unsigned char* buf = lds + (c & 1) * BUF;
    bf16x8 Sf[2];
    Sf[0] = frag_from_tiles(S[0], S[1]);
    Sf[1] = frag_from_tiles(S[2], S[3]);
#pragma unroll
    for (int it = 0; it < 4; ++it) {
      f32x4 o = {0.f, 0.f, 0.f, 0.f};
#pragma unroll
      for (int ks = 0; ks < 2; ++ks) o = MFMA16(lds_frag16(buf + (it * 2 + ks) * 1024 + lane * 16), Sf[ks], o);
#pragma unroll
      for (int s = 0; s < 2; ++s) o = MFMA16(lds_frag16(buf + 8192 + (it * 2 + s) * 1024 + lane * 16), Vf[s], o);
      opk[it].x = pk2(o[0], o[1]); opk[it].y = pk2(o[2], o[3]);
    }
    __builtin_amdgcn_sched_barrier(0);
#pragma unroll
    for (int kt = 0; kt < 4; ++kt) {
      f32x4 sv = S[kt] * at[kt];
#pragma unroll
      for (int s = 0; s < 2; ++s) sv = MFMA16(lds_frag16(buf + 16384 + (kt * 2 + s) * 1024 + lane * 16), Vf[s], sv);
      S[kt] = sv;
    }
    asm volatile("s_waitcnt vmcnt(0)" ::: "memory");
    __syncthreads();
  }
  {
    const int tbp = 16 + 64 * (NCH - 2);
    const size_t rowp = (size_t)b * LP + tbp;
#pragma unroll
    for (int it = 0; it < 4; ++it)
#pragma unroll
      for (int e = 0; e < 4; ++e) {
        const int i = 16 * it + 4 * q + e;
        const u32 w = (e < 2) ? opk[it].x : opk[it].y;
        *reinterpret_cast<u16*>(O + (rowp + i) * 1024 + 512 + h * 128 + n) = (u16)((e & 1) ? (w >> 16) : (w & 0xffffu));
      }
  }
  float* so = p.out + OUT_GLAP + (((size_t)l * NBATCH + b) * 4 + h) * 64 * 128 + n;
#pragma unroll
  for (int kt = 0; kt < 4; ++kt)
#pragma unroll
    for (int e = 0; e < 4; ++e) so[(size_t)(16 * kt + 4 * q + e) * 128] = S[kt][e];
}

__device__ __forceinline__ void phase_scan(const Params& p, int l) {
  const int tid = opaque_tid();
  const int wid = tid >> 6;
  for (int j = blockIdx.x; j < 64; j += gridDim.x) {
    if (j < 32) gdn_scan(p, l, j >> 2, j & 3, tid);
    else gla_scan(p, l, (j - 32) >> 2, j & 3, tid);
  }
  const int nsw = gridDim.x > 64 ? (int)gridDim.x - 64 : (int)gridDim.x;
  const int myw = gridDim.x > 64 ? (int)blockIdx.x - 64 : (int)blockIdx.x;
  if (myw >= 0) {
    float* lds = (float*)(smem_raw + wid * 2048);
    for (int s = myw * NWAVES + wid; s < 2048; s += nsw * NWAVES) {
      const int j = s & 1023;
      if (s < 1024) gdn_job(p, l, j >> 3, (j >> 1) & 3, j & 1, lds, tid);
      else gla_job(p, l, j >> 3, (j >> 1) & 3, j & 1, true, lds, tid);
    }
  }
}

__device__ __forceinline__ void phase_gnorm(const Params& p, int l) {
  const int tid = opaque_tid();
  unsigned char* ws = p.ws;
  const bf16* P2 = (const bf16*)(ws + OFF_R3);
  bf16* O = (bf16*)(ws + OFF_R2);
  const int wid = tid >> 6, lane = tid & 63;
  const int gw = blockIdx.x * NWAVES + wid, NGW = gridDim.x * NWAVES;
  const int cw = (lane & 15) * 8;
  float wA[8], wB[8];
#pragma unroll
  for (int e = 0; e < 8; ++e) { wA[e] = p.in[10][l * 128 + cw + e]; wB[e] = p.in[13][l * 128 + cw + e]; }
  for (int row = gw; row < MT; row += NGW) {
#pragma unroll
    for (int j = 0; j < 2; ++j) {
      const int c0 = j * 512 + lane * 8;
      float o[8], z[8];
      unpack8(*reinterpret_cast<const u32x4*>(O + (size_t)row * 1024 + c0), o);
      unpack8(*reinterpret_cast<const u32x4*>(P2 + (size_t)row * 2048 + (j == 0 ? 0 : 1536) + lane * 8), z);
      float ss = 0.f;
#pragma unroll
      for (int e = 0; e < 8; ++e) ss += o[e] * o[e];
      ss = sum16(ss);
      const float sc = rsqrtf(ss * (1.f / 128.f) + 1e-6f);
#pragma unroll
      for (int e = 0; e < 8; ++e) o[e] = o[e] * sc * (j == 0 ? wA[e] : wB[e]) * (z[e] * sigmoidf_(z[e]));
      *reinterpret_cast<u32x4*>(O + (size_t)row * 1024 + c0) = pack8(o);
    }
  }
}

__device__ __forceinline__ void phase_merge(const Params& p) {
  const int tid = opaque_tid();
  unsigned char* ws = p.ws;
  const bf16* O = (const bf16*)(ws + OFF_R2);
  const bf16* P3 = (const bf16*)(ws + OFF_R4);
  bf16* MG = (bf16*)(ws + OFF_R3);
  for (int u = 0;; ++u) {
    const int t = blockIdx.x + (u >> 1) * gridDim.x, br = u & 1;
    if (t >= 4 * 64) break;
    const int pn = t / 64, pm = t % 64, brow = pm * 256, bcol = pn * 256;
    {
      Acc acc; acc_zero(acc);
      gemm_kloop(acc, O + br * 512, 1024, (const bf16*)(ws + (br ? OFF_WB : OFF_WA)), 512, 512, brow, bcol, tid, true);
      int brow_e = brow;
      asm volatile("" : "+s"(brow_e));
      EPI_COORDS
#pragma unroll
      for (int ai = 0; ai < 2; ++ai)
#pragma unroll
        for (int bj = 0; bj < 2; ++bj)
#pragma unroll
          for (int m = 0; m < 4; ++m) {
            const int erow = brow_e + ai * 128 + wr * 64 + m * 16 + fr;
            const int ecol = bcol + bj * 128 + wc * 32 + 8 * fq;
            float g[8], r[8];
            unpack8(*reinterpret_cast<const u32x4*>(P3 + (size_t)erow * 2048 + br * 1024 + ecol), g);
            bf16* mp = MG + (size_t)erow * 1024 + ecol;
            const f32x4 v0 = acc[ai][bj][m][0], v1 = acc[ai][bj][m][1];
#pragma unroll
            for (int j = 0; j < 4; ++j) { r[j] = v0[j] * sigmoidf_(g[j]); r[4 + j] = v1[j] * sigmoidf_(g[4 + j]); }
            if (br) {
              float pv[8];
              unpack8(*reinterpret_cast<const u32x4*>(mp), pv);
#pragma unroll
              for (int j = 0; j < 8; ++j) r[j] += pv[j];
            }
            *reinterpret_cast<u32x4*>(mp) = pack8(r);
            __builtin_amdgcn_sched_barrier(0);
          }
    }
  }
  __syncthreads();
  tail_gemm<1>(p, O, 1024, (const bf16*)(ws + OFF_WA), 512, 512, 1024, 0, tid);
  tail_gemm<1>(p, O + 512, 1024, (const bf16*)(ws + OFF_WB), 512, 512, 1024, 1, tid);
}

__device__ __forceinline__ void phase_gemm_resid(const Params& p, const bf16* A, int lda, const bf16* Wt, int K) {
  const int tid = opaque_tid();
  unsigned char* ws = p.ws;
  const bf16* Xb = (const bf16*)(ws + OFF_XB);
  bf16* PL = (bf16*)(ws + OFF_R4);
  for (int t = blockIdx.x; t < 4 * 64; t += gridDim.x) {
    const int pn = t / 64, pm = t % 64, brow = pm * 256, bcol = pn * 256;
    Acc acc; acc_zero(acc);
    gemm_kloop(acc, A, lda, Wt, K, K, brow, bcol, tid, true);
    EPI_COORDS
#pragma unroll
    for (int ai = 0; ai < 2; ++ai)
#pragma unroll
      for (int bj = 0; bj < 2; ++bj)
#pragma unroll
        for (int m = 0; m < 4; ++m) {
          const size_t off = (size_t)(brow + ai * 128 + wr * 64 + m * 16 + fr) * 1024 + bcol + bj * 128 + wc * 32 + 8 * fq;
          float x[8], r[8];
          unpack8(*reinterpret_cast<const u32x4*>(Xb + off), x);
          const f32x4 v0 = acc[ai][bj][m][0], v1 = acc[ai][bj][m][1];
#pragma unroll
          for (int j = 0; j < 4; ++j) { r[j] = v0[j] + ALPHA * x[j]; r[4 + j] = v1[j] + ALPHA * x[4 + j]; }
          *reinterpret_cast<u32x4*>(PL + off) = pack8(r);
        }
  }
  __syncthreads();
  tail_gemm<2>(p, A, lda, Wt, K, K, 1024, 0, tid);
}

__device__ __forceinline__ void phase_ffn_in(const Params& p) {
  const int tid = opaque_tid();
  unsigned char* ws = p.ws;
  const bf16* Xb = (const bf16*)(ws + OFF_XB);
  bf16* H = (bf16*)(ws + OFF_R2);
  for (int t = blockIdx.x; t < 22 * NMT; t += gridDim.x) {
    int pn, pm;
    tile_xcd(t, 22, pm, pn);
    const int brow = pm * 256, bcol = pn * 256;
    Acc acc; acc_zero(acc);
    gemm_kloop(acc, Xb, 1024, (const bf16*)(ws + OFF_WFI), 1024, 1024, brow, bcol, tid);
    EPI_COORDS
#pragma unroll
    for (int ai = 0; ai < 2; ++ai)
#pragma unroll
      for (int m = 0; m < 4; ++m) {
        float r[8];
#pragma unroll
        for (int bj = 0; bj < 2; ++bj) {
          const f32x4 a = acc[ai][bj][m][0], u = acc[ai][bj][m][1];
#pragma unroll
          for (int j = 0; j < 4; ++j) r[bj * 4 + j] = a[j] * sigmoidf_(a[j]) * u[j];
        }
        const int hc = (bcol >> 1) + wc * 32 + fq * 8;
        *reinterpret_cast<u32x4*>(H + (size_t)(brow + ai * 128 + wr * 64 + m * 16 + fr) * DFF + hc) = pack8(r);
      }
  }
}

__device__ __forceinline__ void phase_ln(const Params& p, const float* g, const float* bta, bool final_out) {
  const int tid = opaque_tid();
  unsigned char* ws = p.ws;
  const bf16* PL = (const bf16*)(ws + OFF_R4);
  bf16* Xb = (bf16*)(ws + OFF_XB);
  const int wid = tid >> 6, lane = tid & 63;
  const int gw = blockIdx.x * NWAVES + wid, NGW = gridDim.x * NWAVES;
  float gg[2][8], bb[2][8];
#pragma unroll
  for (int j = 0; j < 2; ++j)
#pragma unroll
    for (int e = 0; e < 8; e += 4) {
      const f32x4 gv = *reinterpret_cast<const f32x4*>(g + j * 512 + lane * 8 + e), bv = *reinterpret_cast<const f32x4*>(bta + j * 512 + lane * 8 + e);
      gg[j][e] = gv[0]; gg[j][e + 1] = gv[1]; gg[j][e + 2] = gv[2]; gg[j][e + 3] = gv[3];
      bb[j][e] = bv[0]; bb[j][e + 1] = bv[1]; bb[j][e + 2] = bv[2]; bb[j][e + 3] = bv[3];
    }
  for (int row = gw; row < MT; row += NGW) {
    float v[2][8];
    float s = 0.f, s2 = 0.f;
#pragma unroll
    for (int j = 0; j < 2; ++j) {
      unpack8(*reinterpret_cast<const u32x4*>(PL + (size_t)row * 1024 + j * 512 + lane * 8), v[j]);
#pragma unroll
      for (int e = 0; e < 8; ++e) { s += v[j][e]; s2 += v[j][e] * v[j][e]; }
    }
    const float mean = sum64(s) * (1.f / 1024.f);
    const float var = fmaxf(sum64(s2) * (1.f / 1024.f) - mean * mean, 0.f);
    const float rstd = rsqrtf(var + 1e-5f);
#pragma unroll
    for (int j = 0; j < 2; ++j)
#pragma unroll
      for (int e = 0; e < 8; ++e) v[j][e] -= mean;
    float* dst = nullptr;
    if (final_out) {
      if (row < MP) {
        const int b = row / LP, t = row - b * LP;
        if (t >= 16) dst = p.out + OUT_YP + ((size_t)b * 2048 + (t - 16)) * 1024;
      } else {
        dst = p.out + OUT_YS + (size_t)(row - MP) * 1024;
      }
    }
#pragma unroll
    for (int j = 0; j < 2; ++j) {
      float y[8];
#pragma unroll
      for (int e = 0; e < 8; ++e) y[e] = v[j][e] * rstd * gg[j][e] + bb[j][e];
      if (final_out) {
        if (dst) {
          *reinterpret_cast<f32x4*>(dst + j * 512 + lane * 8) = f32x4{y[0], y[1], y[2], y[3]};
          *reinterpret_cast<f32x4*>(dst + j * 512 + lane * 8 + 4) = f32x4{y[4], y[5], y[6], y[7]};
        }
      } else {
        *reinterpret_cast<u32x4*>(Xb + (size_t)row * 1024 + j * 512 + lane * 8) = pack8(y);
      }
    }
  }
}

#define XB_TMO      128
#define XB_XCNT(j)  (256  + 64 * (j))
#define XB_XSUB(j)  (1280 + 64 * (j))
#define XB_XGEN(j)  (2304 + 64 * (j))
#define XB_TOP      3328
#define XB_TOPGEN   3392
#define XCD_BAR_WORDS 3456
#define XB_SPIN_CAP (1u << 18)

__device__ __forceinline__ unsigned xb_ld(unsigned* p)              { return __hip_atomic_load(p, __ATOMIC_RELAXED, __HIP_MEMORY_SCOPE_AGENT); }
__device__ __forceinline__ unsigned xb_add(unsigned* p, unsigned v) { return __hip_atomic_fetch_add(p, v, __ATOMIC_RELAXED, __HIP_MEMORY_SCOPE_AGENT); }
__device__ __forceinline__ unsigned xb_xcc_id() { return (unsigned)__builtin_amdgcn_s_getreg((3 << 11) | 20) & 0xFu; }
#define XB_SPIN(cond, bar) do { unsigned _sp = 0; while (cond) { __builtin_amdgcn_s_sleep(1); \
    if ((++_sp & 255u) == 0u) { if (xb_ld(&(bar)[XB_TMO])) break; if (_sp > XB_SPIN_CAP) { atomicAdd(&(bar)[XB_TMO], 1u); break; } } } } while (0)

struct XcdBarrier {
    unsigned* bar; unsigned x;
    volatile LAS unsigned* st;
};

__device__ __forceinline__ XcdBarrier xcd_barrier_post(unsigned* bar, volatile LAS unsigned* st) {
    XcdBarrier b; b.bar = bar; b.x = xb_xcc_id(); b.st = st;
    if (threadIdx.x == 0) (void)xb_add(&bar[XB_XCNT(b.x)], 1u);
    return b;
}
__device__ __forceinline__ void xcd_barrier_complete(unsigned* bar, unsigned x, unsigned& nloc, unsigned& nx) {
    const unsigned G = gridDim.x * gridDim.y * gridDim.z;
    unsigned sum, cnt, mine, sp = 0u;
    for (;;) {
        sum = 0u; cnt = 0u; mine = 0u;
#pragma unroll
        for (unsigned j = 0; j < 16; ++j) { const unsigned c = xb_ld(&bar[XB_XCNT(j)]); sum += c; cnt += (c > 0u) ? 1u : 0u; mine = (j == x) ? c : mine; }
        if (sum == G) break;
        __builtin_amdgcn_s_sleep(1);
        if ((++sp & 255u) == 0u) { if (xb_ld(&bar[XB_TMO])) break; if (sp > XB_SPIN_CAP) { atomicAdd(&bar[XB_TMO], 1u); break; } }
    }
    nloc = mine > 0u ? mine : 1u; nx = cnt > 0u ? cnt : 1u;
}

__device__ __forceinline__ void xcd_barrier(const XcdBarrier& b) {
    asm volatile("s_waitcnt vmcnt(0)" ::: "memory");
    __syncthreads();
    if (threadIdx.x == 0) {
        unsigned* bar = b.bar;
        __builtin_amdgcn_s_waitcnt(0);
        unsigned nloc = b.st[0], nx = b.st[1];
        if (nloc == 0u) { xcd_barrier_complete(bar, b.x, nloc, nx); b.st[0] = nloc; b.st[1] = nx; }
        const unsigned old = xb_add(&bar[XB_XSUB(b.x)], 1u);
        const unsigned gen = old / nloc;
        if (old + 1u == (gen + 1u) * nloc) {
            __builtin_amdgcn_fence(__ATOMIC_RELEASE, "agent");
            asm volatile("s_waitcnt vmcnt(0)" ::: "memory");
            const unsigned og = xb_add(&bar[XB_TOP], 1u);
            const unsigned tg = og / nx;
            if (og + 1u == (tg + 1u) * nx) xb_add(&bar[XB_TOPGEN], 1u);
            else XB_SPIN(xb_ld(&bar[XB_TOPGEN]) == tg, bar);
            __builtin_amdgcn_fence(__ATOMIC_ACQUIRE, "agent");
            xb_add(&bar[XB_XGEN(b.x)], 1u);
            asm volatile("s_waitcnt vmcnt(0)" ::: "memory");
        } else {
            XB_SPIN(xb_ld(&bar[XB_XGEN(b.x)]) == gen, bar);
            __builtin_amdgcn_fence(__ATOMIC_ACQUIRE, "agent");
            asm volatile("s_waitcnt vmcnt(0)" ::: "memory");
        }
    }
    __syncthreads();
}


__global__ void __launch_bounds__(NTHREADS, 2) fwd_kernel(Params p_in) {
  volatile LAS unsigned* xb_st = (volatile LAS unsigned*)((LAS unsigned char*)smem_raw + 131072);
  if (threadIdx.x == 0) { xb_st[0] = 0u; xb_st[1] = 0u; xb_st[2] = 0u; xb_st[3] = 0u; }
  __syncthreads();
  const XcdBarrier xb = xcd_barrier_post((unsigned*)(p_in.ws + OFF_BAR), xb_st);
  for (int ph = p_in.ph_lo; ph < p_in.ph_hi; ++ph) {
    const int l = ph / PH_PER_LAYER, k = ph % PH_PER_LAYER;
    Params p = p_in;
    {
      unsigned long long wsi = (unsigned long long)p_in.ws, outi = (unsigned long long)p_in.out;
      asm volatile("" : "+s"(wsi), "+s"(outi));
      p.ws = (unsigned char*)(__attribute__((address_space(1))) unsigned char*)wsi;
      p.out = (float*)(__attribute__((address_space(1))) float*)outi;
    }
    unsigned char* ws = p.ws;
    const int nrep = 1 + ((REPEAT_MASK >> k) & 1);
    for (int rep = 0; rep < nrep; ++rep) {
    if (rep) xcd_barrier(xb);
    switch (k) {
      case 0: if (l == 0) phase_convert(p, 0, 1 | 8, 0); break;
      case 1: phase_gemm_in(p, false); break;
      case 2: phase_pre(p, l); break;
      case 3: phase_scan(p, l);
              __syncthreads();
              phase_convert(p, l, 2 | 4, gridDim.x > 64 ? 64 : 0);
              break;
      case 4: phase_gnorm(p, l); phase_gemm_in(p, true); break;
      case 5: break;
      case 6: phase_merge(p); break;
      case 7: phase_gemm_resid(p, (const bf16*)(ws + OFF_R3), 1024, (const bf16*)(ws + OFF_WO), 1024); break;
      case 8: phase_ln(p, p.in[17] + l * 1024, p.in[18] + l * 1024, false);
              if (l == 0) phase_convert(p, 1, 1, 0);
              break;
      case 9: phase_ffn_in(p); break;
      case 10: phase_gemm_resid(p, (const bf16*)(ws + OFF_R2), DFF, (const bf16*)(ws + OFF_WFO), DFF); break;
      case 11: phase_ln(p, p.in[19] + l * 1024, p.in[20] + l * 1024, l == 1);
               break;
    }
    }
#if EXTRA_SYNCS
    for (int xs = 0; xs < EXTRA_SYNCS; ++xs) xcd_barrier(xb);
#endif
    const bool empty_phase = (k == 5) || (k == 0 && l > 0);
    if (ph + 1 < p_in.ph_hi && !empty_phase) {
      if (p_in.ph_hi > NPHASES) { __syncthreads(); cg::this_grid().sync(); }
      xcd_barrier(xb);
    }
  }
}

extern "C" void kernel_launch(void* const* d_in, const int* in_sizes, int n_in, void* d_out, int out_size, void* d_ws,
                              size_t ws_size, hipStream_t stream) {
  constexpr int LDS_BYTES = 131072 + 16;
  static int grid = 0;
  if (grid == 0) {
    int dev = 0, cus = 0;
    hipGetDevice(&dev);
    hipDeviceGetAttribute(&cus, hipDeviceAttributeMultiprocessorCount, dev);
    hipFuncSetAttribute((const void*)fwd_kernel, hipFuncAttributeMaxDynamicSharedMemorySize, LDS_BYTES);
    int per_cu = 0;
    hipOccupancyMaxActiveBlocksPerMultiprocessor(&per_cu, (const void*)fwd_kernel, NTHREADS, LDS_BYTES);
    (void)hipGetLastError();
    grid = cus > 0 ? cus : 256;
    if (ws_size < WS_END) fprintf(stderr, "kernel_launch: workspace too small: %zu < %zu\n", ws_size, (size_t)WS_END);
    if (per_cu < 1) fprintf(stderr, "kernel_launch: occupancy query says %d blocks per CU\n", per_cu);
  }
  Params p{};
  for (int i = 0; i < 23; ++i) p.in[i] = (const float*)d_in[i];
  p.out = (float*)d_out;
  p.ws = (unsigned char*)d_ws;
  (void)hipMemsetAsync((unsigned char*)d_ws + OFF_BAR, 0, BAR_BYTES, stream);
#if SINGLE_LAUNCH
  p.ph_lo = 0; p.ph_hi = NPHASES;
  void* args[] = {&p};
  hipError_t e = hipLaunchCooperativeKernel((const void*)fwd_kernel, dim3(grid), dim3(NTHREADS), args, LDS_BYTES, stream);
  if (e != hipSuccess) fprintf(stderr, "cooperative launch failed: %s (grid %d)\n", hipGetErrorString(e), grid);
#else
  for (int ph = 0; ph < NPHASES; ++ph) {
    p.ph_lo = ph; p.ph_hi = ph + 1;
    hipLaunchKernelGGL(fwd_kernel, dim3(grid), dim3(NTHREADS), LDS_BYTES, stream, p);
  }
#endif
}
```
